# Optimizing an MI355X kernel written in HIP

```python
import math
import jax, jax.numpy as jnp
from jax import lax
import numpy as np

D_MODEL = 1024
BATCH = 32
SEQ = 2048
DEPTH = 2

EPS = 1e-6
Q_BLOCK = 128
ROPE_THETA = 500000.0
ROPE_FRACTION = 4

A_HEADS = 4
A_QK_DIM = 64
A_V_DIM = 2 * A_QK_DIM
A_QK_W = A_HEADS * 2 * A_QK_DIM
A_V_W = A_HEADS * A_V_DIM

B_HEADS = 4
B_K_DIM = 128
B_V_DIM = 128
B_K_W = B_HEADS * B_K_DIM
B_V_W = B_HEADS * B_V_DIM
B_CONV_CH = 2 * B_K_W + B_V_W
CONV_K = 4
CHUNK = 64

MIX_AB = A_V_W + B_V_W
AB_SIZES = (A_QK_W, A_QK_W, A_V_W, A_V_W, B_CONV_CH, B_V_W, B_HEADS, B_HEADS)
AB_SPLITS = tuple(int(s) for s in np.cumsum(AB_SIZES)[:-1])
IN_AB = int(sum(AB_SIZES))

C_HEADS = 16
C_HEAD_DIM = 64
MIX_C = C_HEADS * C_HEAD_DIM
C_SIZES = (MIX_C, MIX_C, MIX_C, MIX_C, C_HEADS)
C_SPLITS = tuple(int(s) for s in np.cumsum(C_SIZES)[:-1])
IN_C = int(sum(C_SIZES))

kernel_name = "hybrid_diffattn_gdn_fox_block"


def rmsnorm(x, w):
    xf = x.astype(jnp.float32)
    y = xf * lax.rsqrt(jnp.mean(xf * xf, axis=-1, keepdims=True) + EPS)
    return (y * w.astype(jnp.float32)).astype(x.dtype)


def partial_rope(x, positions):
    rot = x.shape[-1] // ROPE_FRACTION
    half = rot // 2
    inv_freq = ROPE_THETA ** (-(jnp.arange(half, dtype=jnp.float32) * 2.0) / rot)
    ang = positions.astype(jnp.float32)[..., None] * inv_freq
    cos = jnp.cos(ang)[:, :, None, :]
    sin = jnp.sin(ang)[:, :, None, :]
    xf = x.astype(jnp.float32)
    x1, x2 = xf[..., :half], xf[..., half:rot]
    out = jnp.concatenate([x1 * cos - x2 * sin, x2 * cos + x1 * sin, xf[..., rot:]], axis=-1)
    return out.astype(x.dtype)


def causal_block_mask(s0, s1):
    qpos = jnp.arange(s0, s1)
    kpos = jnp.arange(s1)
    return kpos[None, :] <= qpos[:, None]


def diff_attention(q, k, v, lam):
    seq = q.shape[1]
    scale = q.shape[-1] ** -0.5
    outs = []
    for s0 in range(0, seq, Q_BLOCK):
        s1 = s0 + Q_BLOCK
        logits = jnp.einsum('bqhcd,bkhcd->bhcqk', q[:, s0:s1], k[:, :s1],
                            preferred_element_type=jnp.float32) * scale
        logits = jnp.where(causal_block_mask(s0, s1), logits, -jnp.inf)
        p = jax.nn.softmax(logits, axis=-1)
        p = p[:, :, 0] - lam * p[:, :, 1]
        outs.append(jnp.einsum('bhqk,bkhe->bqhe', p, v[:, :s1].astype(jnp.float32)))
    return jnp.concatenate(outs, axis=1).astype(v.dtype)


def forgetting_attention(q, k, v, cum_logf):
    seq = q.shape[1]
    scale = q.shape[-1] ** -0.5
    c = jnp.transpose(cum_logf, (0, 2, 1))
    outs = []
    for s0 in range(0, seq, Q_BLOCK):
        s1 = s0 + Q_BLOCK
        logits = jnp.einsum('bqhd,bkhd->bhqk', q[:, s0:s1], k[:, :s1],
                            preferred_element_type=jnp.float32) * scale
        bias = c[:, :, s0:s1, None] - c[:, :, None, :s1]
        logits = jnp.where(causal_block_mask(s0, s1), logits + bias, -jnp.inf)
        p = jax.nn.softmax(logits, axis=-1)
        outs.append(jnp.einsum('bhqk,bkhd->bqhd', p, v[:, :s1].astype(jnp.float32)))
    return jnp.concatenate(outs, axis=1).astype(v.dtype)


def causal_depthwise_conv(x, w):
    kw = w.shape[0]
    return lax.conv_general_dilated(
        x, w[:, None, :], window_strides=(1,), padding=[(kw - 1, 0)],
        dimension_numbers=('NWC', 'WIO', 'NWC'), feature_group_count=x.shape[-1])


def gated_delta_rule_chunked(q, k, v, g, beta):
    out_dtype = v.dtype
    bsz, seq, heads, dk = q.shape
    dv = v.shape[-1]
    n_chunks = seq // CHUNK

    def to_chunks(t):
        return t.astype(jnp.float32).reshape(bsz, n_chunks, CHUNK, heads, -1).transpose(1, 0, 3, 2, 4)

    def to_chunks_s(t):
        return t.reshape(bsz, n_chunks, CHUNK, heads).transpose(1, 0, 3, 2)

    qc = to_chunks(q) * (dk ** -0.5)
    kc = to_chunks(k)
    vc = to_chunks(v)
    bc = to_chunks_s(beta)
    gc = jnp.cumsum(to_chunks_s(g), axis=-1)

    tril = jnp.tril(jnp.ones((CHUNK, CHUNK), dtype=bool))
    strict = jnp.tril(jnp.ones((CHUNK, CHUNK), dtype=bool), k=-1)
    decay = jnp.exp(jnp.where(tril, gc[..., :, None] - gc[..., None, :], -jnp.inf))

    k_beta = kc * bc[..., None]
    v_beta = vc * bc[..., None]
    lower = jnp.where(strict, jnp.einsum('nbhck,nbhsk->nbhcs', k_beta, kc) * decay, 0.0)
    unit_lower = lower + jnp.eye(CHUNK, dtype=jnp.float32)
    rhs = jnp.concatenate([v_beta, k_beta * jnp.exp(gc)[..., None]], axis=-1)
    sol = lax.linalg.triangular_solve(unit_lower, rhs, left_side=True, lower=True,
                                      unit_diagonal=True)
    u, w = sol[..., :dv], sol[..., dv:]
    qk = jnp.where(tril, jnp.einsum('nbhck,nbhsk->nbhcs', qc, kc) * decay, 0.0)

    def step(state, xs):
        q_c, k_c, u_c, w_c, g_c, qk_c = xs
        v_new = u_c - jnp.einsum('bhck,bhkv->bhcv', w_c, state)
        o = (jnp.einsum('bhck,bhkv->bhcv', q_c * jnp.exp(g_c)[..., None], state)
             + jnp.einsum('bhcs,bhsv->bhcv', qk_c, v_new))
        g_last = g_c[..., -1:]
        state = (state * jnp.exp(g_last)[..., None]
                 + jnp.einsum('bhck,bhcv->bhkv', k_c * jnp.exp(g_last - g_c)[..., None], v_new))
        return state, o

    state0 = jnp.zeros((bsz, heads, dk, dv), jnp.float32)
    _, o = lax.scan(step, state0, (qc, kc, u, w, gc, qk))
    return o.transpose(1, 0, 3, 2, 4).reshape(bsz, seq, heads, dv).astype(out_dtype)


def mixer_ab(h, positions, layer, w_in_ab, a_lambda_q1, a_lambda_k1, a_lambda_q2, a_lambda_k2,
             a_subln, b_conv_w, b_a_log, b_dt_bias, b_head_norm, w_out_ab):
    bsz, seq, _ = h.shape
    proj = h @ w_in_ab
    a_q, a_k, a_v, a_z, b_qkv, b_z, b_beta, b_a = jnp.split(proj, AB_SPLITS, axis=-1)

    lambda_init = 0.8 - 0.6 * math.exp(-0.3 * layer)
    f32 = jnp.float32
    lam = (jnp.exp(jnp.sum(a_lambda_q1.astype(f32) * a_lambda_k1.astype(f32)))
           - jnp.exp(jnp.sum(a_lambda_q2.astype(f32) * a_lambda_k2.astype(f32))) + lambda_init)
    q = partial_rope(a_q.reshape(bsz, seq, A_HEADS * 2, A_QK_DIM), positions)
    k = partial_rope(a_k.reshape(bsz, seq, A_HEADS * 2, A_QK_DIM), positions)
    q = q.reshape(bsz, seq, A_HEADS, 2, A_QK_DIM)
    k = k.reshape(bsz, seq, A_HEADS, 2, A_QK_DIM)
    v = a_v.reshape(bsz, seq, A_HEADS, A_V_DIM)
    o_a = diff_attention(q, k, v, lam)
    o_a = rmsnorm(o_a, a_subln) * (1.0 - lambda_init)
    o_a = o_a.reshape(bsz, seq, A_V_W) * jax.nn.silu(a_z)

    qkv = jax.nn.silu(causal_depthwise_conv(b_qkv, b_conv_w))
    bq, bk, bv = jnp.split(qkv, (B_K_W, 2 * B_K_W), axis=-1)
    bq = bq.reshape(bsz, seq, B_HEADS, B_K_DIM).astype(f32)
    bk = bk.reshape(bsz, seq, B_HEADS, B_K_DIM).astype(f32)
    bv = bv.reshape(bsz, seq, B_HEADS, B_V_DIM)
    bq = bq * lax.rsqrt(jnp.sum(bq * bq, axis=-1, keepdims=True) + EPS)
    bk = bk * lax.rsqrt(jnp.sum(bk * bk, axis=-1, keepdims=True) + EPS)
    beta = jax.nn.sigmoid(b_beta.astype(f32))
    g = -jnp.exp(b_a_log.astype(f32)) * jax.nn.softplus(b_a.astype(f32) + b_dt_bias.astype(f32))
    o_b = gated_delta_rule_chunked(bq, bk, bv, g, beta)
    o_b = rmsnorm(o_b, b_head_norm).reshape(bsz, seq, B_V_W) * jax.nn.silu(b_z)

    return jnp.concatenate([o_a, o_b], axis=-1) @ w_out_ab


def mixer_c(h, w_in_c, c_forget_bias, w_out_c):
    bsz, seq, _ = h.shape
    proj = h @ w_in_c
    q, k, v, z, f_logit = jnp.split(proj, C_SPLITS, axis=-1)
    log_f = jax.nn.log_sigmoid(f_logit.astype(jnp.float32) + c_forget_bias.astype(jnp.float32))
    cum_logf = jnp.cumsum(log_f, axis=1)
    o = forgetting_attention(q.reshape(bsz, seq, C_HEADS, C_HEAD_DIM),
                             k.reshape(bsz, seq, C_HEADS, C_HEAD_DIM),
                             v.reshape(bsz, seq, C_HEADS, C_HEAD_DIM), cum_logf)
    return (o.reshape(bsz, seq, MIX_C) * jax.nn.silu(z)) @ w_out_c


def setup_inputs(seed: int = 0) -> dict:
    key = jax.random.key(seed)
    ks = jax.random.split(key, 20)
    f32 = jnp.float32

    def nrm(k, shape, scale):
        return jax.random.normal(k, shape, f32) * scale

    x = nrm(ks[0], (BATCH, SEQ, D_MODEL), 1.0)
    positions = jnp.tile(jnp.arange(SEQ, dtype=jnp.int32)[None, :], (BATCH, 1))
    pre_norm = 1.0 + nrm(ks[1], (DEPTH, D_MODEL), 0.05)
    post_norm = 1.0 + nrm(ks[2], (DEPTH, D_MODEL), 0.05)
    w_in_ab = nrm(ks[3], (D_MODEL, IN_AB), D_MODEL ** -0.5)
    a_lambda_q1 = nrm(ks[4], (A_QK_DIM,), 0.1)
    a_lambda_k1 = nrm(ks[5], (A_QK_DIM,), 0.1)
    a_lambda_q2 = nrm(ks[6], (A_QK_DIM,), 0.1)
    a_lambda_k2 = nrm(ks[7], (A_QK_DIM,), 0.1)
    a_subln = 1.0 + nrm(ks[8], (A_V_DIM,), 0.05)
    b_conv_w = nrm(ks[9], (CONV_K, B_CONV_CH), CONV_K ** -0.5)
    b_a_log = jnp.log(jax.random.uniform(ks[10], (B_HEADS,), f32, 1.0, 16.0))
    dt = jnp.exp(jax.random.uniform(ks[11], (B_HEADS,), f32, math.log(1e-3), math.log(1e-1)))
    b_dt_bias = dt + jnp.log(-jnp.expm1(-dt))
    b_head_norm = 1.0 + nrm(ks[12], (B_V_DIM,), 0.05)
    w_out_ab = nrm(ks[13], (MIX_AB, D_MODEL), MIX_AB ** -0.5)
    w_in_c = nrm(ks[14], (D_MODEL, IN_C), D_MODEL ** -0.5)
    c_forget_bias = jax.random.uniform(ks[15], (C_HEADS,), f32, 1.0, 5.0)
    w_out_c = nrm(ks[16], (MIX_C, D_MODEL), MIX_C ** -0.5)
    return {"x": x, "positions": positions, "pre_norm": pre_norm, "post_norm": post_norm,
            "w_in_ab": w_in_ab, "a_lambda_q1": a_lambda_q1, "a_lambda_k1": a_lambda_k1,
            "a_lambda_q2": a_lambda_q2, "a_lambda_k2": a_lambda_k2, "a_subln": a_subln,
            "b_conv_w": b_conv_w, "b_a_log": b_a_log, "b_dt_bias": b_dt_bias,
            "b_head_norm": b_head_norm, "w_out_ab": w_out_ab,
            "w_in_c": w_in_c, "c_forget_bias": c_forget_bias, "w_out_c": w_out_c}


def reference(x, positions, pre_norm, post_norm, w_in_ab, a_lambda_q1, a_lambda_k1, a_lambda_q2,
              a_lambda_k2, a_subln, b_conv_w, b_a_log, b_dt_bias, b_head_norm, w_out_ab,
              w_in_c, c_forget_bias, w_out_c):
    for layer in range(DEPTH):
        h = rmsnorm(x, pre_norm[layer])
        if layer % 2 == 0:
            y = mixer_ab(h, positions, layer, w_in_ab, a_lambda_q1, a_lambda_k1, a_lambda_q2,
                         a_lambda_k2, a_subln, b_conv_w, b_a_log, b_dt_bias, b_head_norm, w_out_ab)
        else:
            y = mixer_c(h, w_in_c, c_forget_bias, w_out_c)
        x = x + rmsnorm(y, post_norm[layer])
    return x
```

```cpp
#include <hip/hip_runtime.h>
#include <cstdio>
#include <cstdint>
namespace pg8 {
#define PG8_LAS __attribute__((address_space(3)))
typedef unsigned short bf16_t;
typedef short bf16x8 __attribute__((ext_vector_type(8)));
typedef float f32x4 __attribute__((ext_vector_type(4)));
typedef unsigned u32x4 __attribute__((ext_vector_type(4)));
constexpr int BM = 256, BK = 64, HALF = 128, HTB = HALF * BK * 2  , STAGE_BYTES = 8 * HTB, NXCD = 8, WGM = 8;

__host__ __device__ __forceinline__ int lds_byte(int r, int c) { const int st = (r >> 4) * 2 + (c >> 5), rr = r & 15, cc = c & 31, ob = rr * 64 + cc * 2; return st * 1024 + (ob ^ (((ob >> 9) & 1) << 5)); }
__host__ __device__ __forceinline__ void stage_rc(int b, int& R, int& C) { const int st = b / 1024, sb = b % 1024, swz = sb ^ (((sb >> 9) & 1) << 5); R = (st >> 1) * 16 + swz / 64; C = (st & 1) * 32 + (swz % 64) / 2; }
__host__ __device__ __forceinline__ int perm32(int rho) { const int n = rho >> 4, i = rho & 15; return 8 * (i >> 2) + 4 * n + (i & 3); }

struct Unit { int pm, pn; };
struct Gemm { const bf16_t* A; const bf16_t* Bt; int M, N, K; };

struct StaticOrder {
    int nM, nN, nwg, G, c;
    __host__ __device__ void init(int M, int N, int G_, int c_) { nM = M / BM; nN = N / BM; nwg = nM * nN; G = G_; c = c_; }
    __host__ __device__ bool next(int i, Unit& u) const {
        const long L = (long)i * G + c; if (L >= nwg) return false;
        int wgid = (int)L; { const int q = nwg / NXCD, r = nwg % NXCD, xcd = wgid % NXCD, off = wgid / NXCD; wgid = (xcd < r ? xcd * (q + 1) : r * (q + 1) + (xcd - r) * q) + off; }
        const int nig = WGM * nN, gid = wgid / nig, fm = gid * WGM, gsz = (nM - fm) < WGM ? (nM - fm) : WGM;
        u.pm = fm + ((wgid % nig) % gsz); u.pn = (wgid % nig) / gsz; return true;
    }
    __device__ __forceinline__ void a_ready(const Unit&) const {}
    __device__ __forceinline__ void done(const Unit&) const {}
};

__device__ __forceinline__ unsigned cvt_pk_bf16(float lo, float hi) { unsigned r; asm volatile("v_cvt_pk_bf16_f32 %0, %1, %2" : "=v"(r) : "v"(lo), "v"(hi)); return r; }
typedef float f32x2 __attribute__((ext_vector_type(2)));
__device__ __forceinline__ f32x2 gelu_pk(f32x2 v) {
    const f32x2 av = __builtin_elementwise_abs(v), d = av * 0.2316418882f + 1.0f;
    f32x2 t; t.x = __builtin_amdgcn_rcpf(d.x); t.y = __builtin_amdgcn_rcpf(d.y);
    f32x2 q = t * 0.5307027145f + (-0.7265760135f); q = q * t + 0.7107068705f; q = q * t + (-0.142248368f); q = q * t + 0.127414796f; q = q * t;
    const f32x2 s = (v * v) * (-0.72134752044f);
    f32x2 e; e.x = __builtin_amdgcn_exp2f(s.x); e.y = __builtin_amdgcn_exp2f(s.y);
    const f32x2 m = v * (q * e), r = v - m;
    f32x2 o; o.x = v.x < 0.f ? m.x : r.x; o.y = v.y < 0.f ? m.y : r.y; return o;
}

template <int ACT  > struct EpiBf16 {
    static constexpr bool PERM = true, AFTER_DRAIN = false; static_assert(ACT == 0 || ACT == 1, "EpiBf16: ACT is 0 (none) or 1 (gelu_pk)");
    bf16_t* O; int ldc; const float* bias; int split_cols; size_t split_stride; float scale0;
    __device__ __forceinline__ void operator()(const f32x4 (&acc)[2][2][4][2], const Unit& u, int wr, int wc, int fr, int fq) const {
        const int row0 = u.pm * BM + wr * 64 + fr; int colt = u.pn * BM; bf16_t* base = O;
        float sc = 1.f; if (split_cols) { const int t = colt / split_cols; base += (size_t)t * split_stride; colt -= t * split_cols; if (t == 0) sc = scale0; }
        const int col0 = colt + wc * 32 + 8 * fq, bcol0 = u.pn * BM + wc * 32 + 8 * fq;
        f32x4 bv[2][2];
#pragma unroll
        for (int bj = 0; bj < 2; ++bj)
#pragma unroll
            for (int n = 0; n < 2; ++n) bv[bj][n] = bias ? *(const f32x4*)(bias + bcol0 + bj * HALF + 4 * n) : (f32x4){0.f, 0.f, 0.f, 0.f};
#pragma unroll
        for (int ai = 0; ai < 2; ++ai)
#pragma unroll
            for (int m = 0; m < 4; ++m) { bf16_t* rowp = base + (size_t)(row0 + ai * HALF + m * 16) * ldc + col0;
#pragma unroll
                for (int bj = 0; bj < 2; ++bj) { f32x4 v0 = acc[ai][bj][m][0] + bv[bj][0], v1 = acc[ai][bj][m][1] + bv[bj][1];
                    if (ACT == 1) { f32x2 a = gelu_pk((f32x2){v0[0], v0[1]}), b = gelu_pk((f32x2){v0[2], v0[3]}), c = gelu_pk((f32x2){v1[0], v1[1]}), d = gelu_pk((f32x2){v1[2], v1[3]});
                        v0 = (f32x4){a.x, a.y, b.x, b.y}; v1 = (f32x4){c.x, c.y, d.x, d.y}; }
                    v0 = v0 * sc; v1 = v1 * sc; u32x4 w; w.x = cvt_pk_bf16(v0[0], v0[1]); w.y = cvt_pk_bf16(v0[2], v0[3]); w.z = cvt_pk_bf16(v1[0], v1[1]); w.w = cvt_pk_bf16(v1[2], v1[3]);
                    *(u32x4*)(rowp + bj * HALF) = w; } }
    }
};
template <class Epi, class Sched, bool ALIGN_EPI = false, bool SP2 = false>
__device__ __forceinline__ void gemm_phase(PG8_LAS unsigned char* lds, const Gemm g, const Sched& S, const Epi& E) {
    int tid_ = threadIdx.x; asm volatile("" : "+v"(tid_)); const int tid = tid_, wid = __builtin_amdgcn_readfirstlane(tid >> 6), lane = tid & 63, wr = wid >> 2, wc = wid & 3, fr = lane & 15, fq = lane >> 4;
    const int K = g.K, nt = K / BK;
    unsigned voffA[2], voffB[2];
#pragma unroll
    for (int i = 0; i < 2; ++i) { int R, C; stage_rc(tid * 16 + i * 8192, R, C); const int Rb = Epi::PERM ? ((R & ~31) + perm32(R & 31)) : R;
        voffA[i] = (unsigned)(R * K + C) * 2u; voffB[i] = (unsigned)(Rb * K + C) * 2u; }
    const size_t kstep = (size_t)(BK * 2);
    const size_t hstep = (size_t)HALF * K * 2;
    const size_t tstep = 2 * hstep;
    const unsigned ldsw = (unsigned)wid * 1024u;
    const int aoff = lds_byte(wr * 64 + fr, fq * 8), boff = lds_byte(wc * 32 + fr, fq * 8);
#define PG8_SA(b, h) (((b) * 2 + (h)) * HTB)
#define PG8_SB(b, h) ((4 + (b) * 2 + (h)) * HTB)
#define PG8_STAGE(bufoff, gbase, voff) do { _Pragma("unroll") for (int _i = 0; _i < 2; ++_i) \
        __builtin_amdgcn_global_load_lds((const unsigned*)((const char*)(gbase) + (voff)[_i]), (PG8_LAS unsigned*)(lds + (bufoff) + ldsw + _i * 8192), 16, 0, 0); } while (0)
#define PG8_LDA(dst, b, h) do { _Pragma("unroll") for (int m = 0; m < 4; ++m) _Pragma("unroll") for (int k = 0; k < 2; ++k) dst[m][k] = *(const PG8_LAS bf16x8*)(lds + PG8_SA(b, h) + aoff + m * 2048 + k * 1024); } while (0)
#define PG8_LDB(dst, b, h) do { _Pragma("unroll") for (int n = 0; n < 2; ++n) _Pragma("unroll") for (int k = 0; k < 2; ++k) dst[n][k] = *(const PG8_LAS bf16x8*)(lds + PG8_SB(b, h) + boff + n * 2048 + k * 1024); } while (0)
#define PG8_MMA(ai, bj, At, Bt) do { __builtin_amdgcn_s_setprio(1); _Pragma("unroll") for (int m = 0; m < 4; ++m) _Pragma("unroll") for (int n = 0; n < 2; ++n) _Pragma("unroll") for (int k = 0; k < 2; ++k) \
        acc[ai][bj][m][n] = __builtin_amdgcn_mfma_f32_16x16x32_bf16(Bt[n][k], At[m][k], acc[ai][bj][m][n], 0, 0, 0); __builtin_amdgcn_s_setprio(0); } while (0)
#define PG8_WAIT_V(n) asm volatile("s_waitcnt vmcnt(" #n ")" ::: "memory")
#define PG8_WAIT_L(n) asm volatile("s_waitcnt lgkmcnt(" #n ")" ::: "memory")
#define PG8_BAR __builtin_amdgcn_s_barrier()
#define PG8_SCHED __builtin_amdgcn_sched_barrier(0)
    Unit cur, nxt; int ui = 0;
    if (!S.next(0, cur)) return;
    f32x4 acc[2][2][4][2];
#pragma unroll
    for (int a = 0; a < 2; ++a)
#pragma unroll
        for (int b = 0; b < 2; ++b)
#pragma unroll
            for (int m = 0; m < 4; ++m)
#pragma unroll
                for (int n = 0; n < 2; ++n) acc[a][b][m][n] = (f32x4){0.f, 0.f, 0.f, 0.f};
    bf16x8 At[4][2], B0[2][2], B1[2][2];
    const char* cA = (const char*)g.A + (size_t)cur.pm * tstep; const char* cB = (const char*)g.Bt + (size_t)cur.pn * tstep;
    S.a_ready(cur);
    if constexpr (SP2) {
        PG8_STAGE(PG8_SB(0, 0), cB, voffB); PG8_STAGE(PG8_SB(0, 1), cB + hstep, voffB); PG8_STAGE(PG8_SA(0, 0), cA, voffA); PG8_STAGE(PG8_SA(0, 1), cA + hstep, voffA);
        if (wr == 1) PG8_BAR;
        PG8_WAIT_V(2); PG8_BAR;
        PG8_STAGE(PG8_SB(1, 0), cB + kstep, voffB); PG8_STAGE(PG8_SA(1, 0), cA + kstep, voffA); PG8_STAGE(PG8_SB(1, 1), cB + hstep + kstep, voffB);
        PG8_WAIT_V(6); PG8_BAR;
    } else {
        PG8_STAGE(PG8_SB(0, 0), cB, voffB); PG8_STAGE(PG8_SA(0, 0), cA, voffA); PG8_STAGE(PG8_SB(0, 1), cB + hstep, voffB); PG8_STAGE(PG8_SA(0, 1), cA + hstep, voffA);
        if (wr == 1) PG8_BAR;
        PG8_WAIT_V(4); PG8_BAR;
        PG8_STAGE(PG8_SB(1, 0), cB + kstep, voffB); PG8_STAGE(PG8_SA(1, 0), cA + kstep, voffA); PG8_STAGE(PG8_SB(1, 1), cB + hstep + kstep, voffB);
        PG8_WAIT_V(6); PG8_BAR;
    }
    for (;;) {
        const bool has_next = S.next(ui + 1, nxt);
        const char* nA = has_next ? (const char*)g.A + (size_t)nxt.pm * tstep : cA; const char* nB = has_next ? (const char*)g.Bt + (size_t)nxt.pn * tstep : cB;
        for (int t = 0; t < nt; t += 2) {
            const bool last = (t == nt - 2);
            const char* a1 = cA + (size_t)(t + 1) * kstep;
            const char* a2 = last ? nA : cA + (size_t)(t + 2) * kstep; const char* b2 = last ? nB : cB + (size_t)(t + 2) * kstep;
            const char* a3 = a2 + kstep; const char* b3 = b2 + kstep;
            if (last && has_next) S.a_ready(nxt);
            if constexpr (SP2) {
            PG8_LDB(B0, 0, 0); PG8_LDB(B1, 0, 1); PG8_SCHED; PG8_LDA(At, 0, 0); PG8_STAGE(PG8_SA(1, 1), a1 + hstep, voffA);
            PG8_WAIT_V(8); PG8_WAIT_L(0); PG8_BAR; PG8_MMA(0, 0, At, B0); PG8_MMA(0, 1, At, B1); PG8_BAR; PG8_SCHED;
            PG8_LDA(At, 0, 1); PG8_STAGE(PG8_SB(0, 0), b2, voffB); PG8_STAGE(PG8_SB(0, 1), b2 + hstep, voffB); PG8_STAGE(PG8_SA(0, 0), a2, voffA);
            PG8_WAIT_V(8); PG8_WAIT_L(0); PG8_BAR; PG8_MMA(1, 0, At, B0); PG8_MMA(1, 1, At, B1); PG8_BAR; PG8_SCHED;
            PG8_LDB(B0, 1, 0); PG8_LDB(B1, 1, 1); PG8_SCHED; PG8_LDA(At, 1, 0); PG8_STAGE(PG8_SA(0, 1), a2 + hstep, voffA);
            PG8_WAIT_V(8); PG8_WAIT_L(0); PG8_BAR; PG8_MMA(0, 0, At, B0); PG8_MMA(0, 1, At, B1); PG8_BAR; PG8_SCHED;
            PG8_LDA(At, 1, 1); PG8_STAGE(PG8_SB(1, 0), b3, voffB); PG8_STAGE(PG8_SB(1, 1), b3 + hstep, voffB); PG8_STAGE(PG8_SA(1, 0), a3, voffA);
            PG8_WAIT_V(8); PG8_WAIT_L(0); PG8_BAR; PG8_MMA(1, 0, At, B0); PG8_MMA(1, 1, At, B1); PG8_BAR; PG8_SCHED;
            } else {
            PG8_LDB(B0, 0, 0); PG8_SCHED; PG8_LDA(At, 0, 0); PG8_STAGE(PG8_SA(1, 1), a1 + hstep, voffA);
            PG8_WAIT_L(8); PG8_BAR; PG8_WAIT_L(0); PG8_MMA(0, 0, At, B0); PG8_BAR; PG8_SCHED;
            PG8_LDB(B1, 0, 1); PG8_STAGE(PG8_SB(0, 0), b2, voffB);
            PG8_BAR; PG8_WAIT_L(0); PG8_MMA(0, 1, At, B1); PG8_BAR;
            PG8_LDA(At, 0, 1); PG8_STAGE(PG8_SA(0, 0), a2, voffA);
            PG8_BAR; PG8_WAIT_L(0); PG8_MMA(1, 0, At, B0); PG8_BAR; PG8_SCHED;
            PG8_STAGE(PG8_SB(0, 1), b2 + hstep, voffB);
            PG8_WAIT_V(6); PG8_BAR; PG8_MMA(1, 1, At, B1); PG8_BAR;
            PG8_LDB(B0, 1, 0); PG8_SCHED; PG8_LDA(At, 1, 0); PG8_STAGE(PG8_SA(0, 1), a2 + hstep, voffA);
            PG8_WAIT_L(8); PG8_BAR; PG8_WAIT_L(0); PG8_MMA(0, 0, At, B0); PG8_BAR; PG8_SCHED;
            PG8_LDB(B1, 1, 1); PG8_STAGE(PG8_SB(1, 0), b3, voffB);
            PG8_BAR; PG8_WAIT_L(0); PG8_MMA(0, 1, At, B1); PG8_BAR;
            PG8_LDA(At, 1, 1); PG8_STAGE(PG8_SA(1, 0), a3, voffA);
            PG8_BAR; PG8_WAIT_L(0); PG8_MMA(1, 0, At, B0); PG8_BAR; PG8_SCHED;
            PG8_STAGE(PG8_SB(1, 1), b3 + hstep, voffB);
            PG8_WAIT_V(6); PG8_BAR; PG8_MMA(1, 1, At, B1); PG8_BAR;
            }
        }
        if constexpr (ALIGN_EPI) { if (wr == 0) PG8_BAR; }
        if constexpr (!Epi::AFTER_DRAIN) { E(acc, cur, wr, wc, fr, fq); S.done(cur); }
        if (!has_next) break;
#pragma unroll
        for (int a = 0; a < 2; ++a)
#pragma unroll
            for (int b = 0; b < 2; ++b)
#pragma unroll
                for (int m = 0; m < 4; ++m)
#pragma unroll
                    for (int n = 0; n < 2; ++n) acc[a][b][m][n] = (f32x4){0.f, 0.f, 0.f, 0.f};
        cur = nxt; cA = nA; cB = nB; ++ui;
        if constexpr (ALIGN_EPI) { if (wr == 1) PG8_BAR; }
    }
    PG8_WAIT_V(0);
    if constexpr (!ALIGN_EPI) { if (wr == 0) PG8_BAR; }
    PG8_BAR;
    if constexpr (Epi::AFTER_DRAIN) { E.fused(acc, cur, wr, wc, fr, fq, lds, wid, lane); S.done(cur); }
#undef PG8_SA
#undef PG8_SB
#undef PG8_STAGE
#undef PG8_LDA
#undef PG8_LDB
#undef PG8_MMA
#undef PG8_WAIT_V
#undef PG8_WAIT_L
#undef PG8_BAR
#undef PG8_SCHED
}
}

#ifndef PG8_SP2
#define PG8_SP2 true
#endif
#ifndef PG8_ALIGN
#define PG8_ALIGN true
#endif
#include <hip/hip_bf16.h>
#include <cmath>
namespace attn_body {
using bf16=__hip_bfloat16;
using bf16x8=__attribute__((ext_vector_type(8)))short;
using s16x4=__attribute__((ext_vector_type(4)))short;
using f32x16=__attribute__((ext_vector_type(16)))float;
using u32x4=__attribute__((ext_vector_type(4)))unsigned;
using f32x4_t=__attribute__((ext_vector_type(4)))float;
constexpr int BATCH=32,NHEAD=16,SEQ=2048,D=64,DM=NHEAD*D;
constexpr int NW=8,QBLK=32,QB=QBLK*NW,KVBLK=64,NQB=SEQ/QB;
constexpr int ATTN_PITCH=DM, ATTN_UNIT_ROWS=QB;
__device__ __forceinline__ int crow(int r,int hi){return (r&3)+8*(r>>2)+4*hi;}
#define SBAR() __builtin_amdgcn_sched_barrier(0)
__device__ __forceinline__ void cmask(f32x16&p0,f32x16&p1,int jb,int qrel,int hi){
  const float NEG=-INFINITY; int kb=64*jb+4*hi;
  #pragma unroll
  for(int r=0;r<16;++r){int kv=kb+(r&3)+8*(r>>2); if(kv>qrel)p0[r]=NEG; if(kv+32>qrel)p1[r]=NEG;}
}

constexpr int NSLOT=3, SLOTB=8192;
constexpr int LDS_K=0, LDS_V=NSLOT*SLOTB, LDS_WS=2*NSLOT*SLOTB, LDS_OST=LDS_WS+NW*64*4, LDS_BIAS=LDS_OST+NW*4096, LDS_BYTES=LDS_BIAS+SEQ*4;
constexpr float C2=0.125f*1.4426950408889634f;
__device__ __forceinline__ void glds16(const void*gsrc,unsigned lds_dst){unsigned keep;
  asm volatile("s_mov_b32 %0, m0\n\ts_mov_b32 m0, %2\n\ts_nop 0\n\tglobal_load_lds_dwordx4 %1, off\n\ts_mov_b32 m0, %0":"=&s"(keep):"v"(gsrc),"s"(lds_dst):"memory");}
__device__ __forceinline__ float max3f(float a,float b,float c){float r;asm("v_max3_f32 %0, %1, %2, %3":"=v"(r):"v"(a),"v"(b),"v"(c));return r;}
__device__ __forceinline__ float max2f(float a,float b){float r;asm("v_max_f32_e32 %0, %1, %2":"=v"(r):"v"(a),"v"(b));return r;}
__device__ __forceinline__ float fadd_s(float a,float b){float r;asm("v_add_f32_e32 %0, %1, %2":"=v"(r):"v"(a),"v"(b));return r;}
__device__ __forceinline__ float fsub_s(float a,float b){float r;asm("v_sub_f32_e32 %0, %1, %2":"=v"(r):"v"(a),"v"(b));return r;}
typedef float f32x2_t __attribute__((ext_vector_type(2))); typedef __bf16 bf16x2_t __attribute__((ext_vector_type(2)));
__device__ __forceinline__ unsigned cvtpk_s(float lo,float hi){f32x2_t v={lo,hi};bf16x2_t b=__builtin_convertvector(v,bf16x2_t);return __builtin_bit_cast(unsigned,b);}
#define WAIT_BAR(N) asm volatile("s_waitcnt vmcnt(" #N ") lgkmcnt(0)\n\ts_barrier":::"memory")

__device__ __forceinline__ void qkt(f32x16&p0,f32x16&p1,const char*Kslot,const bf16x8*qr,const f32x16&negm0,const f32x16&negm1,int r32,int hi){
  const char*kb=Kslot+hi*1024+r32*16;
  #pragma unroll
  for(int d0=0;d0<4;++d0){
    const bf16x8 b0=*reinterpret_cast<const bf16x8*>(kb+d0*2048);
    const bf16x8 b1=*reinterpret_cast<const bf16x8*>(kb+d0*2048+512);
    if(d0==0){p0=__builtin_amdgcn_mfma_f32_32x32x16_bf16(b0,qr[0],negm0,0,0,0);p1=__builtin_amdgcn_mfma_f32_32x32x16_bf16(b1,qr[0],negm1,0,0,0);}
    else{p0=__builtin_amdgcn_mfma_f32_32x32x16_bf16(b0,qr[d0],p0,0,0,0);p1=__builtin_amdgcn_mfma_f32_32x32x16_bf16(b1,qr[d0],p1,0,0,0);}}
}
typedef __attribute__((address_space(3))) const char* lds_cptr;
typedef short v4i16_t __attribute__((ext_vector_type(4)));
__device__ __forceinline__ void kload8(bf16x8*kf,lds_cptr kp){
  kf[0]=*(const __attribute__((address_space(3))) bf16x8*)(kp);      kf[1]=*(const __attribute__((address_space(3))) bf16x8*)(kp+512);
  kf[2]=*(const __attribute__((address_space(3))) bf16x8*)(kp+2048); kf[3]=*(const __attribute__((address_space(3))) bf16x8*)(kp+2560);
  kf[4]=*(const __attribute__((address_space(3))) bf16x8*)(kp+4096); kf[5]=*(const __attribute__((address_space(3))) bf16x8*)(kp+4608);
  kf[6]=*(const __attribute__((address_space(3))) bf16x8*)(kp+6144); kf[7]=*(const __attribute__((address_space(3))) bf16x8*)(kp+6656);
}
__device__ __forceinline__ void kload2(bf16x8*kf,lds_cptr kp,int j){ kf[2*j]=*(const __attribute__((address_space(3))) bf16x8*)(kp+j*2048); kf[2*j+1]=*(const __attribute__((address_space(3))) bf16x8*)(kp+j*2048+512); }
__device__ __forceinline__ s16x4 vtr(lds_cptr p){ return __builtin_bit_cast(s16x4,__builtin_amdgcn_ds_read_tr16_b64_v4i16((__attribute__((address_space(3))) v4i16_t*)p)); }
__device__ __forceinline__ float rowmax(const f32x16&p0,const f32x16&p1){
  float a=max3f(p0[0],p0[1],p1[0]),b=max3f(p0[2],p0[3],p1[1]);a=max3f(a,p1[2],p1[3]);
  #pragma unroll
  for(int r=4;r<16;r+=4){a=max3f(a,p0[r],p0[r+1]);b=max3f(b,p0[r+2],p0[r+3]);a=max3f(a,p1[r],p1[r+1]);b=max3f(b,p1[r+2],p1[r+3]);}
  const float m=max2f(a,b);
  auto rr=__builtin_amdgcn_permlane32_swap(__float_as_uint(m),__float_as_uint(m),false,false);
  return max2f(__uint_as_float(rr[0]),__uint_as_float(rr[1]));
}
__device__ __forceinline__ void pv(f32x16*o,int vb,bf16x8 pa0,bf16x8 pa1,bf16x8 pa2,bf16x8 pa3){
  #pragma unroll
  for(int d0=0;d0<2;++d0){s16x4 lo[4],hi[4];
    #pragma unroll
    for(int ks=0;ks<4;++ks){
      asm volatile("ds_read_b64_tr_b16 %0,%1 offset:%c2":"=&v"(lo[ks]):"v"(vb),"i"(d0*4096+ks*1024):"memory");
      asm volatile("ds_read_b64_tr_b16 %0,%1 offset:%c2":"=&v"(hi[ks]):"v"(vb),"i"(d0*4096+ks*1024+512):"memory");}
    asm volatile("s_waitcnt lgkmcnt(0)":::"memory");SBAR();
    #define PK(k) (bf16x8){lo[k][0],lo[k][1],lo[k][2],lo[k][3],hi[k][0],hi[k][1],hi[k][2],hi[k][3]}
    o[d0]=__builtin_amdgcn_mfma_f32_32x32x16_bf16(pa0,PK(0),o[d0],0,0,0);
    o[d0]=__builtin_amdgcn_mfma_f32_32x32x16_bf16(pa1,PK(1),o[d0],0,0,0);
    o[d0]=__builtin_amdgcn_mfma_f32_32x32x16_bf16(pa2,PK(2),o[d0],0,0,0);
    o[d0]=__builtin_amdgcn_mfma_f32_32x32x16_bf16(pa3,PK(3),o[d0],0,0,0);
    #undef PK
  }
}

#ifndef ATTN_STORE16
#define ATTN_STORE16(p,v) (*(u32x4*)(p)=(v))
#endif
template<int THRL,bool BIAS> __device__ __forceinline__ void attn_unit(int b,int qb,const bf16*Q,const bf16*__restrict__ K,const bf16*__restrict__ V,bf16*O,const float*__restrict__ cum,const bf16*__restrict__ Zg,char*shm){
  int tid_=threadIdx.x; asm volatile("":"+v"(tid_)); const int tid=tid_,lane=tid&63,r32=lane&31,hi=lane>>5; const int wid=__builtin_amdgcn_readfirstlane(tid>>6);
  const long rowbase=(long)b*SEQ; const int q0=qb*QB;
  const bf16*Qw=Q+(rowbase+q0+wid*QBLK)*DM;
  const bf16*Kh=K+rowbase*DM,*Vh=V+rowbase*DM;
  const unsigned lds0=(unsigned)(uintptr_t)shm;
  float*wsf=(float*)(shm+LDS_WS)+wid*64;
  const bf16*ksrc=Kh+(long)lane*DM+wid*8;
  const bf16*vsrc=Vh+(long)(16*(wid&3)+(lane>>2))*DM+(wid>>2)*32+(lane&3)*8;
  const unsigned kdst=lds0+LDS_K+wid*1024, vdst=lds0+LDS_V+wid*1024;
  #define DMA_K(t,slot) glds16(ksrc+(long)(t)*KVBLK*DM,(unsigned)__builtin_amdgcn_readfirstlane(kdst+(slot)))
  #define DMA_V(t,slot) glds16(vsrc+(long)(t)*KVBLK*DM,(unsigned)__builtin_amdgcn_readfirstlane(vdst+(slot)))
  const int vb0=(int)(lds0+LDS_V)+((lane>>4)&1)*32+(lane&3)*8+(4*hi+((lane&15)>>2))*64;
  const char*Kbase=shm+LDS_K; bf16x8 kf[8];
  const lds_cptr shm3=(lds_cptr)shm; const lds_cptr kp0=shm3+LDS_K+hi*1024+r32*16; const lds_cptr vp0=shm3+LDS_V+((lane>>4)&1)*32+(lane&3)*8+(4*hi+((lane&15)>>2))*64;
  const int NT=(q0+QB)/KVBLK;
  const __attribute__((address_space(3))) float* biasl=(const __attribute__((address_space(3))) float*)((lds_cptr)shm+LDS_BIAS);
  float bv_[4]={0.f,0.f,0.f,0.f}; float cref=0.f;
  if(BIAS){ const int nb=q0+QB; cref=cum[q0];
    _Pragma("unroll") for(int j=0;j<4;++j){const int idx=tid+512*j; bv_[j]=(idx<nb)?cum[idx]:0.f;}
    if(tid<QB){ (void)*(volatile const unsigned*)(Zg+(rowbase+q0+tid)*DM); } }
  DMA_K(0,0);DMA_V(0,0);DMA_K(1,SLOTB);
  bf16x8 qr[4];
  #pragma unroll
  for(int d0=0;d0<4;++d0)qr[d0]=*reinterpret_cast<const bf16x8*>(&Qw[(long)r32*DM+d0*16+hi*8]);
  float mhat=0.f,l_reg=0.f;f32x16 o[2];o[0]=f32x16{};o[1]=f32x16{};f32x16 negm=f32x16{};if(!BIAS){asm volatile("":"+v"(negm));}
  const int qrel=wid*QBLK+r32;
  #define CMASK(P0,P1,t) do{int jb_=(t)-(NT-4); if(jb_>=0)cmask(P0,P1,jb_,qrel,hi);}while(0)
  bool resc=false;
  #define START(P0,P1) do{ const float rm=rowmax(P0,P1); resc=false; \
    { const float dl=rm; mhat=fadd_s(mhat,dl); \
      _Pragma("unroll") for(int r=0;r<16;++r){P0[r]=fsub_s(P0[r],dl);P1[r]=fsub_s(P1[r],dl);} \
      if(!BIAS){ _Pragma("unroll") for(int r=0;r<16;++r)negm[r]=-mhat; asm volatile("":"+v"(negm)); } } \
    _Pragma("unroll") for(int r=0;r<16;++r)P0[r]=__builtin_amdgcn_exp2f(P0[r]); }while(0)
  #define RESC() do{ if(resc){ asm volatile("s_waitcnt lgkmcnt(0)":::"memory"); \
      _Pragma("unroll") for(int d_=0;d_<2;++d_) _Pragma("unroll") for(int r=0;r<16;++r)o[d_][r]*=wsf[crow(r,hi)]; } }while(0)
  f32x16 pA0,pA1,pB0,pB1;
  int sl_prev=0,sl_cur=0,sl_next=SLOTB;
  #define ROT() do{sl_prev=sl_cur;sl_cur=sl_next;sl_next=(sl_next==(NSLOT-1)*SLOTB)?0:sl_next+SLOTB;}while(0)
  DMA_K(2,2*SLOTB);
  if(BIAS){ const int nb=q0+QB;
    _Pragma("unroll") for(int j=0;j<4;++j){const int idx=tid+512*j; if(idx<nb)((__attribute__((address_space(3))) float*)((__attribute__((address_space(3))) char*)shm+LDS_BIAS))[idx]=(cref-bv_[j])*1.4426950408889634f;} }
  WAIT_BAR(3);
  f32x16 bi0=f32x16{},bi1=f32x16{};
  if(BIAS){ _Pragma("unroll") for(int g_=0;g_<4;++g_){ const f32x4_t a_=*(const __attribute__((address_space(3))) f32x4_t*)(biasl+8*g_+4*hi); const f32x4_t b_=*(const __attribute__((address_space(3))) f32x4_t*)(biasl+32+8*g_+4*hi);
      _Pragma("unroll") for(int i_=0;i_<4;++i_){bi0[4*g_+i_]=a_[i_];bi1[4*g_+i_]=b_[i_];} } }
  qkt(pA0,pA1,Kbase,qr,bi0,bi1,r32,hi);asm volatile("s_nop 15\n\ts_nop 7":"+v"(pA0),"+v"(pA1));CMASK(pA0,pA1,0);
  START(pA0,pA1);
  _Pragma("unroll") for(int r=0;r<16;++r)pA1[r]=__builtin_amdgcn_exp2f(pA1[r]);
  if(BIAS){ const __attribute__((address_space(3))) float* bt_=biasl+64+4*hi;
    _Pragma("unroll") for(int g_=0;g_<4;++g_){ const f32x4_t a_=*(const __attribute__((address_space(3))) f32x4_t*)(bt_+8*g_); const f32x4_t b_=*(const __attribute__((address_space(3))) f32x4_t*)(bt_+32+8*g_);
      _Pragma("unroll") for(int i_=0;i_<4;++i_){pB0[4*g_+i_]=a_[i_]-mhat;pB1[4*g_+i_]=b_[i_]-mhat;} } }
  WAIT_BAR(0);
  DMA_K(3,0);DMA_V(1,SLOTB);
  ROT();
  kload8(kf,kp0+sl_cur);
  WAIT_BAR(2);
  s16x4 vlo[8],vhi[8]; u32x4 pw0,pw1,pw2,pw3;
  #define PKW(P,B) cvtpk_s(P[B],P[B+1])
  #define PAF(k) __builtin_bit_cast(bf16x8,pw##k)
  #define VFR(i) (bf16x8){vlo[i][0],vlo[i][1],vlo[i][2],vlo[i][3],vhi[i][0],vhi[i][1],vhi[i][2],vhi[i][3]}
  #define PIN(x) asm volatile("":"+v"(x))
  #define MX3(a,b,c) __builtin_fmaxf(__builtin_fmaxf((a),(b)),(c))
  #define GAPA(MF,A0,A1,A2,A3,W0,W1,PW) do{ MF; sacc+=A0; sacc+=A1; sacc+=A2; sacc+=A3; PIN(sacc); W0; W1; PIN(PW); SBAR(); }while(0)
  #define EX(v) __builtin_amdgcn_exp2f(v)
  #define GAPB(MF,X,B) do{ MF; X[B]=EX(X[B]); X[B+1]=EX(X[B+1]); X[B+2]=EX(X[B+2]); X[B+3]=EX(X[B+3]); PIN(X); SBAR(); }while(0)
  #define BGAP(X,B,NXT) do{ if(BIAS){ bw_=*(const __attribute__((address_space(3))) f32x4_t*)(bn_+(NXT)); X[B]=bq_[0]-mhat; X[(B)+1]=bq_[1]-mhat; X[(B)+2]=bq_[2]-mhat; X[(B)+3]=bq_[3]-mhat; bq_=bw_; } }while(0)
  #define VRD(i) do{ vlo[i]=vtr(vp_+(((i)>>2)*4096+((i)&3)*1024)); vhi[i]=vtr(vp_+(((i)>>2)*4096+((i)&3)*1024+512)); }while(0)
  #define KRD(G,j) do{ if(G){ kload2(kf,kp0+sl_next,j); SBAR(); } }while(0)
  #define STEP(C0,C1,P0,P1,t,GK,GV,GL) do{ SBAR(); \
    const lds_cptr vp_=vp0+sl_prev; \
    VRD(0); SBAR(); float sacc=(P0[0]+P0[1]); \
    GAPA(C0=__builtin_amdgcn_mfma_f32_32x32x16_bf16(kf[0],qr[0],(BIAS?C0:negm),0,0,0), P0[2],P0[3],P0[4],P0[5],     pw0[0]=PKW(P0,0), pw0[1]=PKW(P0,2), pw0); \
    VRD(4); SBAR(); GAPA(C1=__builtin_amdgcn_mfma_f32_32x32x16_bf16(kf[1],qr[0],(BIAS?C1:negm),0,0,0), P0[6],P0[7],P0[8],P0[9],     pw0[2]=PKW(P0,4), pw0[3]=PKW(P0,6), pw0); \
    VRD(1); SBAR(); GAPA(C0=__builtin_amdgcn_mfma_f32_32x32x16_bf16(kf[2],qr[1],C0,0,0,0),   P0[10],P0[11],P0[12],P0[13], pw1[0]=PKW(P0,8), pw1[1]=PKW(P0,10), pw1); \
    VRD(5); SBAR(); GAPA(C1=__builtin_amdgcn_mfma_f32_32x32x16_bf16(kf[3],qr[1],C1,0,0,0),   P0[14],P0[15],P1[0],P1[1],   pw1[2]=PKW(P0,12),pw1[3]=PKW(P0,14), pw1); \
    VRD(2); SBAR(); GAPA(C0=__builtin_amdgcn_mfma_f32_32x32x16_bf16(kf[4],qr[2],C0,0,0,0),   P1[2],P1[3],P1[4],P1[5],     pw2[0]=PKW(P1,0), pw2[1]=PKW(P1,2), pw2); \
    VRD(6); SBAR(); GAPA(C1=__builtin_amdgcn_mfma_f32_32x32x16_bf16(kf[5],qr[2],C1,0,0,0),   P1[6],P1[7],P1[8],P1[9],     pw2[2]=PKW(P1,4), pw2[3]=PKW(P1,6), pw2); \
    VRD(3); SBAR(); GAPA(C0=__builtin_amdgcn_mfma_f32_32x32x16_bf16(kf[6],qr[3],C0,0,0,0),   P1[10],P1[11],P1[12],P1[13], pw3[0]=PKW(P1,8), pw3[1]=PKW(P1,10), pw3); \
    VRD(7); SBAR(); GAPA(C1=__builtin_amdgcn_mfma_f32_32x32x16_bf16(kf[7],qr[3],C1,0,0,0),   P1[14],P1[15],0.f,0.f,       pw3[2]=PKW(P1,12),pw3[3]=PKW(P1,14), pw3); \
    l_reg+=sacc; \
    if(GK){DMA_K((t)+3,sl_cur);} if(GV){DMA_V((t)+1,sl_next);} \
    CMASK(C0,C1,t); \
    { float a=MX3(C0[0],C0[1],C1[0]),b=MX3(C0[2],C0[3],C1[1]); a=MX3(a,C1[2],C1[3]); \
      _Pragma("unroll") for(int r=4;r<16;r+=4){a=MX3(a,C0[r],C0[r+1]);b=MX3(b,C0[r+2],C0[r+3]);a=MX3(a,C1[r],C1[r+1]);b=MX3(b,C1[r+2],C1[r+3]);} \
      float rm=__builtin_fmaxf(a,b); { auto rr=__builtin_amdgcn_permlane32_swap(__float_as_uint(rm),__float_as_uint(rm),false,false); rm=__builtin_fmaxf(__uint_as_float(rr[0]),__uint_as_float(rr[1])); } \
      resc=false; \
      if(__builtin_expect(__any(rm>(float)THRL),0)){ const float dl=__builtin_fmaxf(rm,0.f); mhat+=dl; \
        _Pragma("unroll") for(int r=0;r<16;++r){C0[r]-=dl;C1[r]-=dl;} \
        if(!BIAS){ _Pragma("unroll") for(int r=0;r<16;++r)negm[r]=-mhat; asm volatile("":"+v"(negm)); } \
        const float f=__builtin_amdgcn_exp2f(-dl); l_reg*=f; if(hi==0)wsf[r32]=f; resc=true; } } \
    SBAR(); \
    const __attribute__((address_space(3))) float* bn_=biasl+64*((t)+1)+4*hi; f32x4_t bq_=f32x4_t{},bw_=f32x4_t{}; \
    if(BIAS){ bq_=*(const __attribute__((address_space(3))) f32x4_t*)(bn_); SBAR(); } \
    BGAP(P0,0,8);  GAPB(o[0]=__builtin_amdgcn_mfma_f32_32x32x16_bf16(PAF(0),VFR(0),o[0],0,0,0), C0,0); \
    BGAP(P0,4,16); GAPB(o[1]=__builtin_amdgcn_mfma_f32_32x32x16_bf16(PAF(0),VFR(4),o[1],0,0,0), C0,4); \
    BGAP(P0,8,24); KRD(GL,0); GAPB(o[0]=__builtin_amdgcn_mfma_f32_32x32x16_bf16(PAF(1),VFR(1),o[0],0,0,0), C0,8); \
    BGAP(P0,12,32); KRD(GL,1); GAPB(o[1]=__builtin_amdgcn_mfma_f32_32x32x16_bf16(PAF(1),VFR(5),o[1],0,0,0), C0,12); \
    BGAP(P1,0,40); KRD(GL,2); GAPB(o[0]=__builtin_amdgcn_mfma_f32_32x32x16_bf16(PAF(2),VFR(2),o[0],0,0,0), C1,0); \
    BGAP(P1,4,48); KRD(GL,3); GAPB(o[1]=__builtin_amdgcn_mfma_f32_32x32x16_bf16(PAF(2),VFR(6),o[1],0,0,0), C1,4); \
    BGAP(P1,8,56); GAPB(o[0]=__builtin_amdgcn_mfma_f32_32x32x16_bf16(PAF(3),VFR(3),o[0],0,0,0), C1,8); \
    BGAP(P1,12,56); GAPB(o[1]=__builtin_amdgcn_mfma_f32_32x32x16_bf16(PAF(3),VFR(7),o[1],0,0,0), C1,12); \
    }while(0)
  int t=1;
  #undef CMASK
  #define CMASK(P0,P1,t) do{}while(0)
  for(;t+5<NT;t+=2){
    STEP(pB0,pB1,pA0,pA1,t,true,true,true);     WAIT_BAR(2); RESC(); ROT();
    STEP(pA0,pA1,pB0,pB1,t+1,true,true,true);   WAIT_BAR(2); RESC(); ROT();
  }
  #undef CMASK
  #define CMASK(P0,P1,t) do{int jb_=(t)-(NT-4); if(jb_>=0)cmask(P0,P1,jb_,qrel,hi);}while(0)
  #define ENDW(tt) do{ if((tt)+3<NT){WAIT_BAR(2);} else if((tt)+2<NT){WAIT_BAR(1);} else {WAIT_BAR(0);} }while(0)
  for(;t+1<NT;t+=2){
    STEP(pB0,pB1,pA0,pA1,t,(t+3<NT),(t+1<NT),(t+1<NT));       ENDW(t);   RESC(); ROT();
    STEP(pA0,pA1,pB0,pB1,t+1,(t+4<NT),(t+2<NT),(t+2<NT));     ENDW(t+1); RESC(); ROT();
  }
  STEP(pB0,pB1,pA0,pA1,NT-1,false,false,false); RESC();
  { float sacc=pB0[0]+pB0[1]; _Pragma("unroll") for(int r=2;r<16;++r)sacc+=pB0[r]; _Pragma("unroll") for(int r=0;r<16;++r)sacc+=pB1[r]; l_reg+=sacc;
    pw0=(u32x4){PKW(pB0,0),PKW(pB0,2),PKW(pB0,4),PKW(pB0,6)};pw1=(u32x4){PKW(pB0,8),PKW(pB0,10),PKW(pB0,12),PKW(pB0,14)};pw2=(u32x4){PKW(pB1,0),PKW(pB1,2),PKW(pB1,4),PKW(pB1,6)};pw3=(u32x4){PKW(pB1,8),PKW(pB1,10),PKW(pB1,12),PKW(pB1,14)};
    SBAR(); pv(o,vb0+sl_cur,PAF(0),PAF(1),PAF(2),PAF(3)); }
  #undef PKW
  #undef PAF
  #undef VFR
  #undef PIN
  #undef MX3
  #undef GAPA
  #undef GAPB
  #undef EX
  #undef VRD
  #undef BGAP
  #undef KRD
  #undef STEP
  #undef ENDW
  u32x4 zg_[4]; if(BIAS){ const bf16*Zw=Zg+(rowbase+q0+wid*QBLK)*DM;
    #pragma unroll
    for(int i=0;i<4;++i)zg_[i]=*(const u32x4*)(Zw+(long)(i*8+(lane>>3))*DM+(lane&7)*8); }
  {auto rr=__builtin_amdgcn_permlane32_swap(__float_as_uint(l_reg),__float_as_uint(l_reg),false,false);l_reg=__uint_as_float(rr[0])+__uint_as_float(rr[1]);}
  if(hi==0)wsf[32+r32]=l_reg;asm volatile("s_waitcnt lgkmcnt(0)":::"memory");
  float rli[16];
  #pragma unroll
  for(int r=0;r<16;++r)rli[r]=__builtin_amdgcn_rcpf(wsf[32+crow(r,hi)]);
  bf16*Ow=O+(rowbase+q0+wid*QBLK)*DM;
  { bf16*stg=(bf16*)(shm+LDS_OST)+wid*2048;
    #pragma unroll
    for(int r=0;r<16;++r){const int orow=crow(r,hi);
      #pragma unroll
      for(int d0=0;d0<2;++d0)stg[orow*64+d0*32+r32]=__float2bfloat16(o[d0][r]*rli[r]);}
    asm volatile("s_waitcnt lgkmcnt(0)":::"memory");
    #pragma unroll
    for(int i=0;i<4;++i){const int row=i*8+(lane>>3),ch=lane&7; u32x4 v=*(const u32x4*)(stg+row*64+ch*8);
      if(BIAS){ const u32x4 z=zg_[i];
        #pragma unroll
        for(int k=0;k<4;++k){ const float o0=__uint_as_float(v[k]<<16),o1=__uint_as_float(v[k]&0xffff0000u),z0=__uint_as_float(z[k]<<16),z1=__uint_as_float(z[k]&0xffff0000u);
          v[k]=cvtpk_s(o0*z0*__builtin_amdgcn_rcpf(1.f+__expf(-z0)),o1*z1*__builtin_amdgcn_rcpf(1.f+__expf(-z1))); } }
      ATTN_STORE16(Ow+(long)row*DM+ch*8,v);} }
  asm volatile("s_waitcnt lgkmcnt(0)\n\ts_barrier":::"memory");
  #undef DMA_K
  #undef DMA_V
  #undef CMASK
  #undef START
  #undef RESC
  #undef ROT
}
constexpr int LDS_V2=NSLOT*SLOTB, LDS_WS2=LDS_V2+NSLOT*2*SLOTB, LDS_OST2=LDS_WS2+NW*64*4, LDS_BYTES2=LDS_OST2+NW*8192;
template<int THRL> __device__ __forceinline__ void attn_unit128(int b,int qb,const bf16*Q,const bf16*__restrict__ K,const bf16*__restrict__ V,bf16*O,char*shm){ constexpr bool BIAS=false; const float*cum=nullptr; const bf16*Zg=nullptr; (void)cum; (void)Zg;
  int tid_=threadIdx.x; asm volatile("":"+v"(tid_)); const int tid=tid_,lane=tid&63,r32=lane&31,hi=lane>>5; const int wid=__builtin_amdgcn_readfirstlane(tid>>6);
  const long rowbase=(long)b*SEQ; const int q0=qb*QB;
  const bf16*Qw=Q+(rowbase+q0+wid*QBLK)*DM;
  const bf16*Kh=K+rowbase*DM,*Vh=V+rowbase*DM;
  const unsigned lds0=(unsigned)(uintptr_t)shm;
  float*wsf=(float*)(shm+LDS_WS2)+wid*64;
  const bf16*ksrc=Kh+(long)lane*DM+wid*8;
  const bf16*vsrc=Vh+(long)(16*(wid&3)+(lane>>2))*DM+(wid>>2)*32+(lane&3)*8;
  const unsigned kdst=lds0+LDS_K+wid*1024, vdst=lds0+LDS_V2+wid*1024;
  #define DMA_K(t,slot) glds16(ksrc+(long)(t)*KVBLK*DM,(unsigned)__builtin_amdgcn_readfirstlane(kdst+(slot)))
  #define DMA_V(t,slot) do{ glds16(vsrc+(long)(t)*KVBLK*DM,(unsigned)__builtin_amdgcn_readfirstlane(vdst+2*(slot))); glds16(vsrc+64+(long)(t)*KVBLK*DM,(unsigned)__builtin_amdgcn_readfirstlane(vdst+8192+2*(slot))); }while(0)
  const int vb0=(int)(lds0+LDS_V2)+((lane>>4)&1)*32+(lane&3)*8+(4*hi+((lane&15)>>2))*64;
  const char*Kbase=shm+LDS_K; bf16x8 kf[8];
  const lds_cptr shm3=(lds_cptr)shm; const lds_cptr kp0=shm3+LDS_K+hi*1024+r32*16; const lds_cptr vp0=shm3+LDS_V2+((lane>>4)&1)*32+(lane&3)*8+(4*hi+((lane&15)>>2))*64;
  const int NT=(q0+QB)/KVBLK;
  const __attribute__((address_space(3))) float* biasl=(const __attribute__((address_space(3))) float*)((lds_cptr)shm+LDS_BIAS);
  float bv_[4]={0.f,0.f,0.f,0.f}; float cref=0.f;
  if(BIAS){ const int nb=q0+QB; cref=cum[q0];
    _Pragma("unroll") for(int j=0;j<4;++j){const int idx=tid+512*j; bv_[j]=(idx<nb)?cum[idx]:0.f;}
    if(tid<QB){ (void)*(volatile const unsigned*)(Zg+(rowbase+q0+tid)*DM); } }
  DMA_K(0,0);DMA_V(0,0);DMA_K(1,SLOTB);
  bf16x8 qr[4];
  #pragma unroll
  for(int d0=0;d0<4;++d0)qr[d0]=*reinterpret_cast<const bf16x8*>(&Qw[(long)r32*DM+d0*16+hi*8]);
  float mhat=0.f,l_reg=0.f;f32x16 o[4];o[0]=f32x16{};o[1]=f32x16{};o[2]=f32x16{};o[3]=f32x16{};const f32x16 zc=f32x16{};
  const int qrel=wid*QBLK+r32;
  #define CMASK(P0,P1,t) do{int jb_=(t)-(NT-4); if(jb_>=0)cmask(P0,P1,jb_,qrel,hi);}while(0)
  bool resc=false;
  #define START(P0,P1) do{ const float rm=rowmax(P0,P1); resc=false; \
    { const float dl=rm; mhat=fadd_s(mhat,dl); \
      _Pragma("unroll") for(int r=0;r<16;++r){P0[r]=fsub_s(P0[r],dl);P1[r]=fsub_s(P1[r],dl);} \
      } \
    _Pragma("unroll") for(int r=0;r<16;++r)P0[r]=__builtin_amdgcn_exp2f(P0[r]); }while(0)
  #define RESC() do{ if(resc){ asm volatile("s_waitcnt lgkmcnt(0)":::"memory"); \
      _Pragma("unroll") for(int d_=0;d_<4;++d_) _Pragma("unroll") for(int r=0;r<16;++r)o[d_][r]*=wsf[crow(r,hi)]; } }while(0)
  f32x16 pA0,pA1,pB0,pB1;
  int sl_prev=0,sl_cur=0,sl_next=SLOTB;
  #define ROT() do{sl_prev=sl_cur;sl_cur=sl_next;sl_next=(sl_next==(NSLOT-1)*SLOTB)?0:sl_next+SLOTB;}while(0)
  DMA_K(2,2*SLOTB);
  if(BIAS){ const int nb=q0+QB;
    _Pragma("unroll") for(int j=0;j<4;++j){const int idx=tid+512*j; if(idx<nb)((__attribute__((address_space(3))) float*)((__attribute__((address_space(3))) char*)shm+LDS_BIAS))[idx]=(cref-bv_[j])*1.4426950408889634f;} }
  WAIT_BAR(4);
  f32x16 bi0=f32x16{},bi1=f32x16{};
  if(BIAS){ _Pragma("unroll") for(int g_=0;g_<4;++g_){ const f32x4_t a_=*(const __attribute__((address_space(3))) f32x4_t*)(biasl+8*g_+4*hi); const f32x4_t b_=*(const __attribute__((address_space(3))) f32x4_t*)(biasl+32+8*g_+4*hi);
      _Pragma("unroll") for(int i_=0;i_<4;++i_){bi0[4*g_+i_]=a_[i_];bi1[4*g_+i_]=b_[i_];} } }
  qkt(pA0,pA1,Kbase,qr,bi0,bi1,r32,hi);asm volatile("s_nop 15\n\ts_nop 7":"+v"(pA0),"+v"(pA1));CMASK(pA0,pA1,0);
  START(pA0,pA1);
  _Pragma("unroll") for(int r=0;r<16;++r)pA1[r]=__builtin_amdgcn_exp2f(pA1[r]);
  if(BIAS){ const __attribute__((address_space(3))) float* bt_=biasl+64+4*hi;
    _Pragma("unroll") for(int g_=0;g_<4;++g_){ const f32x4_t a_=*(const __attribute__((address_space(3))) f32x4_t*)(bt_+8*g_); const f32x4_t b_=*(const __attribute__((address_space(3))) f32x4_t*)(bt_+32+8*g_);
      _Pragma("unroll") for(int i_=0;i_<4;++i_){pB0[4*g_+i_]=a_[i_]-mhat;pB1[4*g_+i_]=b_[i_]-mhat;} } }
  WAIT_BAR(0);
  DMA_K(3,0);DMA_V(1,SLOTB);
  ROT();
  kload8(kf,kp0+sl_cur);
  WAIT_BAR(3);
  s16x4 vlo[4],vhi[4]; u32x4 pw0,pw1,pw2,pw3;
  #define PKW(P,B) cvtpk_s(P[B],P[B+1])
  #define PAF(k) __builtin_bit_cast(bf16x8,pw##k)
  #define VFR(i) (bf16x8){vlo[i][0],vlo[i][1],vlo[i][2],vlo[i][3],vhi[i][0],vhi[i][1],vhi[i][2],vhi[i][3]}
  #define PIN(x) asm volatile("":"+v"(x))
  #define MX3(a,b,c) __builtin_fmaxf(__builtin_fmaxf((a),(b)),(c))
  #define GAPA(MF,A0,A1,A2,A3,W0,W1,PW) do{ MF; sacc+=A0; sacc+=A1; sacc+=A2; sacc+=A3; PIN(sacc); W0; W1; PIN(PW); SBAR(); }while(0)
  #define EX(v) __builtin_amdgcn_exp2f(v)
  #define GAPB(MF,X,B) do{ MF; X[B]=EX(X[B]); X[B+1]=EX(X[B+1]); X[B+2]=EX(X[B+2]); X[B+3]=EX(X[B+3]); PIN(X); SBAR(); }while(0)
  #define BGAP(X,B,NXT) do{ if(BIAS){ bw_=*(const __attribute__((address_space(3))) f32x4_t*)(bn_+(NXT)); X[B]=bq_[0]-mhat; X[(B)+1]=bq_[1]-mhat; X[(B)+2]=bq_[2]-mhat; X[(B)+3]=bq_[3]-mhat; bq_=bw_; } }while(0)
  #define GAPB2(MF,X,B) do{ MF; X[B]=EX(X[B]); X[(B)+1]=EX(X[(B)+1]); PIN(X); SBAR(); }while(0)
  #define VLD(sl_,i) do{ vlo[sl_]=vtr(vp_+(((i)>>2)*4096+((i)&3)*1024)); vhi[sl_]=vtr(vp_+(((i)>>2)*4096+((i)&3)*1024+512)); }while(0)
  #define VFRS(i) (bf16x8){vlo[i][0],vlo[i][1],vlo[i][2],vlo[i][3],vhi[i][0],vhi[i][1],vhi[i][2],vhi[i][3]}
  #define VRD2(i) do{ vlo[i]=vtr(vp_+(8192+((i)>>2)*4096+((i)&3)*1024)); vhi[i]=vtr(vp_+(8192+((i)>>2)*4096+((i)&3)*1024+512)); }while(0)
  #define VRD(i) do{ vlo[i]=vtr(vp_+(((i)>>2)*4096+((i)&3)*1024)); vhi[i]=vtr(vp_+(((i)>>2)*4096+((i)&3)*1024+512)); }while(0)
  #define KRD(G,j) do{ if(G){ kload2(kf,kp0+sl_next,j); SBAR(); } }while(0)
  #define STEP(C0,C1,P0,P1,t,GK,GV,GL) do{ SBAR(); \
    const lds_cptr vp_=vp0+2*sl_prev; \
    float sacc=(P0[0]+P0[1]); \
    GAPA(C0=__builtin_amdgcn_mfma_f32_32x32x16_bf16(kf[0],qr[0],zc,0,0,0), P0[2],P0[3],P0[4],P0[5],     pw0[0]=PKW(P0,0), pw0[1]=PKW(P0,2), pw0); \
    GAPA(C1=__builtin_amdgcn_mfma_f32_32x32x16_bf16(kf[1],qr[0],zc,0,0,0), P0[6],P0[7],P0[8],P0[9],     pw0[2]=PKW(P0,4), pw0[3]=PKW(P0,6), pw0); \
    GAPA(C0=__builtin_amdgcn_mfma_f32_32x32x16_bf16(kf[2],qr[1],C0,0,0,0),   P0[10],P0[11],P0[12],P0[13], pw1[0]=PKW(P0,8), pw1[1]=PKW(P0,10), pw1); \
    GAPA(C1=__builtin_amdgcn_mfma_f32_32x32x16_bf16(kf[3],qr[1],C1,0,0,0),   P0[14],P0[15],P1[0],P1[1],   pw1[2]=PKW(P0,12),pw1[3]=PKW(P0,14), pw1); \
    VLD(0,0); SBAR(); GAPA(C0=__builtin_amdgcn_mfma_f32_32x32x16_bf16(kf[4],qr[2],C0,0,0,0),   P1[2],P1[3],P1[4],P1[5],     pw2[0]=PKW(P1,0), pw2[1]=PKW(P1,2), pw2); \
    VLD(1,4); SBAR(); GAPA(C1=__builtin_amdgcn_mfma_f32_32x32x16_bf16(kf[5],qr[2],C1,0,0,0),   P1[6],P1[7],P1[8],P1[9],     pw2[2]=PKW(P1,4), pw2[3]=PKW(P1,6), pw2); \
    VLD(2,1); SBAR(); GAPA(C0=__builtin_amdgcn_mfma_f32_32x32x16_bf16(kf[6],qr[3],C0,0,0,0),   P1[10],P1[11],P1[12],P1[13], pw3[0]=PKW(P1,8), pw3[1]=PKW(P1,10), pw3); \
    VLD(3,5); SBAR(); GAPA(C1=__builtin_amdgcn_mfma_f32_32x32x16_bf16(kf[7],qr[3],C1,0,0,0),   P1[14],P1[15],0.f,0.f,       pw3[2]=PKW(P1,12),pw3[3]=PKW(P1,14), pw3); \
    l_reg+=sacc; \
    if(GK){DMA_K((t)+3,sl_cur);} if(GV){DMA_V((t)+1,sl_next);} \
    _Pragma("unroll") for(int r=0;r<16;++r){C0[r]-=mhat;C1[r]-=mhat;} CMASK(C0,C1,t); \
    { float a=MX3(C0[0],C0[1],C1[0]),b=MX3(C0[2],C0[3],C1[1]); a=MX3(a,C1[2],C1[3]); \
      _Pragma("unroll") for(int r=4;r<16;r+=4){a=MX3(a,C0[r],C0[r+1]);b=MX3(b,C0[r+2],C0[r+3]);a=MX3(a,C1[r],C1[r+1]);b=MX3(b,C1[r+2],C1[r+3]);} \
      float rm=__builtin_fmaxf(a,b); { auto rr=__builtin_amdgcn_permlane32_swap(__float_as_uint(rm),__float_as_uint(rm),false,false); rm=__builtin_fmaxf(__uint_as_float(rr[0]),__uint_as_float(rr[1])); } \
      resc=false; \
      if(__builtin_expect(__any(rm>(float)THRL),0)){ const float dl=__builtin_fmaxf(rm,0.f); mhat+=dl; \
        _Pragma("unroll") for(int r=0;r<16;++r){C0[r]-=dl;C1[r]-=dl;} \
        const float f=__builtin_amdgcn_exp2f(-dl); l_reg*=f; if(hi==0)wsf[r32]=f; resc=true; } } \
    SBAR(); \
    GAPB2(o[0]=__builtin_amdgcn_mfma_f32_32x32x16_bf16(PAF(0),VFRS(0),o[0],0,0,0), C0,0); VLD(0,2); SBAR(); \
    GAPB2(o[1]=__builtin_amdgcn_mfma_f32_32x32x16_bf16(PAF(0),VFRS(1),o[1],0,0,0), C0,2); VLD(1,6); SBAR(); \
    KRD(GL,0); GAPB2(o[0]=__builtin_amdgcn_mfma_f32_32x32x16_bf16(PAF(1),VFRS(2),o[0],0,0,0), C0,4); VLD(2,3); SBAR(); \
    KRD(GL,1); GAPB2(o[1]=__builtin_amdgcn_mfma_f32_32x32x16_bf16(PAF(1),VFRS(3),o[1],0,0,0), C0,6); VLD(3,7); SBAR(); \
    KRD(GL,2); GAPB2(o[0]=__builtin_amdgcn_mfma_f32_32x32x16_bf16(PAF(2),VFRS(0),o[0],0,0,0), C0,8); VLD(0,8); SBAR(); \
    KRD(GL,3); GAPB2(o[1]=__builtin_amdgcn_mfma_f32_32x32x16_bf16(PAF(2),VFRS(1),o[1],0,0,0), C0,10); VLD(1,12); SBAR(); \
    GAPB2(o[0]=__builtin_amdgcn_mfma_f32_32x32x16_bf16(PAF(3),VFRS(2),o[0],0,0,0), C0,12); VLD(2,9); SBAR(); \
    GAPB2(o[1]=__builtin_amdgcn_mfma_f32_32x32x16_bf16(PAF(3),VFRS(3),o[1],0,0,0), C0,14); VLD(3,13); SBAR(); \
    GAPB2(o[2]=__builtin_amdgcn_mfma_f32_32x32x16_bf16(PAF(0),VFRS(0),o[2],0,0,0), C1,0); VLD(0,10); SBAR(); \
    GAPB2(o[3]=__builtin_amdgcn_mfma_f32_32x32x16_bf16(PAF(0),VFRS(1),o[3],0,0,0), C1,2); VLD(1,14); SBAR(); \
    GAPB2(o[2]=__builtin_amdgcn_mfma_f32_32x32x16_bf16(PAF(1),VFRS(2),o[2],0,0,0), C1,4); VLD(2,11); SBAR(); \
    GAPB2(o[3]=__builtin_amdgcn_mfma_f32_32x32x16_bf16(PAF(1),VFRS(3),o[3],0,0,0), C1,6); VLD(3,15); SBAR(); \
    GAPB2(o[2]=__builtin_amdgcn_mfma_f32_32x32x16_bf16(PAF(2),VFRS(0),o[2],0,0,0), C1,8); \
    GAPB2(o[3]=__builtin_amdgcn_mfma_f32_32x32x16_bf16(PAF(2),VFRS(1),o[3],0,0,0), C1,10); \
    GAPB2(o[2]=__builtin_amdgcn_mfma_f32_32x32x16_bf16(PAF(3),VFRS(2),o[2],0,0,0), C1,12); \
    GAPB2(o[3]=__builtin_amdgcn_mfma_f32_32x32x16_bf16(PAF(3),VFRS(3),o[3],0,0,0), C1,14); \
    }while(0)
  int t=1;
  #undef CMASK
  #define CMASK(P0,P1,t) do{}while(0)
  for(;t+5<NT;t+=2){
    STEP(pB0,pB1,pA0,pA1,t,true,true,true);     WAIT_BAR(3); RESC(); ROT();
    STEP(pA0,pA1,pB0,pB1,t+1,true,true,true);   WAIT_BAR(3); RESC(); ROT();
  }
  #undef CMASK
  #define CMASK(P0,P1,t) do{int jb_=(t)-(NT-4); if(jb_>=0)cmask(P0,P1,jb_,qrel,hi);}while(0)
  #define ENDW(tt) do{ if((tt)+3<NT){WAIT_BAR(3);} else if((tt)+2<NT){WAIT_BAR(2);} else {WAIT_BAR(0);} }while(0)
  for(;t+1<NT;t+=2){
    STEP(pB0,pB1,pA0,pA1,t,(t+3<NT),(t+1<NT),(t+1<NT));       ENDW(t);   RESC(); ROT();
    STEP(pA0,pA1,pB0,pB1,t+1,(t+4<NT),(t+2<NT),(t+2<NT));     ENDW(t+1); RESC(); ROT();
  }
  STEP(pB0,pB1,pA0,pA1,NT-1,false,false,false); RESC();
  { float sacc=pB0[0]+pB0[1]; _Pragma("unroll") for(int r=2;r<16;++r)sacc+=pB0[r]; _Pragma("unroll") for(int r=0;r<16;++r)sacc+=pB1[r]; l_reg+=sacc;
    pw0=(u32x4){PKW(pB0,0),PKW(pB0,2),PKW(pB0,4),PKW(pB0,6)};pw1=(u32x4){PKW(pB0,8),PKW(pB0,10),PKW(pB0,12),PKW(pB0,14)};pw2=(u32x4){PKW(pB1,0),PKW(pB1,2),PKW(pB1,4),PKW(pB1,6)};pw3=(u32x4){PKW(pB1,8),PKW(pB1,10),PKW(pB1,12),PKW(pB1,14)};
    SBAR(); pv(o,vb0+2*sl_cur,PAF(0),PAF(1),PAF(2),PAF(3)); pv(o+2,vb0+2*sl_cur+8192,PAF(0),PAF(1),PAF(2),PAF(3)); }
  #undef PKW
  #undef PAF
  #undef VFR
  #undef PIN
  #undef MX3
  #undef GAPA
  #undef GAPB
  #undef EX
  #undef VRD
  #undef VRD2
  #undef VLD
  #undef VFRS
  #undef GAPB2
  #undef BGAP
  #undef KRD
  #undef STEP
  #undef ENDW
  u32x4 zg_[4]; if(BIAS){ const bf16*Zw=Zg+(rowbase+q0+wid*QBLK)*DM;
    #pragma unroll
    for(int i=0;i<4;++i)zg_[i]=*(const u32x4*)(Zw+(long)(i*8+(lane>>3))*DM+(lane&7)*8); }
  {auto rr=__builtin_amdgcn_permlane32_swap(__float_as_uint(l_reg),__float_as_uint(l_reg),false,false);l_reg=__uint_as_float(rr[0])+__uint_as_float(rr[1]);}
  if(hi==0)wsf[32+r32]=l_reg;asm volatile("s_waitcnt lgkmcnt(0)":::"memory");
  float rli[16];
  #pragma unroll
  for(int r=0;r<16;++r)rli[r]=__builtin_amdgcn_rcpf(wsf[32+crow(r,hi)]);
  bf16*Ow=O+(rowbase+q0+wid*QBLK)*DM;
  { bf16*stg=(bf16*)(shm+LDS_OST2)+wid*4096;
    #pragma unroll
    for(int r=0;r<16;++r){const int orow=crow(r,hi);
      #pragma unroll
      for(int d0=0;d0<4;++d0)stg[orow*128+d0*32+r32]=__float2bfloat16(o[d0][r]*rli[r]);}
    asm volatile("s_waitcnt lgkmcnt(0)":::"memory");
    #pragma unroll
    for(int i=0;i<8;++i){const int row=i*4+(lane>>4),ch=lane&15; const u32x4 v=*(const u32x4*)(stg+row*128+ch*8); ATTN_STORE16(Ow+(long)row*DM+ch*8,v);} }
  asm volatile("s_waitcnt lgkmcnt(0)\n\ts_barrier":::"memory");
  #undef DMA_K
  #undef DMA_V
  #undef CMASK
  #undef START
  #undef RESC
  #undef ROT
}
constexpr int ATTN_LDS_BYTES=LDS_BYTES;
struct AttnTensors { const bf16* Q; const bf16* K; const bf16* V; bf16* O; const float* cum; const bf16* Z; };
struct AttnUnit { int bh; int qb; };
struct StaticOrder {
  int vcu,G;
  __device__ __forceinline__ StaticOrder(int vcu_,int G_,int np_):vcu(vcu_),G(G_),NP_(np_){}
  int NP_;
  __device__ __forceinline__ bool next(int i,AttnUnit&u)const{ int P;
    if(NP_%G==0 && G%8==0){ const int ppc=NP_/G; if(i>=2*ppc)return false; const int g=vcu>>3,j=vcu&7,r=i>>1; P=(g*2*ppc+2*r+(j>>2))*4+(j&3); }
    else { P=vcu+(i>>1)*G; if(P>=NP_)return false; }
    const int s=P&3; u.bh=P>>2; u.qb=(i&1)?7-s:s; return true; }
};
template<bool BIAS,int THRL=8> __device__ __forceinline__ void attn_phase(char*lds,const AttnTensors&T,const StaticOrder&S){
  AttnUnit u;
  for(int i=0;S.next(i,u);++i){
    const int b=u.bh>>4, vh=u.bh&15;
    if(BIAS){ attn_unit<64,true>(b,u.qb,T.Q+vh*64,T.K+vh*64,T.V+vh*64,T.O+vh*64,T.cum+(long)u.bh*SEQ,T.Z+vh*64,lds); }
    else { const int b8=u.bh>>3, v8=u.bh&7; const int h=v8>>1,c=v8&1; const int sub=(h*2+c)*64;
      attn_unit128<THRL>(b8,u.qb,T.Q+sub,T.K+sub,T.V+h*128,T.O+c*512+h*128,lds); }
  }
}
#undef SBAR
#undef WAIT_BAR
}
#include <hip/hip_cooperative_groups.h>
namespace cg = cooperative_groups;
#define LAS __attribute__((address_space(3)))
typedef unsigned short bf16;
typedef unsigned v4u __attribute__((ext_vector_type(4)));
typedef unsigned v2u __attribute__((ext_vector_type(2)));
typedef float f32x4 __attribute__((ext_vector_type(4)));

constexpr int NWAVES = 8, NTHR = 512;
constexpr int BATCH = 32, SEQ = 2048, D = 1024, M = BATCH * SEQ;
constexpr int IN_AB = 4104, IN_C = 4112, NP = 4096;
constexpr float EPS = 1e-6f;
constexpr float QSCALE = 0.125f * 1.4426950408889634f;
constexpr size_t MiB = 1u << 20;
constexpr size_t WS_W1T = 2 * MiB, WS_WO1T = 10 * MiB, WS_W2T = 12 * MiB, WS_WO2T = 20 * MiB;
constexpr size_t WS_CS = 22 * MiB;
constexpr size_t WS_GB = 26 * MiB;
constexpr size_t WS_CUM = 28 * MiB;
constexpr size_t WS_XB = 32 * MiB;
constexpr size_t WS_P = 160 * MiB;
constexpr size_t WS_OA = 672 * MiB;
constexpr size_t WS_OB = 800 * MiB;
constexpr size_t WS_BAR = 0;
constexpr size_t WS_EGL = 1 * MiB;
constexpr size_t WS_GW = WS_XB, WS_GQG = WS_XB + 64 * MiB;
constexpr size_t WS_GKDT = 864 * MiB, WS_GUT = 928 * MiB, WS_GQKM = 992 * MiB;
constexpr size_t WS_END = 1024 * MiB;
constexpr size_t PSTRIDE = (size_t)M * 1024;
constexpr int LDS_BYTES = 147456;

__device__ __forceinline__ float bf2f(bf16 u) { return __uint_as_float((unsigned)u << 16); }
__device__ __forceinline__ unsigned f2bf(float f) { return attn_body::cvtpk_s(f, 0.f) & 0xffffu; }
__device__ __forceinline__ unsigned pk2(float lo, float hi) { return attn_body::cvtpk_s(lo, hi); }
#define LBAR() do { asm volatile("s_waitcnt lgkmcnt(0)" ::: "memory"); __builtin_amdgcn_s_barrier(); asm volatile("" ::: "memory"); } while (0)
__device__ __forceinline__ float dpp_f(float v, int ctrl_sel) {
    const int x = __float_as_int(v);
    int r = ctrl_sel == 0 ? __builtin_amdgcn_update_dpp(x, x, 0xB1, 0xF, 0xF, true) : ctrl_sel == 1 ? __builtin_amdgcn_update_dpp(x, x, 0x4E, 0xF, 0xF, true)
          : ctrl_sel == 2 ? __builtin_amdgcn_update_dpp(x, x, 0x141, 0xF, 0xF, true) : __builtin_amdgcn_update_dpp(x, x, 0x140, 0xF, 0xF, true);
    return __int_as_float(r);
}
__device__ __forceinline__ float row16_sum(float v) { v += dpp_f(v, 0); v += dpp_f(v, 1); v += dpp_f(v, 2); v += dpp_f(v, 3); return v; }
__device__ __forceinline__ float wave_sum(float v) {
    v = row16_sum(v);
    { auto r = __builtin_amdgcn_permlane16_swap(__float_as_uint(v), __float_as_uint(v), false, false); v = __uint_as_float(r[0]) + __uint_as_float(r[1]); }
    { auto r = __builtin_amdgcn_permlane32_swap(__float_as_uint(v), __float_as_uint(v), false, false); v = __uint_as_float(r[0]) + __uint_as_float(r[1]); }
    return v;
}
__device__ __forceinline__ float silu_f(float x) { return x * __builtin_amdgcn_rcpf(1.f + __expf(-x)); }
__device__ __forceinline__ void unpack8(v4u w, float* f) {
#pragma unroll
    for (int i = 0; i < 4; ++i) { f[2 * i] = __uint_as_float(w[i] << 16); f[2 * i + 1] = __uint_as_float(w[i] & 0xffff0000u); }
}

struct EpiRope {
    static constexpr bool PERM = true, AFTER_DRAIN = false;
    bf16* O; const float* cs;
    __device__ __forceinline__ void operator()(const pg8::f32x4 (&acc)[2][2][4][2], const pg8::Unit& u, int wr, int wc, int fr, int fq) const {
        const int row0 = u.pm * 256 + wr * 64 + fr; int colt = u.pn * 256;
        const int t = colt >> 10; bf16* base = O + (size_t)t * PSTRIDE; colt -= t << 10;
        const int col0 = colt + wc * 32 + 8 * fq;
        const bool rot = (t == 0) && ((wc & 1) == 0);
        const float sg = (fq == 0) ? -1.f : 1.f;
        f32x4 nx[4] = {{1.f, 1.f, 1.f, 1.f}, {1.f, 1.f, 1.f, 1.f}, {0.f, 0.f, 0.f, 0.f}, {0.f, 0.f, 0.f, 0.f}};
        if (rot) { const f32x4* cp = (const f32x4*)(cs + (size_t)row0 * 16); nx[0] = cp[0]; nx[1] = cp[1]; nx[2] = cp[2]; nx[3] = cp[3]; }
#pragma unroll
        for (int ai = 0; ai < 2; ++ai)
#pragma unroll
            for (int m = 0; m < 4; ++m) {
                const int row = row0 + ai * 128 + m * 16; bf16* rowp = base + (size_t)row * 1024 + col0;
                const f32x4 c0 = nx[0], c1 = nx[1], s0 = nx[2], s1 = nx[3];
                if (rot && (ai * 4 + m) < 7) { const int rown = row0 + ((ai * 4 + m + 1) >> 2) * 128 + ((ai * 4 + m + 1) & 3) * 16; const f32x4* cp = (const f32x4*)(cs + (size_t)rown * 16); nx[0] = cp[0]; nx[1] = cp[1]; nx[2] = cp[2]; nx[3] = cp[3]; }
#pragma unroll
                for (int bj = 0; bj < 2; ++bj) {
                    f32x4 v0 = acc[ai][bj][m][0], v1 = acc[ai][bj][m][1];
                    if (rot) {
                        f32x4 p0, p1;
#pragma unroll
                        for (int i = 0; i < 4; ++i) {
                            auto r0_ = __builtin_amdgcn_permlane16_swap(__float_as_uint(v0[i]), __float_as_uint(v0[i]), false, false); p0[i] = __uint_as_float((fq & 1) ? r0_[0] : r0_[1]);
                            auto r1_ = __builtin_amdgcn_permlane16_swap(__float_as_uint(v1[i]), __float_as_uint(v1[i]), false, false); p1[i] = __uint_as_float((fq & 1) ? r1_[0] : r1_[1]); }
                        if (fq < 2) { v0 = v0 * c0 + sg * (p0 * s0); v1 = v1 * c1 + sg * (p1 * s1); }
                    }
                    v4u w; w.x = pg8::cvt_pk_bf16(v0[0], v0[1]); w.y = pg8::cvt_pk_bf16(v0[2], v0[3]); w.z = pg8::cvt_pk_bf16(v1[0], v1[1]); w.w = pg8::cvt_pk_bf16(v1[2], v1[3]);
                    *(v4u*)(rowp + bj * 128) = w;
                }
            }
    }
};

#define XB_TMO      128
#define XB_XCNT(j)  (256  + 64 * (j))
#define XB_XSUB(j)  (1280 + 64 * (j))
#define XB_XGEN(j)  (2304 + 64 * (j))
#define XB_TOP      3328
#define XB_TOPGEN   3392
#define XCD_BAR_WORDS 3456
#define XB_SPIN_CAP (1u << 18)

__device__ __forceinline__ unsigned xb_ld(unsigned* p)              { return __hip_atomic_load(p, __ATOMIC_RELAXED, __HIP_MEMORY_SCOPE_AGENT); }
__device__ __forceinline__ unsigned xb_add(unsigned* p, unsigned v) { return __hip_atomic_fetch_add(p, v, __ATOMIC_RELAXED, __HIP_MEMORY_SCOPE_AGENT); }
__device__ __forceinline__ unsigned xb_xcc_id() { return (unsigned)__builtin_amdgcn_s_getreg((3 << 11) | 20) & 0xFu; }
#define XB_SPIN(cond, bar) do { unsigned _sp = 0; while (cond) { __builtin_amdgcn_s_sleep(1); \
    if ((++_sp & 255u) == 0u) { if (xb_ld(&(bar)[XB_TMO])) break; if (_sp > XB_SPIN_CAP) { atomicAdd(&(bar)[XB_TMO], 1u); break; } } } } while (0)

struct XcdBarrier {
    unsigned* bar; unsigned x;
    volatile LAS unsigned* st;
};

__device__ __forceinline__ XcdBarrier xcd_barrier_post(unsigned* bar, volatile LAS unsigned* st) {
    XcdBarrier b; b.bar = bar; b.x = xb_xcc_id(); b.st = st;
    if (threadIdx.x == 0) (void)xb_add(&bar[XB_XCNT(b.x)], 1u);
    return b;
}
__device__ __forceinline__ void xcd_barrier_complete(unsigned* bar, unsigned x, unsigned& nloc, unsigned& nx) {
    const unsigned G = gridDim.x * gridDim.y * gridDim.z;
    unsigned sum, cnt, mine, sp = 0u;
    for (;;) {
        sum = 0u; cnt = 0u; mine = 0u;
#pragma unroll
        for (unsigned j = 0; j < 16; ++j) { const unsigned c = xb_ld(&bar[XB_XCNT(j)]); sum += c; cnt += (c > 0u) ? 1u : 0u; mine = (j == x) ? c : mine; }
        if (sum == G) break;
        __builtin_amdgcn_s_sleep(1);
        if ((++sp & 255u) == 0u) { if (xb_ld(&bar[XB_TMO])) break; if (sp > XB_SPIN_CAP) { atomicAdd(&bar[XB_TMO], 1u); break; } }
    }
    nloc = mine > 0u ? mine : 1u; nx = cnt > 0u ? cnt : 1u;
}

__device__ __forceinline__ void xcd_barrier(const XcdBarrier& b) {
    asm volatile("s_waitcnt vmcnt(0)" ::: "memory");
    __syncthreads();
    if (threadIdx.x == 0) {
        unsigned* bar = b.bar;
        __builtin_amdgcn_s_waitcnt(0);
        unsigned nloc = b.st[0], nx = b.st[1];
        if (nloc == 0u) { xcd_barrier_complete(bar, b.x, nloc, nx); b.st[0] = nloc; b.st[1] = nx; }
        const unsigned old = xb_add(&bar[XB_XSUB(b.x)], 1u);
        const unsigned gen = old / nloc;
        if (old + 1u == (gen + 1u) * nloc) {
            __builtin_amdgcn_fence(__ATOMIC_RELEASE, "agent");
            asm volatile("s_waitcnt vmcnt(0)" ::: "memory");
            const unsigned og = xb_add(&bar[XB_TOP], 1u);
            const unsigned tg = og / nx;
            if (og + 1u == (tg + 1u) * nx) xb_add(&bar[XB_TOPGEN], 1u);
            else XB_SPIN(xb_ld(&bar[XB_TOPGEN]) == tg, bar);
            __builtin_amdgcn_fence(__ATOMIC_ACQUIRE, "agent");
            xb_add(&bar[XB_XGEN(b.x)], 1u);
            asm volatile("s_waitcnt vmcnt(0)" ::: "memory");
        } else {
            XB_SPIN(xb_ld(&bar[XB_XGEN(b.x)]) == gen, bar);
            __builtin_amdgcn_fence(__ATOMIC_ACQUIRE, "agent");
            asm volatile("s_waitcnt vmcnt(0)" ::: "memory");
        }
    }
    __syncthreads();
}

struct Args {
    const float* x; const int* pos; const float* pre; const float* post; const float* w_in_ab;
    const float* lq1; const float* lk1; const float* lq2; const float* lk2; const float* subln;
    const float* convw; const float* a_log; const float* dt_bias; const float* head_norm; const float* w_out_ab;
    const float* w_in_c; const float* fbias; const float* w_out_c;
    float* out; unsigned char* ws;
};

__device__ __forceinline__ void transpose_item(const float* W, int ldw, int K, int ncols, bf16* WT, const float* kscale, int qcols, LAS float* scr, int item, int lane) {
    const int nblk = ncols / 32, kb = item / nblk, nb = item % nblk, k0 = 64 * kb, n0 = 32 * nb;
    const float cscale = (n0 + (lane & 31)) < qcols ? QSCALE : 1.f;
#pragma unroll 8
    for (int i = 0; i < 32; ++i) { const int kk = 2 * i + (lane >> 5); const float ks = kscale ? kscale[k0 + kk] : 1.f;
        scr[kk * 33 + (lane & 31)] = W[(size_t)(k0 + kk) * ldw + n0 + (lane & 31)] * ks * cscale; }
    asm volatile("s_waitcnt lgkmcnt(0)" ::: "memory");
    const int c = lane & 7;
#pragma unroll
    for (int j = 0; j < 4; ++j) { const int n = (lane >> 3) + 8 * j; const LAS float* s = scr + (8 * c) * 33 + n;
        v4u o; o.x = pk2(s[0 * 33], s[1 * 33]); o.y = pk2(s[2 * 33], s[3 * 33]); o.z = pk2(s[4 * 33], s[5 * 33]); o.w = pk2(s[6 * 33], s[7 * 33]);
        *(v4u*)(WT + (size_t)(n0 + n) * K + k0 + 8 * c) = o; }
    asm volatile("s_waitcnt lgkmcnt(0)" ::: "memory");
}

template <int NC> __device__ __forceinline__ void stage_small_w(LAS float* wl, const float* W, int ldw, const float* pre, int tid) {
    for (int e = tid; e < NC * 1024; e += NTHR) { const int k = e / NC, c = e % NC; wl[c * 1024 + k] = W[(size_t)k * ldw + NP + c] * pre[k]; }
}
template <int NC> __device__ __forceinline__ float small_dots(const LAS float* wl, const f32x4 (&v)[4], int lane) {
    float mine = 0.f;
#pragma unroll 4
    for (int c = 0; c < NC; ++c) { float s = 0.f;
#pragma unroll
        for (int j = 0; j < 4; ++j) { const f32x4 w = *(const LAS f32x4*)(wl + c * 1024 + 256 * j + 4 * lane); s += (v[j].x * w.x + v[j].y * w.y) + (v[j].z * w.z + v[j].w * w.w); }
        s = wave_sum(s); mine = (lane == c) ? s : mine; }
    return mine;
}
__device__ __forceinline__ void store_row_bf16(bf16* orow, const f32x4 (&v)[4], float sc, int lane) {
    unsigned long long* o8 = (unsigned long long*)orow + lane;
#pragma unroll
    for (int j = 0; j < 4; ++j) o8[64 * j] = (unsigned long long)pk2(v[j].x * sc, v[j].y * sc) | ((unsigned long long)pk2(v[j].z * sc, v[j].w * sc) << 32);
}
__device__ __forceinline__ float sumsq4(const f32x4 (&v)[4]) { float s = 0.f;
#pragma unroll
    for (int j = 0; j < 4; ++j) s += (v[j].x * v[j].x + v[j].y * v[j].y) + (v[j].z * v[j].z + v[j].w * v[j].w);
    return s; }

__device__ __forceinline__ void phase_prologue(const Args& A, LAS unsigned char* lds, int vcu, int G, int tid, int lane, int wave) {
    unsigned char* ws = A.ws;
    LAS float* wl = (LAS float*)lds;
    LAS float* scr = (LAS float*)(lds + 32768 + wave * 12288);
    stage_small_w<8>(wl, A.w_in_ab, IN_AB, A.pre, tid);
    const int gw = vcu * NWAVES + wave, NGW = G * NWAVES;
    constexpr int I1 = 16 * 128, IO = 16 * 32;
    for (int it = gw; it < 2 * I1 + 2 * IO; it += NGW) {
        int r = it;
        if (r < I1) { transpose_item(A.w_in_ab, IN_AB, D, NP, (bf16*)(ws + WS_W1T), A.pre, 512, scr, r, lane); continue; } r -= I1;
        if (r < I1) { transpose_item(A.w_in_c, IN_C, D, NP, (bf16*)(ws + WS_W2T), A.pre + D, 1024, scr, r, lane); continue; } r -= I1;
        if (r < IO) { transpose_item(A.w_out_ab, D, D, D, (bf16*)(ws + WS_WO1T), nullptr, 0, scr, r, lane); continue; } r -= IO;
        transpose_item(A.w_out_c, D, D, D, (bf16*)(ws + WS_WO2T), nullptr, 0, scr, r, lane);
    }
    __syncthreads();
    bf16* XB = (bf16*)(ws + WS_XB); float* GB = (float*)(ws + WS_GB); float* CS = (float*)(ws + WS_CS);
    const int hh = lane & 3; const float alog = A.a_log[hh], dtb = A.dt_bias[hh];
    const float invf = powf(500000.0f, -(float)(lane & 7) * 0.125f);
    for (int m = gw; m < M; m += NGW) {
        const f32x4* xr = (const f32x4*)(A.x + (size_t)m * D) + lane; f32x4 v[4];
#pragma unroll
        for (int j = 0; j < 4; ++j) v[j] = xr[64 * j];
        const float rstd = __builtin_amdgcn_rsqf(wave_sum(sumsq4(v)) * (1.f / D) + EPS);
        store_row_bf16(XB + (size_t)m * D, v, rstd, lane);
        float mine = small_dots<8>(wl, v, lane) * rstd;
        if (lane < 4) GB[(size_t)m * 8 + lane] = 1.f / (1.f + expf(-mine));
        else if (lane < 8) { const float xx = mine + dtb; const float sp = xx > 20.f ? xx : log1pf(expf(xx)); GB[(size_t)m * 8 + lane] = -expf(alog) * sp; }
    }
    for (int q = 0; q < (M / NGW + 7) / 8; ++q) { const int ri = (lane >> 3) + 8 * q; const int m = gw + ri * NGW;
        if (m < M) { const float ang = (float)A.pos[m] * invf; const float sn = sinf(ang), cn = cosf(ang); CS[(size_t)m * 16 + (lane & 7)] = cn; CS[(size_t)m * 16 + 8 + (lane & 7)] = sn; } }
}

typedef short s16x8 __attribute__((ext_vector_type(8)));
typedef float f32x16v __attribute__((ext_vector_type(16)));
typedef float f32x2v __attribute__((ext_vector_type(2)));
__device__ __forceinline__ int crow16(int r, int hi) { return (r & 3) + 8 * (r >> 2) + 4 * hi; }
__device__ __forceinline__ void phase_gdn_prep(const Args& A, LAS unsigned char* lds, int vcu, int G, int tid, int lane, int wave) {
    unsigned char* ws = A.ws;
    const bf16* PQK = (const bf16*)(ws + WS_P) + 2 * PSTRIDE;
    const bf16* PVZ = (const bf16*)(ws + WS_P) + 3 * PSTRIDE;
    const float* GB = (const float*)(ws + WS_GB);
    bf16* GW = (bf16*)(ws + WS_GW); bf16* GQG = (bf16*)(ws + WS_GQG); bf16* GKDT = (bf16*)(ws + WS_GKDT); bf16* GUT = (bf16*)(ws + WS_GUT); bf16* GQKM = (bf16*)(ws + WS_GQKM);
    float* EGL = (float*)(ws + WS_EGL);
    LAS bf16* kb16 = (LAS bf16*)lds; LAS bf16* qb16 = (LAS bf16*)(lds + 17408);
    LAS float* RHS = (LAS float*)(lds + 34816); LAS float* Am = (LAS float*)(lds + 100352);
    LAS float* gcl = (LAS float*)(lds + 117760); LAS float* betal = (LAS float*)(lds + 118016);
    const int r32 = lane & 31, hi = lane >> 5;
    unsigned xraw[3][11]; float g_nx = 0.f, beta_nx = 0.f;
#define PREP_ISSUE(un) do { const int b_ = (un) >> 7, n_ = ((un) >> 2) & 31, h_ = (un) & 3; const long m0_ = (long)b_ * SEQ + n_ * 64; \
        g_nx = GB[(m0_ + lane) * 8 + 4 + h_]; beta_nx = GB[(m0_ + lane) * 8 + h_]; \
        _Pragma("unroll") for (int which = 0; which < 3; ++which) { const bf16* sp_ = (which < 2 ? PQK + which * 512 : PVZ) + h_ * 128 + 2 * lane; \
            _Pragma("unroll") for (int i = 0; i < 11; ++i) { long row_ = m0_ + wave * 8 + i - 3; row_ = row_ < 0 ? 0 : row_; xraw[which][i] = *(const unsigned*)(sp_ + row_ * 1024); } } } while (0)
    for (int unit = vcu; unit < 4096; unit += G) {
        const int b = unit >> 7, n = (unit >> 2) & 31, h = unit & 3;
        const int t0 = n * 64; const size_t m0 = (size_t)b * SEQ + t0; const size_t ch = unit;
        PREP_ISSUE(unit); const float g_l = g_nx, beta_l = beta_nx;
        float gc = g_l;
        {
            gc += __int_as_float(__builtin_amdgcn_update_dpp(0, __float_as_int(gc), 0x111, 0xF, 0xF, false));
            gc += __int_as_float(__builtin_amdgcn_update_dpp(0, __float_as_int(gc), 0x112, 0xF, 0xF, false));
            gc += __int_as_float(__builtin_amdgcn_update_dpp(0, __float_as_int(gc), 0x114, 0xF, 0xF, false));
            gc += __int_as_float(__builtin_amdgcn_update_dpp(0, __float_as_int(gc), 0x118, 0xF, 0xF, false));
            const float t0 = __int_as_float(__builtin_amdgcn_readlane(__float_as_int(gc), 15)), t1 = __int_as_float(__builtin_amdgcn_readlane(__float_as_int(gc), 31)), t2 = __int_as_float(__builtin_amdgcn_readlane(__float_as_int(gc), 47));
            const int rw = lane >> 4; gc += (rw == 1) ? t0 : (rw == 2) ? (t0 + t1) : (rw == 3) ? ((t0 + t1) + t2) : 0.f; }
        const float glast = __int_as_float(__builtin_amdgcn_readlane(__float_as_int(gc), 63));
        if (wave == 0) { gcl[lane] = gc; betal[lane] = beta_l; if (lane == 0) EGL[ch] = __expf(glast); }
        float val[3][8][2];
#pragma unroll
        for (int which = 0; which < 3; ++which) {
            const int chn = which * 512 + h * 128 + 2 * lane;
            f32x2v w[4];
#pragma unroll
            for (int j = 0; j < 4; ++j) w[j] = *(const f32x2v*)(A.convw + j * 1536 + chn);
            float x0[11], x1[11];
#pragma unroll
            for (int i = 0; i < 11; ++i) { const int tr = wave * 8 + i - 3; const unsigned u = (t0 + tr >= 0) ? xraw[which][i] : 0u;
                x0[i] = __uint_as_float(u << 16); x1[i] = __uint_as_float(u & 0xffff0000u); }
#pragma unroll
            for (int r = 0; r < 8; ++r) {
                const float y0 = w[0].x * x0[r] + w[1].x * x0[r + 1] + w[2].x * x0[r + 2] + w[3].x * x0[r + 3];
                const float y1 = w[0].y * x1[r] + w[1].y * x1[r + 1] + w[2].y * x1[r + 2] + w[3].y * x1[r + 3];
                val[which][r][0] = silu_f(y0); val[which][r][1] = silu_f(y1); }
        }
        float kd0[8], kd1[8];
        int zv_ = 0; asm volatile("" : "+v"(zv_)); const int iv0 = wave * 8 + zv_;
        LAS bf16* kbw = kb16 + (wave * 8) * 136 + 2 * lane; LAS bf16* qbw = qb16 + (wave * 8) * 136 + 2 * lane; LAS float* rhw = RHS + (wave * 8) * 256 + 2 * lane;
        bf16* gqw = GQG + ch * 8192 + (((wave >> 2) * 8 + (lane >> 3)) * 64 + ((lane >> 2) & 1) * 32 + (wave & 3) * 8) * 8 + 2 * (lane & 3);
#pragma unroll
        for (int r = 0; r < 8; ++r) {
            const float q0 = val[0][r][0], q1 = val[0][r][1], k0 = val[1][r][0], k1 = val[1][r][1];
            const float rq = __builtin_amdgcn_rsqf(wave_sum(q0 * q0 + q1 * q1) + EPS) * 0.08838834764831845f, rk = __builtin_amdgcn_rsqf(wave_sum(k0 * k0 + k1 * k1) + EPS);
            const float gci = __shfl(gc, iv0 + r), bi = __shfl(beta_l, iv0 + r);
            const float eg = __expf(gci), ed = __expf(glast - gci);
            const float qa = q0 * rq, qb = q1 * rq, ka = k0 * rk, kb = k1 * rk;
            *(LAS unsigned*)(kbw + r * 136) = pk2(ka, kb);
            *(LAS unsigned*)(qbw + r * 136) = pk2(qa, qb);
            *(LAS f32x2v*)(rhw + r * 256) = (f32x2v){bi * val[2][r][0], bi * val[2][r][1]};
            *(LAS f32x2v*)(rhw + r * 256 + 128) = (f32x2v){bi * eg * ka, bi * eg * kb};
            *(unsigned*)(gqw + r * 8) = pk2(qa * eg, qb * eg);
            kd0[r] = ka * ed; kd1[r] = kb * ed;
        }
        { v4u o; o.x = pk2(kd0[0], kd0[1]); o.y = pk2(kd0[2], kd0[3]); o.z = pk2(kd0[4], kd0[5]); o.w = pk2(kd0[6], kd0[7]);
          *(v4u*)(GKDT + ch * 8192 + ((((2 * lane) >> 5) * 4 + (wave >> 1)) * 64 + (wave & 1) * 32 + ((2 * lane) & 31)) * 8) = o;
          o.x = pk2(kd1[0], kd1[1]); o.y = pk2(kd1[2], kd1[3]); o.z = pk2(kd1[4], kd1[5]); o.w = pk2(kd1[6], kd1[7]);
          *(v4u*)(GKDT + ch * 8192 + ((((2 * lane + 1) >> 5) * 4 + (wave >> 1)) * 64 + (wave & 1) * 32 + ((2 * lane + 1) & 31)) * 8) = o; }
        LBAR();
        {
            const int which = wave >> 2, mi = (wave >> 1) & 1, ni = wave & 1;
            const LAS bf16* ab = (which ? qb16 : kb16) + (mi * 32 + r32) * 136 + hi * 8; const LAS bf16* bb = kb16 + (ni * 32 + r32) * 136 + hi * 8;
            f32x16v Dv = {};
#pragma unroll
            for (int kk = 0; kk < 8; ++kk) Dv = __builtin_amdgcn_mfma_f32_32x32x16_bf16(*(const LAS s16x8*)(ab + kk * 16), *(const LAS s16x8*)(bb + kk * 16), Dv, 0, 0, 0);
            const int j = ni * 32 + r32; const float gcj = gcl[j];
#pragma unroll
            for (int r = 0; r < 16; ++r) { const int i = mi * 32 + crow16(r, hi); const float dec = __expf(gcl[i] - gcj);
                if (which == 0) Am[i * 68 + j] = (j < i) ? betal[i] * Dv[r] * dec : 0.f;
                else GQKM[ch * 4096 + ((mi * 4 + (j >> 4)) * 64 + ((j >> 3) & 1) * 32 + crow16(r, hi)) * 8 + (j & 7)] = (bf16)f2bf((j <= i) ? Dv[r] * dec : 0.f); }
        }
        LBAR();
        if (tid < 256) {
            const int c = tid; float x[64]; int zv = 0; asm volatile("" : "+v"(zv)); const LAS float* Amv = Am + zv;
            f32x4 A0_0, A0_1, A0_2, A0_3, A0_4, A0_5, A0_6, A0_7, A1_0, A1_1, A1_2, A1_3, A1_4, A1_5, A1_6, A1_7; float r0 = 0.f, r1 = 0.f, c0 = 0.f, c1 = 0.f, c2 = 0.f, c3 = 0.f;
            r0 = RHS[0 + c];
            A1_0 = *(const LAS f32x4*)(Amv + 68); r1 = RHS[256 + c]; __builtin_amdgcn_sched_barrier(0); c0 = r0; c1 = 0.f; c2 = 0.f; c3 = 0.f; x[0] = (c0 + c1) + (c2 + c3); __builtin_amdgcn_sched_barrier(0);
            A0_0 = *(const LAS f32x4*)(Amv + 136); r0 = RHS[512 + c]; __builtin_amdgcn_sched_barrier(0); c0 = r1; c1 = 0.f; c2 = 0.f; c3 = 0.f; c0 -= A1_0[0] * x[0]; x[1] = (c0 + c1) + (c2 + c3); __builtin_amdgcn_sched_barrier(0);
            A1_0 = *(const LAS f32x4*)(Amv + 204); r1 = RHS[768 + c]; __builtin_amdgcn_sched_barrier(0); c0 = r0; c1 = 0.f; c2 = 0.f; c3 = 0.f; c0 -= A0_0[0] * x[0]; c1 -= A0_0[1] * x[1]; x[2] = (c0 + c1) + (c2 + c3); __builtin_amdgcn_sched_barrier(0);
            A0_0 = *(const LAS f32x4*)(Amv + 272); r0 = RHS[1024 + c]; __builtin_amdgcn_sched_barrier(0); c0 = r1; c1 = 0.f; c2 = 0.f; c3 = 0.f; c0 -= A1_0[0] * x[0]; c1 -= A1_0[1] * x[1]; c2 -= A1_0[2] * x[2]; x[3] = (c0 + c1) + (c2 + c3); __builtin_amdgcn_sched_barrier(0);
            A1_0 = *(const LAS f32x4*)(Amv + 340); A1_1 = *(const LAS f32x4*)(Amv + 344); r1 = RHS[1280 + c]; __builtin_amdgcn_sched_barrier(0); c0 = r0; c1 = 0.f; c2 = 0.f; c3 = 0.f; c0 -= A0_0[0] * x[0]; c1 -= A0_0[1] * x[1]; c2 -= A0_0[2] * x[2]; c3 -= A0_0[3] * x[3]; x[4] = (c0 + c1) + (c2 + c3); __builtin_amdgcn_sched_barrier(0);
            A0_0 = *(const LAS f32x4*)(Amv + 408); A0_1 = *(const LAS f32x4*)(Amv + 412); r0 = RHS[1536 + c]; __builtin_amdgcn_sched_barrier(0); c0 = r1; c1 = 0.f; c2 = 0.f; c3 = 0.f; c0 -= A1_0[0] * x[0]; c1 -= A1_0[1] * x[1]; c2 -= A1_0[2] * x[2]; c3 -= A1_0[3] * x[3]; c0 -= A1_1[0] * x[4]; x[5] = (c0 + c1) + (c2 + c3); __builtin_amdgcn_sched_barrier(0);
            A1_0 = *(const LAS f32x4*)(Amv + 476); A1_1 = *(const LAS f32x4*)(Amv + 480); r1 = RHS[1792 + c]; __builtin_amdgcn_sched_barrier(0); c0 = r0; c1 = 0.f; c2 = 0.f; c3 = 0.f; c0 -= A0_0[0] * x[0]; c1 -= A0_0[1] * x[1]; c2 -= A0_0[2] * x[2]; c3 -= A0_0[3] * x[3]; c0 -= A0_1[0] * x[4]; c1 -= A0_1[1] * x[5]; x[6] = (c0 + c1) + (c2 + c3); __builtin_amdgcn_sched_barrier(0);
            A0_0 = *(const LAS f32x4*)(Amv + 544); A0_1 = *(const LAS f32x4*)(Amv + 548); r0 = RHS[2048 + c]; __builtin_amdgcn_sched_barrier(0); c0 = r1; c1 = 0.f; c2 = 0.f; c3 = 0.f; c0 -= A1_0[0] * x[0]; c1 -= A1_0[1] * x[1]; c2 -= A1_0[2] * x[2]; c3 -= A1_0[3] * x[3]; c0 -= A1_1[0] * x[4]; c1 -= A1_1[1] * x[5]; c2 -= A1_1[2] * x[6]; x[7] = (c0 + c1) + (c2 + c3); __builtin_amdgcn_sched_barrier(0);
            A1_0 = *(const LAS f32x4*)(Amv + 612); A1_1 = *(const LAS f32x4*)(Amv + 616); A1_2 = *(const LAS f32x4*)(Amv + 620); r1 = RHS[2304 + c]; __builtin_amdgcn_sched_barrier(0); c0 = r0; c1 = 0.f; c2 = 0.f; c3 = 0.f; c0 -= A0_0[0] * x[0]; c1 -= A0_0[1] * x[1]; c2 -= A0_0[2] * x[2]; c3 -= A0_0[3] * x[3]; c0 -= A0_1[0] * x[4]; c1 -= A0_1[1] * x[5]; c2 -= A0_1[2] * x[6]; c3 -= A0_1[3] * x[7]; x[8] = (c0 + c1) + (c2 + c3); __builtin_amdgcn_sched_barrier(0);
            A0_0 = *(const LAS f32x4*)(Amv + 680); A0_1 = *(const LAS f32x4*)(Amv + 684); A0_2 = *(const LAS f32x4*)(Amv + 688); r0 = RHS[2560 + c]; __builtin_amdgcn_sched_barrier(0); c0 = r1; c1 = 0.f; c2 = 0.f; c3 = 0.f; c0 -= A1_0[0] * x[0]; c1 -= A1_0[1] * x[1]; c2 -= A1_0[2] * x[2]; c3 -= A1_0[3] * x[3]; c0 -= A1_1[0] * x[4]; c1 -= A1_1[1] * x[5]; c2 -= A1_1[2] * x[6]; c3 -= A1_1[3] * x[7]; c0 -= A1_2[0] * x[8]; x[9] = (c0 + c1) + (c2 + c3); __builtin_amdgcn_sched_barrier(0);
            A1_0 = *(const LAS f32x4*)(Amv + 748); A1_1 = *(const LAS f32x4*)(Amv + 752); A1_2 = *(const LAS f32x4*)(Amv + 756); r1 = RHS[2816 + c]; __builtin_amdgcn_sched_barrier(0); c0 = r0; c1 = 0.f; c2 = 0.f; c3 = 0.f; c0 -= A0_0[0] * x[0]; c1 -= A0_0[1] * x[1]; c2 -= A0_0[2] * x[2]; c3 -= A0_0[3] * x[3]; c0 -= A0_1[0] * x[4]; c1 -= A0_1[1] * x[5]; c2 -= A0_1[2] * x[6]; c3 -= A0_1[3] * x[7]; c0 -= A0_2[0] * x[8]; c1 -= A0_2[1] * x[9]; x[10] = (c0 + c1) + (c2 + c3); __builtin_amdgcn_sched_barrier(0);
            A0_0 = *(const LAS f32x4*)(Amv + 816); A0_1 = *(const LAS f32x4*)(Amv + 820); A0_2 = *(const LAS f32x4*)(Amv + 824); r0 = RHS[3072 + c]; __builtin_amdgcn_sched_barrier(0); c0 = r1; c1 = 0.f; c2 = 0.f; c3 = 0.f; c0 -= A1_0[0] * x[0]; c1 -= A1_0[1] * x[1]; c2 -= A1_0[2] * x[2]; c3 -= A1_0[3] * x[3]; c0 -= A1_1[0] * x[4]; c1 -= A1_1[1] * x[5]; c2 -= A1_1[2] * x[6]; c3 -= A1_1[3] * x[7]; c0 -= A1_2[0] * x[8]; c1 -= A1_2[1] * x[9]; c2 -= A1_2[2] * x[10]; x[11] = (c0 + c1) + (c2 + c3); __builtin_amdgcn_sched_barrier(0);
            A1_0 = *(const LAS f32x4*)(Amv + 884); A1_1 = *(const LAS f32x4*)(Amv + 888); A1_2 = *(const LAS f32x4*)(Amv + 892); A1_3 = *(const LAS f32x4*)(Amv + 896); r1 = RHS[3328 + c]; __builtin_amdgcn_sched_barrier(0); c0 = r0; c1 = 0.f; c2 = 0.f; c3 = 0.f; c0 -= A0_0[0] * x[0]; c1 -= A0_0[1] * x[1]; c2 -= A0_0[2] * x[2]; c3 -= A0_0[3] * x[3]; c0 -= A0_1[0] * x[4]; c1 -= A0_1[1] * x[5]; c2 -= A0_1[2] * x[6]; c3 -= A0_1[3] * x[7]; c0 -= A0_2[0] * x[8]; c1 -= A0_2[1] * x[9]; c2 -= A0_2[2] * x[10]; c3 -= A0_2[3] * x[11]; x[12] = (c0 + c1) + (c2 + c3); __builtin_amdgcn_sched_barrier(0);
            A0_0 = *(const LAS f32x4*)(Amv + 952); A0_1 = *(const LAS f32x4*)(Amv + 956); A0_2 = *(const LAS f32x4*)(Amv + 960); A0_3 = *(const LAS f32x4*)(Amv + 964); r0 = RHS[3584 + c]; __builtin_amdgcn_sched_barrier(0); c0 = r1; c1 = 0.f; c2 = 0.f; c3 = 0.f; c0 -= A1_0[0] * x[0]; c1 -= A1_0[1] * x[1]; c2 -= A1_0[2] * x[2]; c3 -= A1_0[3] * x[3]; c0 -= A1_1[0] * x[4]; c1 -= A1_1[1] * x[5]; c2 -= A1_1[2] * x[6]; c3 -= A1_1[3] * x[7]; c0 -= A1_2[0] * x[8]; c1 -= A1_2[1] * x[9]; c2 -= A1_2[2] * x[10]; c3 -= A1_2[3] * x[11]; c0 -= A1_3[0] * x[12]; x[13] = (c0 + c1) + (c2 + c3); __builtin_amdgcn_sched_barrier(0);
            A1_0 = *(const LAS f32x4*)(Amv + 1020); A1_1 = *(const LAS f32x4*)(Amv + 1024); A1_2 = *(const LAS f32x4*)(Amv + 1028); A1_3 = *(const LAS f32x4*)(Amv + 1032); r1 = RHS[3840 + c]; __builtin_amdgcn_sched_barrier(0); c0 = r0; c1 = 0.f; c2 = 0.f; c3 = 0.f; c0 -= A0_0[0] * x[0]; c1 -= A0_0[1] * x[1]; c2 -= A0_0[2] * x[2]; c3 -= A0_0[3] * x[3]; c0 -= A0_1[0] * x[4]; c1 -= A0_1[1] * x[5]; c2 -= A0_1[2] * x[6]; c3 -= A0_1[3] * x[7]; c0 -= A0_2[0] * x[8]; c1 -= A0_2[1] * x[9]; c2 -= A0_2[2] * x[10]; c3 -= A0_2[3] * x[11]; c0 -= A0_3[0] * x[12]; c1 -= A0_3[1] * x[13]; x[14] = (c0 + c1) + (c2 + c3); __builtin_amdgcn_sched_barrier(0);
            A0_0 = *(const LAS f32x4*)(Amv + 1088); A0_1 = *(const LAS f32x4*)(Amv + 1092); A0_2 = *(const LAS f32x4*)(Amv + 1096); A0_3 = *(const LAS f32x4*)(Amv + 1100); r0 = RHS[4096 + c]; __builtin_amdgcn_sched_barrier(0); c0 = r1; c1 = 0.f; c2 = 0.f; c3 = 0.f; c0 -= A1_0[0] * x[0]; c1 -= A1_0[1] * x[1]; c2 -= A1_0[2] * x[2]; c3 -= A1_0[3] * x[3]; c0 -= A1_1[0] * x[4]; c1 -= A1_1[1] * x[5]; c2 -= A1_1[2] * x[6]; c3 -= A1_1[3] * x[7]; c0 -= A1_2[0] * x[8]; c1 -= A1_2[1] * x[9]; c2 -= A1_2[2] * x[10]; c3 -= A1_2[3] * x[11]; c0 -= A1_3[0] * x[12]; c1 -= A1_3[1] * x[13]; c2 -= A1_3[2] * x[14]; x[15] = (c0 + c1) + (c2 + c3); __builtin_amdgcn_sched_barrier(0);
            A1_0 = *(const LAS f32x4*)(Amv + 1156); A1_1 = *(const LAS f32x4*)(Amv + 1160); A1_2 = *(const LAS f32x4*)(Amv + 1164); A1_3 = *(const LAS f32x4*)(Amv + 1168); A1_4 = *(const LAS f32x4*)(Amv + 1172); r1 = RHS[4352 + c]; __builtin_amdgcn_sched_barrier(0); c0 = r0; c1 = 0.f; c2 = 0.f; c3 = 0.f; c0 -= A0_0[0] * x[0]; c1 -= A0_0[1] * x[1]; c2 -= A0_0[2] * x[2]; c3 -= A0_0[3] * x[3]; c0 -= A0_1[0] * x[4]; c1 -= A0_1[1] * x[5]; c2 -= A0_1[2] * x[6]; c3 -= A0_1[3] * x[7]; c0 -= A0_2[0] * x[8]; c1 -= A0_2[1] * x[9]; c2 -= A0_2[2] * x[10]; c3 -= A0_2[3] * x[11]; c0 -= A0_3[0] * x[12]; c1 -= A0_3[1] * x[13]; c2 -= A0_3[2] * x[14]; c3 -= A0_3[3] * x[15]; x[16] = (c0 + c1) + (c2 + c3); __builtin_amdgcn_sched_barrier(0);
            A0_0 = *(const LAS f32x4*)(Amv + 1224); A0_1 = *(const LAS f32x4*)(Amv + 1228); A0_2 = *(const LAS f32x4*)(Amv + 1232); A0_3 = *(const LAS f32x4*)(Amv + 1236); A0_4 = *(const LAS f32x4*)(Amv + 1240); r0 = RHS[4608 + c]; __builtin_amdgcn_sched_barrier(0); c0 = r1; c1 = 0.f; c2 = 0.f; c3 = 0.f; c0 -= A1_0[0] * x[0]; c1 -= A1_0[1] * x[1]; c2 -= A1_0[2] * x[2]; c3 -= A1_0[3] * x[3]; c0 -= A1_1[0] * x[4]; c1 -= A1_1[1] * x[5]; c2 -= A1_1[2] * x[6]; c3 -= A1_1[3] * x[7]; c0 -= A1_2[0] * x[8]; c1 -= A1_2[1] * x[9]; c2 -= A1_2[2] * x[10]; c3 -= A1_2[3] * x[11]; c0 -= A1_3[0] * x[12]; c1 -= A1_3[1] * x[13]; c2 -= A1_3[2] * x[14]; c3 -= A1_3[3] * x[15]; c0 -= A1_4[0] * x[16]; x[17] = (c0 + c1) + (c2 + c3); __builtin_amdgcn_sched_barrier(0);
            A1_0 = *(const LAS f32x4*)(Amv + 1292); A1_1 = *(const LAS f32x4*)(Amv + 1296); A1_2 = *(const LAS f32x4*)(Amv + 1300); A1_3 = *(const LAS f32x4*)(Amv + 1304); A1_4 = *(const LAS f32x4*)(Amv + 1308); r1 = RHS[4864 + c]; __builtin_amdgcn_sched_barrier(0); c0 = r0; c1 = 0.f; c2 = 0.f; c3 = 0.f; c0 -= A0_0[0] * x[0]; c1 -= A0_0[1] * x[1]; c2 -= A0_0[2] * x[2]; c3 -= A0_0[3] * x[3]; c0 -= A0_1[0] * x[4]; c1 -= A0_1[1] * x[5]; c2 -= A0_1[2] * x[6]; c3 -= A0_1[3] * x[7]; c0 -= A0_2[0] * x[8]; c1 -= A0_2[1] * x[9]; c2 -= A0_2[2] * x[10]; c3 -= A0_2[3] * x[11]; c0 -= A0_3[0] * x[12]; c1 -= A0_3[1] * x[13]; c2 -= A0_3[2] * x[14]; c3 -= A0_3[3] * x[15]; c0 -= A0_4[0] * x[16]; c1 -= A0_4[1] * x[17]; x[18] = (c0 + c1) + (c2 + c3); __builtin_amdgcn_sched_barrier(0);
            A0_0 = *(const LAS f32x4*)(Amv + 1360); A0_1 = *(const LAS f32x4*)(Amv + 1364); A0_2 = *(const LAS f32x4*)(Amv + 1368); A0_3 = *(const LAS f32x4*)(Amv + 1372); A0_4 = *(const LAS f32x4*)(Amv + 1376); r0 = RHS[5120 + c]; __builtin_amdgcn_sched_barrier(0); c0 = r1; c1 = 0.f; c2 = 0.f; c3 = 0.f; c0 -= A1_0[0] * x[0]; c1 -= A1_0[1] * x[1]; c2 -= A1_0[2] * x[2]; c3 -= A1_0[3] * x[3]; c0 -= A1_1[0] * x[4]; c1 -= A1_1[1] * x[5]; c2 -= A1_1[2] * x[6]; c3 -= A1_1[3] * x[7]; c0 -= A1_2[0] * x[8]; c1 -= A1_2[1] * x[9]; c2 -= A1_2[2] * x[10]; c3 -= A1_2[3] * x[11]; c0 -= A1_3[0] * x[12]; c1 -= A1_3[1] * x[13]; c2 -= A1_3[2] * x[14]; c3 -= A1_3[3] * x[15]; c0 -= A1_4[0] * x[16]; c1 -= A1_4[1] * x[17]; c2 -= A1_4[2] * x[18]; x[19] = (c0 + c1) + (c2 + c3); __builtin_amdgcn_sched_barrier(0);
            A1_0 = *(const LAS f32x4*)(Amv + 1428); A1_1 = *(const LAS f32x4*)(Amv + 1432); A1_2 = *(const LAS f32x4*)(Amv + 1436); A1_3 = *(const LAS f32x4*)(Amv + 1440); A1_4 = *(const LAS f32x4*)(Amv + 1444); A1_5 = *(const LAS f32x4*)(Amv + 1448); r1 = RHS[5376 + c]; __builtin_amdgcn_sched_barrier(0); c0 = r0; c1 = 0.f; c2 = 0.f; c3 = 0.f; c0 -= A0_0[0] * x[0]; c1 -= A0_0[1] * x[1]; c2 -= A0_0[2] * x[2]; c3 -= A0_0[3] * x[3]; c0 -= A0_1[0] * x[4]; c1 -= A0_1[1] * x[5]; c2 -= A0_1[2] * x[6]; c3 -= A0_1[3] * x[7]; c0 -= A0_2[0] * x[8]; c1 -= A0_2[1] * x[9]; c2 -= A0_2[2] * x[10]; c3 -= A0_2[3] * x[11]; c0 -= A0_3[0] * x[12]; c1 -= A0_3[1] * x[13]; c2 -= A0_3[2] * x[14]; c3 -= A0_3[3] * x[15]; c0 -= A0_4[0] * x[16]; c1 -= A0_4[1] * x[17]; c2 -= A0_4[2] * x[18]; c3 -= A0_4[3] * x[19]; x[20] = (c0 + c1) + (c2 + c3); __builtin_amdgcn_sched_barrier(0);
            A0_0 = *(const LAS f32x4*)(Amv + 1496); A0_1 = *(const LAS f32x4*)(Amv + 1500); A0_2 = *(const LAS f32x4*)(Amv + 1504); A0_3 = *(const LAS f32x4*)(Amv + 1508); A0_4 = *(const LAS f32x4*)(Amv + 1512); A0_5 = *(const LAS f32x4*)(Amv + 1516); r0 = RHS[5632 + c]; __builtin_amdgcn_sched_barrier(0); c0 = r1; c1 = 0.f; c2 = 0.f; c3 = 0.f; c0 -= A1_0[0] * x[0]; c1 -= A1_0[1] * x[1]; c2 -= A1_0[2] * x[2]; c3 -= A1_0[3] * x[3]; c0 -= A1_1[0] * x[4]; c1 -= A1_1[1] * x[5]; c2 -= A1_1[2] * x[6]; c3 -= A1_1[3] * x[7]; c0 -= A1_2[0] * x[8]; c1 -= A1_2[1] * x[9]; c2 -= A1_2[2] * x[10]; c3 -= A1_2[3] * x[11]; c0 -= A1_3[0] * x[12]; c1 -= A1_3[1] * x[13]; c2 -= A1_3[2] * x[14]; c3 -= A1_3[3] * x[15]; c0 -= A1_4[0] * x[16]; c1 -= A1_4[1] * x[17]; c2 -= A1_4[2] * x[18]; c3 -= A1_4[3] * x[19]; c0 -= A1_5[0] * x[20]; x[21] = (c0 + c1) + (c2 + c3); __builtin_amdgcn_sched_barrier(0);
            A1_0 = *(const LAS f32x4*)(Amv + 1564); A1_1 = *(const LAS f32x4*)(Amv + 1568); A1_2 = *(const LAS f32x4*)(Amv + 1572); A1_3 = *(const LAS f32x4*)(Amv + 1576); A1_4 = *(const LAS f32x4*)(Amv + 1580); A1_5 = *(const LAS f32x4*)(Amv + 1584); r1 = RHS[5888 + c]; __builtin_amdgcn_sched_barrier(0); c0 = r0; c1 = 0.f; c2 = 0.f; c3 = 0.f; c0 -= A0_0[0] * x[0]; c1 -= A0_0[1] * x[1]; c2 -= A0_0[2] * x[2]; c3 -= A0_0[3] * x[3]; c0 -= A0_1[0] * x[4]; c1 -= A0_1[1] * x[5]; c2 -= A0_1[2] * x[6]; c3 -= A0_1[3] * x[7]; c0 -= A0_2[0] * x[8]; c1 -= A0_2[1] * x[9]; c2 -= A0_2[2] * x[10]; c3 -= A0_2[3] * x[11]; c0 -= A0_3[0] * x[12]; c1 -= A0_3[1] * x[13]; c2 -= A0_3[2] * x[14]; c3 -= A0_3[3] * x[15]; c0 -= A0_4[0] * x[16]; c1 -= A0_4[1] * x[17]; c2 -= A0_4[2] * x[18]; c3 -= A0_4[3] * x[19]; c0 -= A0_5[0] * x[20]; c1 -= A0_5[1] * x[21]; x[22] = (c0 + c1) + (c2 + c3); __builtin_amdgcn_sched_barrier(0);
            A0_0 = *(const LAS f32x4*)(Amv + 1632); A0_1 = *(const LAS f32x4*)(Amv + 1636); A0_2 = *(const LAS f32x4*)(Amv + 1640); A0_3 = *(const LAS f32x4*)(Amv + 1644); A0_4 = *(const LAS f32x4*)(Amv + 1648); A0_5 = *(const LAS f32x4*)(Amv + 1652); r0 = RHS[6144 + c]; __builtin_amdgcn_sched_barrier(0); c0 = r1; c1 = 0.f; c2 = 0.f; c3 = 0.f; c0 -= A1_0[0] * x[0]; c1 -= A1_0[1] * x[1]; c2 -= A1_0[2] * x[2]; c3 -= A1_0[3] * x[3]; c0 -= A1_1[0] * x[4]; c1 -= A1_1[1] * x[5]; c2 -= A1_1[2] * x[6]; c3 -= A1_1[3] * x[7]; c0 -= A1_2[0] * x[8]; c1 -= A1_2[1] * x[9]; c2 -= A1_2[2] * x[10]; c3 -= A1_2[3] * x[11]; c0 -= A1_3[0] * x[12]; c1 -= A1_3[1] * x[13]; c2 -= A1_3[2] * x[14]; c3 -= A1_3[3] * x[15]; c0 -= A1_4[0] * x[16]; c1 -= A1_4[1] * x[17]; c2 -= A1_4[2] * x[18]; c3 -= A1_4[3] * x[19]; c0 -= A1_5[0] * x[20]; c1 -= A1_5[1] * x[21]; c2 -= A1_5[2] * x[22]; x[23] = (c0 + c1) + (c2 + c3); __builtin_amdgcn_sched_barrier(0);
            A1_0 = *(const LAS f32x4*)(Amv + 1700); A1_1 = *(const LAS f32x4*)(Amv + 1704); A1_2 = *(const LAS f32x4*)(Amv + 1708); A1_3 = *(const LAS f32x4*)(Amv + 1712); A1_4 = *(const LAS f32x4*)(Amv + 1716); A1_5 = *(const LAS f32x4*)(Amv + 1720); A1_6 = *(const LAS f32x4*)(Amv + 1724); r1 = RHS[6400 + c]; __builtin_amdgcn_sched_barrier(0); c0 = r0; c1 = 0.f; c2 = 0.f; c3 = 0.f; c0 -= A0_0[0] * x[0]; c1 -= A0_0[1] * x[1]; c2 -= A0_0[2] * x[2]; c3 -= A0_0[3] * x[3]; c0 -= A0_1[0] * x[4]; c1 -= A0_1[1] * x[5]; c2 -= A0_1[2] * x[6]; c3 -= A0_1[3] * x[7]; c0 -= A0_2[0] * x[8]; c1 -= A0_2[1] * x[9]; c2 -= A0_2[2] * x[10]; c3 -= A0_2[3] * x[11]; c0 -= A0_3[0] * x[12]; c1 -= A0_3[1] * x[13]; c2 -= A0_3[2] * x[14]; c3 -= A0_3[3] * x[15]; c0 -= A0_4[0] * x[16]; c1 -= A0_4[1] * x[17]; c2 -= A0_4[2] * x[18]; c3 -= A0_4[3] * x[19]; c0 -= A0_5[0] * x[20]; c1 -= A0_5[1] * x[21]; c2 -= A0_5[2] * x[22]; c3 -= A0_5[3] * x[23]; x[24] = (c0 + c1) + (c2 + c3); __builtin_amdgcn_sched_barrier(0);
            A0_0 = *(const LAS f32x4*)(Amv + 1768); A0_1 = *(const LAS f32x4*)(Amv + 1772); A0_2 = *(const LAS f32x4*)(Amv + 1776); A0_3 = *(const LAS f32x4*)(Amv + 1780); A0_4 = *(const LAS f32x4*)(Amv + 1784); A0_5 = *(const LAS f32x4*)(Amv + 1788); A0_6 = *(const LAS f32x4*)(Amv + 1792); r0 = RHS[6656 + c]; __builtin_amdgcn_sched_barrier(0); c0 = r1; c1 = 0.f; c2 = 0.f; c3 = 0.f; c0 -= A1_0[0] * x[0]; c1 -= A1_0[1] * x[1]; c2 -= A1_0[2] * x[2]; c3 -= A1_0[3] * x[3]; c0 -= A1_1[0] * x[4]; c1 -= A1_1[1] * x[5]; c2 -= A1_1[2] * x[6]; c3 -= A1_1[3] * x[7]; c0 -= A1_2[0] * x[8]; c1 -= A1_2[1] * x[9]; c2 -= A1_2[2] * x[10]; c3 -= A1_2[3] * x[11]; c0 -= A1_3[0] * x[12]; c1 -= A1_3[1] * x[13]; c2 -= A1_3[2] * x[14]; c3 -= A1_3[3] * x[15]; c0 -= A1_4[0] * x[16]; c1 -= A1_4[1] * x[17]; c2 -= A1_4[2] * x[18]; c3 -= A1_4[3] * x[19]; c0 -= A1_5[0] * x[20]; c1 -= A1_5[1] * x[21]; c2 -= A1_5[2] * x[22]; c3 -= A1_5[3] * x[23]; c0 -= A1_6[0] * x[24]; x[25] = (c0 + c1) + (c2 + c3); __builtin_amdgcn_sched_barrier(0);
            A1_0 = *(const LAS f32x4*)(Amv + 1836); A1_1 = *(const LAS f32x4*)(Amv + 1840); A1_2 = *(const LAS f32x4*)(Amv + 1844); A1_3 = *(const LAS f32x4*)(Amv + 1848); A1_4 = *(const LAS f32x4*)(Amv + 1852); A1_5 = *(const LAS f32x4*)(Amv + 1856); A1_6 = *(const LAS f32x4*)(Amv + 1860); r1 = RHS[6912 + c]; __builtin_amdgcn_sched_barrier(0); c0 = r0; c1 = 0.f; c2 = 0.f; c3 = 0.f; c0 -= A0_0[0] * x[0]; c1 -= A0_0[1] * x[1]; c2 -= A0_0[2] * x[2]; c3 -= A0_0[3] * x[3]; c0 -= A0_1[0] * x[4]; c1 -= A0_1[1] * x[5]; c2 -= A0_1[2] * x[6]; c3 -= A0_1[3] * x[7]; c0 -= A0_2[0] * x[8]; c1 -= A0_2[1] * x[9]; c2 -= A0_2[2] * x[10]; c3 -= A0_2[3] * x[11]; c0 -= A0_3[0] * x[12]; c1 -= A0_3[1] * x[13]; c2 -= A0_3[2] * x[14]; c3 -= A0_3[3] * x[15]; c0 -= A0_4[0] * x[16]; c1 -= A0_4[1] * x[17]; c2 -= A0_4[2] * x[18]; c3 -= A0_4[3] * x[19]; c0 -= A0_5[0] * x[20]; c1 -= A0_5[1] * x[21]; c2 -= A0_5[2] * x[22]; c3 -= A0_5[3] * x[23]; c0 -= A0_6[0] * x[24]; c1 -= A0_6[1] * x[25]; x[26] = (c0 + c1) + (c2 + c3); __builtin_amdgcn_sched_barrier(0);
            A0_0 = *(const LAS f32x4*)(Amv + 1904); A0_1 = *(const LAS f32x4*)(Amv + 1908); A0_2 = *(const LAS f32x4*)(Amv + 1912); A0_3 = *(const LAS f32x4*)(Amv + 1916); A0_4 = *(const LAS f32x4*)(Amv + 1920); A0_5 = *(const LAS f32x4*)(Amv + 1924); A0_6 = *(const LAS f32x4*)(Amv + 1928); r0 = RHS[7168 + c]; __builtin_amdgcn_sched_barrier(0); c0 = r1; c1 = 0.f; c2 = 0.f; c3 = 0.f; c0 -= A1_0[0] * x[0]; c1 -= A1_0[1] * x[1]; c2 -= A1_0[2] * x[2]; c3 -= A1_0[3] * x[3]; c0 -= A1_1[0] * x[4]; c1 -= A1_1[1] * x[5]; c2 -= A1_1[2] * x[6]; c3 -= A1_1[3] * x[7]; c0 -= A1_2[0] * x[8]; c1 -= A1_2[1] * x[9]; c2 -= A1_2[2] * x[10]; c3 -= A1_2[3] * x[11]; c0 -= A1_3[0] * x[12]; c1 -= A1_3[1] * x[13]; c2 -= A1_3[2] * x[14]; c3 -= A1_3[3] * x[15]; c0 -= A1_4[0] * x[16]; c1 -= A1_4[1] * x[17]; c2 -= A1_4[2] * x[18]; c3 -= A1_4[3] * x[19]; c0 -= A1_5[0] * x[20]; c1 -= A1_5[1] * x[21]; c2 -= A1_5[2] * x[22]; c3 -= A1_5[3] * x[23]; c0 -= A1_6[0] * x[24]; c1 -= A1_6[1] * x[25]; c2 -= A1_6[2] * x[26]; x[27] = (c0 + c1) + (c2 + c3); __builtin_amdgcn_sched_barrier(0);
            A1_0 = *(const LAS f32x4*)(Amv + 1972); A1_1 = *(const LAS f32x4*)(Amv + 1976); A1_2 = *(const LAS f32x4*)(Amv + 1980); A1_3 = *(const LAS f32x4*)(Amv + 1984); A1_4 = *(const LAS f32x4*)(Amv + 1988); A1_5 = *(const LAS f32x4*)(Amv + 1992); A1_6 = *(const LAS f32x4*)(Amv + 1996); A1_7 = *(const LAS f32x4*)(Amv + 2000); r1 = RHS[7424 + c]; __builtin_amdgcn_sched_barrier(0); c0 = r0; c1 = 0.f; c2 = 0.f; c3 = 0.f; c0 -= A0_0[0] * x[0]; c1 -= A0_0[1] * x[1]; c2 -= A0_0[2] * x[2]; c3 -= A0_0[3] * x[3]; c0 -= A0_1[0] * x[4]; c1 -= A0_1[1] * x[5]; c2 -= A0_1[2] * x[6]; c3 -= A0_1[3] * x[7]; c0 -= A0_2[0] * x[8]; c1 -= A0_2[1] * x[9]; c2 -= A0_2[2] * x[10]; c3 -= A0_2[3] * x[11]; c0 -= A0_3[0] * x[12]; c1 -= A0_3[1] * x[13]; c2 -= A0_3[2] * x[14]; c3 -= A0_3[3] * x[15]; c0 -= A0_4[0] * x[16]; c1 -= A0_4[1] * x[17]; c2 -= A0_4[2] * x[18]; c3 -= A0_4[3] * x[19]; c0 -= A0_5[0] * x[20]; c1 -= A0_5[1] * x[21]; c2 -= A0_5[2] * x[22]; c3 -= A0_5[3] * x[23]; c0 -= A0_6[0] * x[24]; c1 -= A0_6[1] * x[25]; c2 -= A0_6[2] * x[26]; c3 -= A0_6[3] * x[27]; x[28] = (c0 + c1) + (c2 + c3); __builtin_amdgcn_sched_barrier(0);
            A0_0 = *(const LAS f32x4*)(Amv + 2040); A0_1 = *(const LAS f32x4*)(Amv + 2044); A0_2 = *(const LAS f32x4*)(Amv + 2048); A0_3 = *(const LAS f32x4*)(Amv + 2052); A0_4 = *(const LAS f32x4*)(Amv + 2056); A0_5 = *(const LAS f32x4*)(Amv + 2060); A0_6 = *(const LAS f32x4*)(Amv + 2064); A0_7 = *(const LAS f32x4*)(Amv + 2068); r0 = RHS[7680 + c]; __builtin_amdgcn_sched_barrier(0); c0 = r1; c1 = 0.f; c2 = 0.f; c3 = 0.f; c0 -= A1_0[0] * x[0]; c1 -= A1_0[1] * x[1]; c2 -= A1_0[2] * x[2]; c3 -= A1_0[3] * x[3]; c0 -= A1_1[0] * x[4]; c1 -= A1_1[1] * x[5]; c2 -= A1_1[2] * x[6]; c3 -= A1_1[3] * x[7]; c0 -= A1_2[0] * x[8]; c1 -= A1_2[1] * x[9]; c2 -= A1_2[2] * x[10]; c3 -= A1_2[3] * x[11]; c0 -= A1_3[0] * x[12]; c1 -= A1_3[1] * x[13]; c2 -= A1_3[2] * x[14]; c3 -= A1_3[3] * x[15]; c0 -= A1_4[0] * x[16]; c1 -= A1_4[1] * x[17]; c2 -= A1_4[2] * x[18]; c3 -= A1_4[3] * x[19]; c0 -= A1_5[0] * x[20]; c1 -= A1_5[1] * x[21]; c2 -= A1_5[2] * x[22]; c3 -= A1_5[3] * x[23]; c0 -= A1_6[0] * x[24]; c1 -= A1_6[1] * x[25]; c2 -= A1_6[2] * x[26]; c3 -= A1_6[3] * x[27]; c0 -= A1_7[0] * x[28]; x[29] = (c0 + c1) + (c2 + c3); __builtin_amdgcn_sched_barrier(0);
            A1_0 = *(const LAS f32x4*)(Amv + 2108); A1_1 = *(const LAS f32x4*)(Amv + 2112); A1_2 = *(const LAS f32x4*)(Amv + 2116); A1_3 = *(const LAS f32x4*)(Amv + 2120); A1_4 = *(const LAS f32x4*)(Amv + 2124); A1_5 = *(const LAS f32x4*)(Amv + 2128); A1_6 = *(const LAS f32x4*)(Amv + 2132); A1_7 = *(const LAS f32x4*)(Amv + 2136); r1 = RHS[7936 + c]; __builtin_amdgcn_sched_barrier(0); c0 = r0; c1 = 0.f; c2 = 0.f; c3 = 0.f; c0 -= A0_0[0] * x[0]; c1 -= A0_0[1] * x[1]; c2 -= A0_0[2] * x[2]; c3 -= A0_0[3] * x[3]; c0 -= A0_1[0] * x[4]; c1 -= A0_1[1] * x[5]; c2 -= A0_1[2] * x[6]; c3 -= A0_1[3] * x[7]; c0 -= A0_2[0] * x[8]; c1 -= A0_2[1] * x[9]; c2 -= A0_2[2] * x[10]; c3 -= A0_2[3] * x[11]; c0 -= A0_3[0] * x[12]; c1 -= A0_3[1] * x[13]; c2 -= A0_3[2] * x[14]; c3 -= A0_3[3] * x[15]; c0 -= A0_4[0] * x[16]; c1 -= A0_4[1] * x[17]; c2 -= A0_4[2] * x[18]; c3 -= A0_4[3] * x[19]; c0 -= A0_5[0] * x[20]; c1 -= A0_5[1] * x[21]; c2 -= A0_5[2] * x[22]; c3 -= A0_5[3] * x[23]; c0 -= A0_6[0] * x[24]; c1 -= A0_6[1] * x[25]; c2 -= A0_6[2] * x[26]; c3 -= A0_6[3] * x[27]; c0 -= A0_7[0] * x[28]; c1 -= A0_7[1] * x[29]; x[30] = (c0 + c1) + (c2 + c3); __builtin_amdgcn_sched_barrier(0);
            A0_0 = *(const LAS f32x4*)(Amv + 2176); A0_1 = *(const LAS f32x4*)(Amv + 2180); A0_2 = *(const LAS f32x4*)(Amv + 2184); A0_3 = *(const LAS f32x4*)(Amv + 2188); A0_4 = *(const LAS f32x4*)(Amv + 2192); A0_5 = *(const LAS f32x4*)(Amv + 2196); A0_6 = *(const LAS f32x4*)(Amv + 2200); A0_7 = *(const LAS f32x4*)(Amv + 2204); r0 = RHS[8192 + c]; __builtin_amdgcn_sched_barrier(0); c0 = r1; c1 = 0.f; c2 = 0.f; c3 = 0.f; c0 -= A1_0[0] * x[0]; c1 -= A1_0[1] * x[1]; c2 -= A1_0[2] * x[2]; c3 -= A1_0[3] * x[3]; c0 -= A1_1[0] * x[4]; c1 -= A1_1[1] * x[5]; c2 -= A1_1[2] * x[6]; c3 -= A1_1[3] * x[7]; c0 -= A1_2[0] * x[8]; c1 -= A1_2[1] * x[9]; c2 -= A1_2[2] * x[10]; c3 -= A1_2[3] * x[11]; c0 -= A1_3[0] * x[12]; c1 -= A1_3[1] * x[13]; c2 -= A1_3[2] * x[14]; c3 -= A1_3[3] * x[15]; c0 -= A1_4[0] * x[16]; c1 -= A1_4[1] * x[17]; c2 -= A1_4[2] * x[18]; c3 -= A1_4[3] * x[19]; c0 -= A1_5[0] * x[20]; c1 -= A1_5[1] * x[21]; c2 -= A1_5[2] * x[22]; c3 -= A1_5[3] * x[23]; c0 -= A1_6[0] * x[24]; c1 -= A1_6[1] * x[25]; c2 -= A1_6[2] * x[26]; c3 -= A1_6[3] * x[27]; c0 -= A1_7[0] * x[28]; c1 -= A1_7[1] * x[29]; c2 -= A1_7[2] * x[30]; x[31] = (c0 + c1) + (c2 + c3); __builtin_amdgcn_sched_barrier(0);
            A1_0 = *(const LAS f32x4*)(Amv + 2244); A1_1 = *(const LAS f32x4*)(Amv + 2248); A1_2 = *(const LAS f32x4*)(Amv + 2252); A1_3 = *(const LAS f32x4*)(Amv + 2256); A1_4 = *(const LAS f32x4*)(Amv + 2260); A1_5 = *(const LAS f32x4*)(Amv + 2264); A1_6 = *(const LAS f32x4*)(Amv + 2268); A1_7 = *(const LAS f32x4*)(Amv + 2272); r1 = RHS[8448 + c]; __builtin_amdgcn_sched_barrier(0); c0 = r0; c1 = 0.f; c2 = 0.f; c3 = 0.f; c0 -= A0_0[0] * x[0]; c1 -= A0_0[1] * x[1]; c2 -= A0_0[2] * x[2]; c3 -= A0_0[3] * x[3]; c0 -= A0_1[0] * x[4]; c1 -= A0_1[1] * x[5]; c2 -= A0_1[2] * x[6]; c3 -= A0_1[3] * x[7]; c0 -= A0_2[0] * x[8]; c1 -= A0_2[1] * x[9]; c2 -= A0_2[2] * x[10]; c3 -= A0_2[3] * x[11]; c0 -= A0_3[0] * x[12]; c1 -= A0_3[1] * x[13]; c2 -= A0_3[2] * x[14]; c3 -= A0_3[3] * x[15]; c0 -= A0_4[0] * x[16]; c1 -= A0_4[1] * x[17]; c2 -= A0_4[2] * x[18]; c3 -= A0_4[3] * x[19]; c0 -= A0_5[0] * x[20]; c1 -= A0_5[1] * x[21]; c2 -= A0_5[2] * x[22]; c3 -= A0_5[3] * x[23]; c0 -= A0_6[0] * x[24]; c1 -= A0_6[1] * x[25]; c2 -= A0_6[2] * x[26]; c3 -= A0_6[3] * x[27]; c0 -= A0_7[0] * x[28]; c1 -= A0_7[1] * x[29]; c2 -= A0_7[2] * x[30]; c3 -= A0_7[3] * x[31]; x[32] = (c0 + c1) + (c2 + c3); __builtin_amdgcn_sched_barrier(0);
            A0_0 = *(const LAS f32x4*)(Amv + 2276); __builtin_amdgcn_sched_barrier(0); c0 = r1; c1 = 0.f; c2 = 0.f; c3 = 0.f; c0 -= A1_0[0] * x[0]; c1 -= A1_0[1] * x[1]; c2 -= A1_0[2] * x[2]; c3 -= A1_0[3] * x[3]; c0 -= A1_1[0] * x[4]; c1 -= A1_1[1] * x[5]; c2 -= A1_1[2] * x[6]; c3 -= A1_1[3] * x[7]; c0 -= A1_2[0] * x[8]; c1 -= A1_2[1] * x[9]; c2 -= A1_2[2] * x[10]; c3 -= A1_2[3] * x[11]; c0 -= A1_3[0] * x[12]; c1 -= A1_3[1] * x[13]; c2 -= A1_3[2] * x[14]; c3 -= A1_3[3] * x[15]; c0 -= A1_4[0] * x[16]; c1 -= A1_4[1] * x[17]; c2 -= A1_4[2] * x[18]; c3 -= A1_4[3] * x[19]; c0 -= A1_5[0] * x[20]; c1 -= A1_5[1] * x[21]; c2 -= A1_5[2] * x[22]; c3 -= A1_5[3] * x[23]; c0 -= A1_6[0] * x[24]; c1 -= A1_6[1] * x[25]; c2 -= A1_6[2] * x[26]; c3 -= A1_6[3] * x[27]; c0 -= A1_7[0] * x[28]; c1 -= A1_7[1] * x[29]; c2 -= A1_7[2] * x[30]; c3 -= A1_7[3] * x[31]; __builtin_amdgcn_sched_barrier(0);
            A1_0 = *(const LAS f32x4*)(Amv + 2312); A1_1 = *(const LAS f32x4*)(Amv + 2316); A1_2 = *(const LAS f32x4*)(Amv + 2320); A1_3 = *(const LAS f32x4*)(Amv + 2324); A1_4 = *(const LAS f32x4*)(Amv + 2328); A1_5 = *(const LAS f32x4*)(Amv + 2332); A1_6 = *(const LAS f32x4*)(Amv + 2336); A1_7 = *(const LAS f32x4*)(Amv + 2340); r1 = RHS[8704 + c]; __builtin_amdgcn_sched_barrier(0); c0 -= A0_0[0] * x[32]; x[33] = (c0 + c1) + (c2 + c3); __builtin_amdgcn_sched_barrier(0);
            A0_0 = *(const LAS f32x4*)(Amv + 2344); __builtin_amdgcn_sched_barrier(0); c0 = r1; c1 = 0.f; c2 = 0.f; c3 = 0.f; c0 -= A1_0[0] * x[0]; c1 -= A1_0[1] * x[1]; c2 -= A1_0[2] * x[2]; c3 -= A1_0[3] * x[3]; c0 -= A1_1[0] * x[4]; c1 -= A1_1[1] * x[5]; c2 -= A1_1[2] * x[6]; c3 -= A1_1[3] * x[7]; c0 -= A1_2[0] * x[8]; c1 -= A1_2[1] * x[9]; c2 -= A1_2[2] * x[10]; c3 -= A1_2[3] * x[11]; c0 -= A1_3[0] * x[12]; c1 -= A1_3[1] * x[13]; c2 -= A1_3[2] * x[14]; c3 -= A1_3[3] * x[15]; c0 -= A1_4[0] * x[16]; c1 -= A1_4[1] * x[17]; c2 -= A1_4[2] * x[18]; c3 -= A1_4[3] * x[19]; c0 -= A1_5[0] * x[20]; c1 -= A1_5[1] * x[21]; c2 -= A1_5[2] * x[22]; c3 -= A1_5[3] * x[23]; c0 -= A1_6[0] * x[24]; c1 -= A1_6[1] * x[25]; c2 -= A1_6[2] * x[26]; c3 -= A1_6[3] * x[27]; c0 -= A1_7[0] * x[28]; c1 -= A1_7[1] * x[29]; c2 -= A1_7[2] * x[30]; c3 -= A1_7[3] * x[31]; __builtin_amdgcn_sched_barrier(0);
            A1_0 = *(const LAS f32x4*)(Amv + 2380); A1_1 = *(const LAS f32x4*)(Amv + 2384); A1_2 = *(const LAS f32x4*)(Amv + 2388); A1_3 = *(const LAS f32x4*)(Amv + 2392); A1_4 = *(const LAS f32x4*)(Amv + 2396); A1_5 = *(const LAS f32x4*)(Amv + 2400); A1_6 = *(const LAS f32x4*)(Amv + 2404); A1_7 = *(const LAS f32x4*)(Amv + 2408); r1 = RHS[8960 + c]; __builtin_amdgcn_sched_barrier(0); c0 -= A0_0[0] * x[32]; c1 -= A0_0[1] * x[33]; x[34] = (c0 + c1) + (c2 + c3); __builtin_amdgcn_sched_barrier(0);
            A0_0 = *(const LAS f32x4*)(Amv + 2412); __builtin_amdgcn_sched_barrier(0); c0 = r1; c1 = 0.f; c2 = 0.f; c3 = 0.f; c0 -= A1_0[0] * x[0]; c1 -= A1_0[1] * x[1]; c2 -= A1_0[2] * x[2]; c3 -= A1_0[3] * x[3]; c0 -= A1_1[0] * x[4]; c1 -= A1_1[1] * x[5]; c2 -= A1_1[2] * x[6]; c3 -= A1_1[3] * x[7]; c0 -= A1_2[0] * x[8]; c1 -= A1_2[1] * x[9]; c2 -= A1_2[2] * x[10]; c3 -= A1_2[3] * x[11]; c0 -= A1_3[0] * x[12]; c1 -= A1_3[1] * x[13]; c2 -= A1_3[2] * x[14]; c3 -= A1_3[3] * x[15]; c0 -= A1_4[0] * x[16]; c1 -= A1_4[1] * x[17]; c2 -= A1_4[2] * x[18]; c3 -= A1_4[3] * x[19]; c0 -= A1_5[0] * x[20]; c1 -= A1_5[1] * x[21]; c2 -= A1_5[2] * x[22]; c3 -= A1_5[3] * x[23]; c0 -= A1_6[0] * x[24]; c1 -= A1_6[1] * x[25]; c2 -= A1_6[2] * x[26]; c3 -= A1_6[3] * x[27]; c0 -= A1_7[0] * x[28]; c1 -= A1_7[1] * x[29]; c2 -= A1_7[2] * x[30]; c3 -= A1_7[3] * x[31]; __builtin_amdgcn_sched_barrier(0);
            A1_0 = *(const LAS f32x4*)(Amv + 2448); A1_1 = *(const LAS f32x4*)(Amv + 2452); A1_2 = *(const LAS f32x4*)(Amv + 2456); A1_3 = *(const LAS f32x4*)(Amv + 2460); A1_4 = *(const LAS f32x4*)(Amv + 2464); A1_5 = *(const LAS f32x4*)(Amv + 2468); A1_6 = *(const LAS f32x4*)(Amv + 2472); A1_7 = *(const LAS f32x4*)(Amv + 2476); r1 = RHS[9216 + c]; __builtin_amdgcn_sched_barrier(0); c0 -= A0_0[0] * x[32]; c1 -= A0_0[1] * x[33]; c2 -= A0_0[2] * x[34]; x[35] = (c0 + c1) + (c2 + c3); __builtin_amdgcn_sched_barrier(0);
            A0_0 = *(const LAS f32x4*)(Amv + 2480); __builtin_amdgcn_sched_barrier(0); c0 = r1; c1 = 0.f; c2 = 0.f; c3 = 0.f; c0 -= A1_0[0] * x[0]; c1 -= A1_0[1] * x[1]; c2 -= A1_0[2] * x[2]; c3 -= A1_0[3] * x[3]; c0 -= A1_1[0] * x[4]; c1 -= A1_1[1] * x[5]; c2 -= A1_1[2] * x[6]; c3 -= A1_1[3] * x[7]; c0 -= A1_2[0] * x[8]; c1 -= A1_2[1] * x[9]; c2 -= A1_2[2] * x[10]; c3 -= A1_2[3] * x[11]; c0 -= A1_3[0] * x[12]; c1 -= A1_3[1] * x[13]; c2 -= A1_3[2] * x[14]; c3 -= A1_3[3] * x[15]; c0 -= A1_4[0] * x[16]; c1 -= A1_4[1] * x[17]; c2 -= A1_4[2] * x[18]; c3 -= A1_4[3] * x[19]; c0 -= A1_5[0] * x[20]; c1 -= A1_5[1] * x[21]; c2 -= A1_5[2] * x[22]; c3 -= A1_5[3] * x[23]; c0 -= A1_6[0] * x[24]; c1 -= A1_6[1] * x[25]; c2 -= A1_6[2] * x[26]; c3 -= A1_6[3] * x[27]; c0 -= A1_7[0] * x[28]; c1 -= A1_7[1] * x[29]; c2 -= A1_7[2] * x[30]; c3 -= A1_7[3] * x[31]; __builtin_amdgcn_sched_barrier(0);
            A1_0 = *(const LAS f32x4*)(Amv + 2516); A1_1 = *(const LAS f32x4*)(Amv + 2520); A1_2 = *(const LAS f32x4*)(Amv + 2524); A1_3 = *(const LAS f32x4*)(Amv + 2528); A1_4 = *(const LAS f32x4*)(Amv + 2532); A1_5 = *(const LAS f32x4*)(Amv + 2536); A1_6 = *(const LAS f32x4*)(Amv + 2540); A1_7 = *(const LAS f32x4*)(Amv + 2544); r1 = RHS[9472 + c]; __builtin_amdgcn_sched_barrier(0); c0 -= A0_0[0] * x[32]; c1 -= A0_0[1] * x[33]; c2 -= A0_0[2] * x[34]; c3 -= A0_0[3] * x[35]; x[36] = (c0 + c1) + (c2 + c3); __builtin_amdgcn_sched_barrier(0);
            A0_0 = *(const LAS f32x4*)(Amv + 2548); A0_1 = *(const LAS f32x4*)(Amv + 2552); __builtin_amdgcn_sched_barrier(0); c0 = r1; c1 = 0.f; c2 = 0.f; c3 = 0.f; c0 -= A1_0[0] * x[0]; c1 -= A1_0[1] * x[1]; c2 -= A1_0[2] * x[2]; c3 -= A1_0[3] * x[3]; c0 -= A1_1[0] * x[4]; c1 -= A1_1[1] * x[5]; c2 -= A1_1[2] * x[6]; c3 -= A1_1[3] * x[7]; c0 -= A1_2[0] * x[8]; c1 -= A1_2[1] * x[9]; c2 -= A1_2[2] * x[10]; c3 -= A1_2[3] * x[11]; c0 -= A1_3[0] * x[12]; c1 -= A1_3[1] * x[13]; c2 -= A1_3[2] * x[14]; c3 -= A1_3[3] * x[15]; c0 -= A1_4[0] * x[16]; c1 -= A1_4[1] * x[17]; c2 -= A1_4[2] * x[18]; c3 -= A1_4[3] * x[19]; c0 -= A1_5[0] * x[20]; c1 -= A1_5[1] * x[21]; c2 -= A1_5[2] * x[22]; c3 -= A1_5[3] * x[23]; c0 -= A1_6[0] * x[24]; c1 -= A1_6[1] * x[25]; c2 -= A1_6[2] * x[26]; c3 -= A1_6[3] * x[27]; c0 -= A1_7[0] * x[28]; c1 -= A1_7[1] * x[29]; c2 -= A1_7[2] * x[30]; c3 -= A1_7[3] * x[31]; __builtin_amdgcn_sched_barrier(0);
            A1_0 = *(const LAS f32x4*)(Amv + 2584); A1_1 = *(const LAS f32x4*)(Amv + 2588); A1_2 = *(const LAS f32x4*)(Amv + 2592); A1_3 = *(const LAS f32x4*)(Amv + 2596); A1_4 = *(const LAS f32x4*)(Amv + 2600); A1_5 = *(const LAS f32x4*)(Amv + 2604); A1_6 = *(const LAS f32x4*)(Amv + 2608); A1_7 = *(const LAS f32x4*)(Amv + 2612); r1 = RHS[9728 + c]; __builtin_amdgcn_sched_barrier(0); c0 -= A0_0[0] * x[32]; c1 -= A0_0[1] * x[33]; c2 -= A0_0[2] * x[34]; c3 -= A0_0[3] * x[35]; c0 -= A0_1[0] * x[36]; x[37] = (c0 + c1) + (c2 + c3); __builtin_amdgcn_sched_barrier(0);
            A0_0 = *(const LAS f32x4*)(Amv + 2616); A0_1 = *(const LAS f32x4*)(Amv + 2620); __builtin_amdgcn_sched_barrier(0); c0 = r1; c1 = 0.f; c2 = 0.f; c3 = 0.f; c0 -= A1_0[0] * x[0]; c1 -= A1_0[1] * x[1]; c2 -= A1_0[2] * x[2]; c3 -= A1_0[3] * x[3]; c0 -= A1_1[0] * x[4]; c1 -= A1_1[1] * x[5]; c2 -= A1_1[2] * x[6]; c3 -= A1_1[3] * x[7]; c0 -= A1_2[0] * x[8]; c1 -= A1_2[1] * x[9]; c2 -= A1_2[2] * x[10]; c3 -= A1_2[3] * x[11]; c0 -= A1_3[0] * x[12]; c1 -= A1_3[1] * x[13]; c2 -= A1_3[2] * x[14]; c3 -= A1_3[3] * x[15]; c0 -= A1_4[0] * x[16]; c1 -= A1_4[1] * x[17]; c2 -= A1_4[2] * x[18]; c3 -= A1_4[3] * x[19]; c0 -= A1_5[0] * x[20]; c1 -= A1_5[1] * x[21]; c2 -= A1_5[2] * x[22]; c3 -= A1_5[3] * x[23]; c0 -= A1_6[0] * x[24]; c1 -= A1_6[1] * x[25]; c2 -= A1_6[2] * x[26]; c3 -= A1_6[3] * x[27]; c0 -= A1_7[0] * x[28]; c1 -= A1_7[1] * x[29]; c2 -= A1_7[2] * x[30]; c3 -= A1_7[3] * x[31]; __builtin_amdgcn_sched_barrier(0);
            A1_0 = *(const LAS f32x4*)(Amv + 2652); A1_1 = *(const LAS f32x4*)(Amv + 2656); A1_2 = *(const LAS f32x4*)(Amv + 2660); A1_3 = *(const LAS f32x4*)(Amv + 2664); A1_4 = *(const LAS f32x4*)(Amv + 2668); A1_5 = *(const LAS f32x4*)(Amv + 2672); A1_6 = *(const LAS f32x4*)(Amv + 2676); A1_7 = *(const LAS f32x4*)(Amv + 2680); r1 = RHS[9984 + c]; __builtin_amdgcn_sched_barrier(0); c0 -= A0_0[0] * x[32]; c1 -= A0_0[1] * x[33]; c2 -= A0_0[2] * x[34]; c3 -= A0_0[3] * x[35]; c0 -= A0_1[0] * x[36]; c1 -= A0_1[1] * x[37]; x[38] = (c0 + c1) + (c2 + c3); __builtin_amdgcn_sched_barrier(0);
            A0_0 = *(const LAS f32x4*)(Amv + 2684); A0_1 = *(const LAS f32x4*)(Amv + 2688); __builtin_amdgcn_sched_barrier(0); c0 = r1; c1 = 0.f; c2 = 0.f; c3 = 0.f; c0 -= A1_0[0] * x[0]; c1 -= A1_0[1] * x[1]; c2 -= A1_0[2] * x[2]; c3 -= A1_0[3] * x[3]; c0 -= A1_1[0] * x[4]; c1 -= A1_1[1] * x[5]; c2 -= A1_1[2] * x[6]; c3 -= A1_1[3] * x[7]; c0 -= A1_2[0] * x[8]; c1 -= A1_2[1] * x[9]; c2 -= A1_2[2] * x[10]; c3 -= A1_2[3] * x[11]; c0 -= A1_3[0] * x[12]; c1 -= A1_3[1] * x[13]; c2 -= A1_3[2] * x[14]; c3 -= A1_3[3] * x[15]; c0 -= A1_4[0] * x[16]; c1 -= A1_4[1] * x[17]; c2 -= A1_4[2] * x[18]; c3 -= A1_4[3] * x[19]; c0 -= A1_5[0] * x[20]; c1 -= A1_5[1] * x[21]; c2 -= A1_5[2] * x[22]; c3 -= A1_5[3] * x[23]; c0 -= A1_6[0] * x[24]; c1 -= A1_6[1] * x[25]; c2 -= A1_6[2] * x[26]; c3 -= A1_6[3] * x[27]; c0 -= A1_7[0] * x[28]; c1 -= A1_7[1] * x[29]; c2 -= A1_7[2] * x[30]; c3 -= A1_7[3] * x[31]; __builtin_amdgcn_sched_barrier(0);
            A1_0 = *(const LAS f32x4*)(Amv + 2720); A1_1 = *(const LAS f32x4*)(Amv + 2724); A1_2 = *(const LAS f32x4*)(Amv + 2728); A1_3 = *(const LAS f32x4*)(Amv + 2732); A1_4 = *(const LAS f32x4*)(Amv + 2736); A1_5 = *(const LAS f32x4*)(Amv + 2740); A1_6 = *(const LAS f32x4*)(Amv + 2744); A1_7 = *(const LAS f32x4*)(Amv + 2748); r1 = RHS[10240 + c]; __builtin_amdgcn_sched_barrier(0); c0 -= A0_0[0] * x[32]; c1 -= A0_0[1] * x[33]; c2 -= A0_0[2] * x[34]; c3 -= A0_0[3] * x[35]; c0 -= A0_1[0] * x[36]; c1 -= A0_1[1] * x[37]; c2 -= A0_1[2] * x[38]; x[39] = (c0 + c1) + (c2 + c3); __builtin_amdgcn_sched_barrier(0);
            A0_0 = *(const LAS f32x4*)(Amv + 2752); A0_1 = *(const LAS f32x4*)(Amv + 2756); __builtin_amdgcn_sched_barrier(0); c0 = r1; c1 = 0.f; c2 = 0.f; c3 = 0.f; c0 -= A1_0[0] * x[0]; c1 -= A1_0[1] * x[1]; c2 -= A1_0[2] * x[2]; c3 -= A1_0[3] * x[3]; c0 -= A1_1[0] * x[4]; c1 -= A1_1[1] * x[5]; c2 -= A1_1[2] * x[6]; c3 -= A1_1[3] * x[7]; c0 -= A1_2[0] * x[8]; c1 -= A1_2[1] * x[9]; c2 -= A1_2[2] * x[10]; c3 -= A1_2[3] * x[11]; c0 -= A1_3[0] * x[12]; c1 -= A1_3[1] * x[13]; c2 -= A1_3[2] * x[14]; c3 -= A1_3[3] * x[15]; c0 -= A1_4[0] * x[16]; c1 -= A1_4[1] * x[17]; c2 -= A1_4[2] * x[18]; c3 -= A1_4[3] * x[19]; c0 -= A1_5[0] * x[20]; c1 -= A1_5[1] * x[21]; c2 -= A1_5[2] * x[22]; c3 -= A1_5[3] * x[23]; c0 -= A1_6[0] * x[24]; c1 -= A1_6[1] * x[25]; c2 -= A1_6[2] * x[26]; c3 -= A1_6[3] * x[27]; c0 -= A1_7[0] * x[28]; c1 -= A1_7[1] * x[29]; c2 -= A1_7[2] * x[30]; c3 -= A1_7[3] * x[31]; __builtin_amdgcn_sched_barrier(0);
            A1_0 = *(const LAS f32x4*)(Amv + 2788); A1_1 = *(const LAS f32x4*)(Amv + 2792); A1_2 = *(const LAS f32x4*)(Amv + 2796); A1_3 = *(const LAS f32x4*)(Amv + 2800); A1_4 = *(const LAS f32x4*)(Amv + 2804); A1_5 = *(const LAS f32x4*)(Amv + 2808); A1_6 = *(const LAS f32x4*)(Amv + 2812); A1_7 = *(const LAS f32x4*)(Amv + 2816); r1 = RHS[10496 + c]; __builtin_amdgcn_sched_barrier(0); c0 -= A0_0[0] * x[32]; c1 -= A0_0[1] * x[33]; c2 -= A0_0[2] * x[34]; c3 -= A0_0[3] * x[35]; c0 -= A0_1[0] * x[36]; c1 -= A0_1[1] * x[37]; c2 -= A0_1[2] * x[38]; c3 -= A0_1[3] * x[39]; x[40] = (c0 + c1) + (c2 + c3); __builtin_amdgcn_sched_barrier(0);
            A0_0 = *(const LAS f32x4*)(Amv + 2820); A0_1 = *(const LAS f32x4*)(Amv + 2824); A0_2 = *(const LAS f32x4*)(Amv + 2828); __builtin_amdgcn_sched_barrier(0); c0 = r1; c1 = 0.f; c2 = 0.f; c3 = 0.f; c0 -= A1_0[0] * x[0]; c1 -= A1_0[1] * x[1]; c2 -= A1_0[2] * x[2]; c3 -= A1_0[3] * x[3]; c0 -= A1_1[0] * x[4]; c1 -= A1_1[1] * x[5]; c2 -= A1_1[2] * x[6]; c3 -= A1_1[3] * x[7]; c0 -= A1_2[0] * x[8]; c1 -= A1_2[1] * x[9]; c2 -= A1_2[2] * x[10]; c3 -= A1_2[3] * x[11]; c0 -= A1_3[0] * x[12]; c1 -= A1_3[1] * x[13]; c2 -= A1_3[2] * x[14]; c3 -= A1_3[3] * x[15]; c0 -= A1_4[0] * x[16]; c1 -= A1_4[1] * x[17]; c2 -= A1_4[2] * x[18]; c3 -= A1_4[3] * x[19]; c0 -= A1_5[0] * x[20]; c1 -= A1_5[1] * x[21]; c2 -= A1_5[2] * x[22]; c3 -= A1_5[3] * x[23]; c0 -= A1_6[0] * x[24]; c1 -= A1_6[1] * x[25]; c2 -= A1_6[2] * x[26]; c3 -= A1_6[3] * x[27]; c0 -= A1_7[0] * x[28]; c1 -= A1_7[1] * x[29]; c2 -= A1_7[2] * x[30]; c3 -= A1_7[3] * x[31]; __builtin_amdgcn_sched_barrier(0);
            A1_0 = *(const LAS f32x4*)(Amv + 2856); A1_1 = *(const LAS f32x4*)(Amv + 2860); A1_2 = *(const LAS f32x4*)(Amv + 2864); A1_3 = *(const LAS f32x4*)(Amv + 2868); A1_4 = *(const LAS f32x4*)(Amv + 2872); A1_5 = *(const LAS f32x4*)(Amv + 2876); A1_6 = *(const LAS f32x4*)(Amv + 2880); A1_7 = *(const LAS f32x4*)(Amv + 2884); r1 = RHS[10752 + c]; __builtin_amdgcn_sched_barrier(0); c0 -= A0_0[0] * x[32]; c1 -= A0_0[1] * x[33]; c2 -= A0_0[2] * x[34]; c3 -= A0_0[3] * x[35]; c0 -= A0_1[0] * x[36]; c1 -= A0_1[1] * x[37]; c2 -= A0_1[2] * x[38]; c3 -= A0_1[3] * x[39]; c0 -= A0_2[0] * x[40]; x[41] = (c0 + c1) + (c2 + c3); __builtin_amdgcn_sched_barrier(0);
            A0_0 = *(const LAS f32x4*)(Amv + 2888); A0_1 = *(const LAS f32x4*)(Amv + 2892); A0_2 = *(const LAS f32x4*)(Amv + 2896); __builtin_amdgcn_sched_barrier(0); c0 = r1; c1 = 0.f; c2 = 0.f; c3 = 0.f; c0 -= A1_0[0] * x[0]; c1 -= A1_0[1] * x[1]; c2 -= A1_0[2] * x[2]; c3 -= A1_0[3] * x[3]; c0 -= A1_1[0] * x[4]; c1 -= A1_1[1] * x[5]; c2 -= A1_1[2] * x[6]; c3 -= A1_1[3] * x[7]; c0 -= A1_2[0] * x[8]; c1 -= A1_2[1] * x[9]; c2 -= A1_2[2] * x[10]; c3 -= A1_2[3] * x[11]; c0 -= A1_3[0] * x[12]; c1 -= A1_3[1] * x[13]; c2 -= A1_3[2] * x[14]; c3 -= A1_3[3] * x[15]; c0 -= A1_4[0] * x[16]; c1 -= A1_4[1] * x[17]; c2 -= A1_4[2] * x[18]; c3 -= A1_4[3] * x[19]; c0 -= A1_5[0] * x[20]; c1 -= A1_5[1] * x[21]; c2 -= A1_5[2] * x[22]; c3 -= A1_5[3] * x[23]; c0 -= A1_6[0] * x[24]; c1 -= A1_6[1] * x[25]; c2 -= A1_6[2] * x[26]; c3 -= A1_6[3] * x[27]; c0 -= A1_7[0] * x[28]; c1 -= A1_7[1] * x[29]; c2 -= A1_7[2] * x[30]; c3 -= A1_7[3] * x[31]; __builtin_amdgcn_sched_barrier(0);
            A1_0 = *(const LAS f32x4*)(Amv + 2924); A1_1 = *(const LAS f32x4*)(Amv + 2928); A1_2 = *(const LAS f32x4*)(Amv + 2932); A1_3 = *(const LAS f32x4*)(Amv + 2936); A1_4 = *(const LAS f32x4*)(Amv + 2940); A1_5 = *(const LAS f32x4*)(Amv + 2944); A1_6 = *(const LAS f32x4*)(Amv + 2948); A1_7 = *(const LAS f32x4*)(Amv + 2952); r1 = RHS[11008 + c]; __builtin_amdgcn_sched_barrier(0); c0 -= A0_0[0] * x[32]; c1 -= A0_0[1] * x[33]; c2 -= A0_0[2] * x[34]; c3 -= A0_0[3] * x[35]; c0 -= A0_1[0] * x[36]; c1 -= A0_1[1] * x[37]; c2 -= A0_1[2] * x[38]; c3 -= A0_1[3] * x[39]; c0 -= A0_2[0] * x[40]; c1 -= A0_2[1] * x[41]; x[42] = (c0 + c1) + (c2 + c3); __builtin_amdgcn_sched_barrier(0);
            A0_0 = *(const LAS f32x4*)(Amv + 2956); A0_1 = *(const LAS f32x4*)(Amv + 2960); A0_2 = *(const LAS f32x4*)(Amv + 2964); __builtin_amdgcn_sched_barrier(0); c0 = r1; c1 = 0.f; c2 = 0.f; c3 = 0.f; c0 -= A1_0[0] * x[0]; c1 -= A1_0[1] * x[1]; c2 -= A1_0[2] * x[2]; c3 -= A1_0[3] * x[3]; c0 -= A1_1[0] * x[4]; c1 -= A1_1[1] * x[5]; c2 -= A1_1[2] * x[6]; c3 -= A1_1[3] * x[7]; c0 -= A1_2[0] * x[8]; c1 -= A1_2[1] * x[9]; c2 -= A1_2[2] * x[10]; c3 -= A1_2[3] * x[11]; c0 -= A1_3[0] * x[12]; c1 -= A1_3[1] * x[13]; c2 -= A1_3[2] * x[14]; c3 -= A1_3[3] * x[15]; c0 -= A1_4[0] * x[16]; c1 -= A1_4[1] * x[17]; c2 -= A1_4[2] * x[18]; c3 -= A1_4[3] * x[19]; c0 -= A1_5[0] * x[20]; c1 -= A1_5[1] * x[21]; c2 -= A1_5[2] * x[22]; c3 -= A1_5[3] * x[23]; c0 -= A1_6[0] * x[24]; c1 -= A1_6[1] * x[25]; c2 -= A1_6[2] * x[26]; c3 -= A1_6[3] * x[27]; c0 -= A1_7[0] * x[28]; c1 -= A1_7[1] * x[29]; c2 -= A1_7[2] * x[30]; c3 -= A1_7[3] * x[31]; __builtin_amdgcn_sched_barrier(0);
            A1_0 = *(const LAS f32x4*)(Amv + 2992); A1_1 = *(const LAS f32x4*)(Amv + 2996); A1_2 = *(const LAS f32x4*)(Amv + 3000); A1_3 = *(const LAS f32x4*)(Amv + 3004); A1_4 = *(const LAS f32x4*)(Amv + 3008); A1_5 = *(const LAS f32x4*)(Amv + 3012); A1_6 = *(const LAS f32x4*)(Amv + 3016); A1_7 = *(const LAS f32x4*)(Amv + 3020); r1 = RHS[11264 + c]; __builtin_amdgcn_sched_barrier(0); c0 -= A0_0[0] * x[32]; c1 -= A0_0[1] * x[33]; c2 -= A0_0[2] * x[34]; c3 -= A0_0[3] * x[35]; c0 -= A0_1[0] * x[36]; c1 -= A0_1[1] * x[37]; c2 -= A0_1[2] * x[38]; c3 -= A0_1[3] * x[39]; c0 -= A0_2[0] * x[40]; c1 -= A0_2[1] * x[41]; c2 -= A0_2[2] * x[42]; x[43] = (c0 + c1) + (c2 + c3); __builtin_amdgcn_sched_barrier(0);
            A0_0 = *(const LAS f32x4*)(Amv + 3024); A0_1 = *(const LAS f32x4*)(Amv + 3028); A0_2 = *(const LAS f32x4*)(Amv + 3032); __builtin_amdgcn_sched_barrier(0); c0 = r1; c1 = 0.f; c2 = 0.f; c3 = 0.f; c0 -= A1_0[0] * x[0]; c1 -= A1_0[1] * x[1]; c2 -= A1_0[2] * x[2]; c3 -= A1_0[3] * x[3]; c0 -= A1_1[0] * x[4]; c1 -= A1_1[1] * x[5]; c2 -= A1_1[2] * x[6]; c3 -= A1_1[3] * x[7]; c0 -= A1_2[0] * x[8]; c1 -= A1_2[1] * x[9]; c2 -= A1_2[2] * x[10]; c3 -= A1_2[3] * x[11]; c0 -= A1_3[0] * x[12]; c1 -= A1_3[1] * x[13]; c2 -= A1_3[2] * x[14]; c3 -= A1_3[3] * x[15]; c0 -= A1_4[0] * x[16]; c1 -= A1_4[1] * x[17]; c2 -= A1_4[2] * x[18]; c3 -= A1_4[3] * x[19]; c0 -= A1_5[0] * x[20]; c1 -= A1_5[1] * x[21]; c2 -= A1_5[2] * x[22]; c3 -= A1_5[3] * x[23]; c0 -= A1_6[0] * x[24]; c1 -= A1_6[1] * x[25]; c2 -= A1_6[2] * x[26]; c3 -= A1_6[3] * x[27]; c0 -= A1_7[0] * x[28]; c1 -= A1_7[1] * x[29]; c2 -= A1_7[2] * x[30]; c3 -= A1_7[3] * x[31]; __builtin_amdgcn_sched_barrier(0);
            A1_0 = *(const LAS f32x4*)(Amv + 3060); A1_1 = *(const LAS f32x4*)(Amv + 3064); A1_2 = *(const LAS f32x4*)(Amv + 3068); A1_3 = *(const LAS f32x4*)(Amv + 3072); A1_4 = *(const LAS f32x4*)(Amv + 3076); A1_5 = *(const LAS f32x4*)(Amv + 3080); A1_6 = *(const LAS f32x4*)(Amv + 3084); A1_7 = *(const LAS f32x4*)(Amv + 3088); r1 = RHS[11520 + c]; __builtin_amdgcn_sched_barrier(0); c0 -= A0_0[0] * x[32]; c1 -= A0_0[1] * x[33]; c2 -= A0_0[2] * x[34]; c3 -= A0_0[3] * x[35]; c0 -= A0_1[0] * x[36]; c1 -= A0_1[1] * x[37]; c2 -= A0_1[2] * x[38]; c3 -= A0_1[3] * x[39]; c0 -= A0_2[0] * x[40]; c1 -= A0_2[1] * x[41]; c2 -= A0_2[2] * x[42]; c3 -= A0_2[3] * x[43]; x[44] = (c0 + c1) + (c2 + c3); __builtin_amdgcn_sched_barrier(0);
            A0_0 = *(const LAS f32x4*)(Amv + 3092); A0_1 = *(const LAS f32x4*)(Amv + 3096); A0_2 = *(const LAS f32x4*)(Amv + 3100); A0_3 = *(const LAS f32x4*)(Amv + 3104); __builtin_amdgcn_sched_barrier(0); c0 = r1; c1 = 0.f; c2 = 0.f; c3 = 0.f; c0 -= A1_0[0] * x[0]; c1 -= A1_0[1] * x[1]; c2 -= A1_0[2] * x[2]; c3 -= A1_0[3] * x[3]; c0 -= A1_1[0] * x[4]; c1 -= A1_1[1] * x[5]; c2 -= A1_1[2] * x[6]; c3 -= A1_1[3] * x[7]; c0 -= A1_2[0] * x[8]; c1 -= A1_2[1] * x[9]; c2 -= A1_2[2] * x[10]; c3 -= A1_2[3] * x[11]; c0 -= A1_3[0] * x[12]; c1 -= A1_3[1] * x[13]; c2 -= A1_3[2] * x[14]; c3 -= A1_3[3] * x[15]; c0 -= A1_4[0] * x[16]; c1 -= A1_4[1] * x[17]; c2 -= A1_4[2] * x[18]; c3 -= A1_4[3] * x[19]; c0 -= A1_5[0] * x[20]; c1 -= A1_5[1] * x[21]; c2 -= A1_5[2] * x[22]; c3 -= A1_5[3] * x[23]; c0 -= A1_6[0] * x[24]; c1 -= A1_6[1] * x[25]; c2 -= A1_6[2] * x[26]; c3 -= A1_6[3] * x[27]; c0 -= A1_7[0] * x[28]; c1 -= A1_7[1] * x[29]; c2 -= A1_7[2] * x[30]; c3 -= A1_7[3] * x[31]; __builtin_amdgcn_sched_barrier(0);
            A1_0 = *(const LAS f32x4*)(Amv + 3128); A1_1 = *(const LAS f32x4*)(Amv + 3132); A1_2 = *(const LAS f32x4*)(Amv + 3136); A1_3 = *(const LAS f32x4*)(Amv + 3140); A1_4 = *(const LAS f32x4*)(Amv + 3144); A1_5 = *(const LAS f32x4*)(Amv + 3148); A1_6 = *(const LAS f32x4*)(Amv + 3152); A1_7 = *(const LAS f32x4*)(Amv + 3156); r1 = RHS[11776 + c]; __builtin_amdgcn_sched_barrier(0); c0 -= A0_0[0] * x[32]; c1 -= A0_0[1] * x[33]; c2 -= A0_0[2] * x[34]; c3 -= A0_0[3] * x[35]; c0 -= A0_1[0] * x[36]; c1 -= A0_1[1] * x[37]; c2 -= A0_1[2] * x[38]; c3 -= A0_1[3] * x[39]; c0 -= A0_2[0] * x[40]; c1 -= A0_2[1] * x[41]; c2 -= A0_2[2] * x[42]; c3 -= A0_2[3] * x[43]; c0 -= A0_3[0] * x[44]; x[45] = (c0 + c1) + (c2 + c3); __builtin_amdgcn_sched_barrier(0);
            A0_0 = *(const LAS f32x4*)(Amv + 3160); A0_1 = *(const LAS f32x4*)(Amv + 3164); A0_2 = *(const LAS f32x4*)(Amv + 3168); A0_3 = *(const LAS f32x4*)(Amv + 3172); __builtin_amdgcn_sched_barrier(0); c0 = r1; c1 = 0.f; c2 = 0.f; c3 = 0.f; c0 -= A1_0[0] * x[0]; c1 -= A1_0[1] * x[1]; c2 -= A1_0[2] * x[2]; c3 -= A1_0[3] * x[3]; c0 -= A1_1[0] * x[4]; c1 -= A1_1[1] * x[5]; c2 -= A1_1[2] * x[6]; c3 -= A1_1[3] * x[7]; c0 -= A1_2[0] * x[8]; c1 -= A1_2[1] * x[9]; c2 -= A1_2[2] * x[10]; c3 -= A1_2[3] * x[11]; c0 -= A1_3[0] * x[12]; c1 -= A1_3[1] * x[13]; c2 -= A1_3[2] * x[14]; c3 -= A1_3[3] * x[15]; c0 -= A1_4[0] * x[16]; c1 -= A1_4[1] * x[17]; c2 -= A1_4[2] * x[18]; c3 -= A1_4[3] * x[19]; c0 -= A1_5[0] * x[20]; c1 -= A1_5[1] * x[21]; c2 -= A1_5[2] * x[22]; c3 -= A1_5[3] * x[23]; c0 -= A1_6[0] * x[24]; c1 -= A1_6[1] * x[25]; c2 -= A1_6[2] * x[26]; c3 -= A1_6[3] * x[27]; c0 -= A1_7[0] * x[28]; c1 -= A1_7[1] * x[29]; c2 -= A1_7[2] * x[30]; c3 -= A1_7[3] * x[31]; __builtin_amdgcn_sched_barrier(0);
            A1_0 = *(const LAS f32x4*)(Amv + 3196); A1_1 = *(const LAS f32x4*)(Amv + 3200); A1_2 = *(const LAS f32x4*)(Amv + 3204); A1_3 = *(const LAS f32x4*)(Amv + 3208); A1_4 = *(const LAS f32x4*)(Amv + 3212); A1_5 = *(const LAS f32x4*)(Amv + 3216); A1_6 = *(const LAS f32x4*)(Amv + 3220); A1_7 = *(const LAS f32x4*)(Amv + 3224); r1 = RHS[12032 + c]; __builtin_amdgcn_sched_barrier(0); c0 -= A0_0[0] * x[32]; c1 -= A0_0[1] * x[33]; c2 -= A0_0[2] * x[34]; c3 -= A0_0[3] * x[35]; c0 -= A0_1[0] * x[36]; c1 -= A0_1[1] * x[37]; c2 -= A0_1[2] * x[38]; c3 -= A0_1[3] * x[39]; c0 -= A0_2[0] * x[40]; c1 -= A0_2[1] * x[41]; c2 -= A0_2[2] * x[42]; c3 -= A0_2[3] * x[43]; c0 -= A0_3[0] * x[44]; c1 -= A0_3[1] * x[45]; x[46] = (c0 + c1) + (c2 + c3); __builtin_amdgcn_sched_barrier(0);
            A0_0 = *(const LAS f32x4*)(Amv + 3228); A0_1 = *(const LAS f32x4*)(Amv + 3232); A0_2 = *(const LAS f32x4*)(Amv + 3236); A0_3 = *(const LAS f32x4*)(Amv + 3240); __builtin_amdgcn_sched_barrier(0); c0 = r1; c1 = 0.f; c2 = 0.f; c3 = 0.f; c0 -= A1_0[0] * x[0]; c1 -= A1_0[1] * x[1]; c2 -= A1_0[2] * x[2]; c3 -= A1_0[3] * x[3]; c0 -= A1_1[0] * x[4]; c1 -= A1_1[1] * x[5]; c2 -= A1_1[2] * x[6]; c3 -= A1_1[3] * x[7]; c0 -= A1_2[0] * x[8]; c1 -= A1_2[1] * x[9]; c2 -= A1_2[2] * x[10]; c3 -= A1_2[3] * x[11]; c0 -= A1_3[0] * x[12]; c1 -= A1_3[1] * x[13]; c2 -= A1_3[2] * x[14]; c3 -= A1_3[3] * x[15]; c0 -= A1_4[0] * x[16]; c1 -= A1_4[1] * x[17]; c2 -= A1_4[2] * x[18]; c3 -= A1_4[3] * x[19]; c0 -= A1_5[0] * x[20]; c1 -= A1_5[1] * x[21]; c2 -= A1_5[2] * x[22]; c3 -= A1_5[3] * x[23]; c0 -= A1_6[0] * x[24]; c1 -= A1_6[1] * x[25]; c2 -= A1_6[2] * x[26]; c3 -= A1_6[3] * x[27]; c0 -= A1_7[0] * x[28]; c1 -= A1_7[1] * x[29]; c2 -= A1_7[2] * x[30]; c3 -= A1_7[3] * x[31]; __builtin_amdgcn_sched_barrier(0);
            A1_0 = *(const LAS f32x4*)(Amv + 3264); A1_1 = *(const LAS f32x4*)(Amv + 3268); A1_2 = *(const LAS f32x4*)(Amv + 3272); A1_3 = *(const LAS f32x4*)(Amv + 3276); A1_4 = *(const LAS f32x4*)(Amv + 3280); A1_5 = *(const LAS f32x4*)(Amv + 3284); A1_6 = *(const LAS f32x4*)(Amv + 3288); A1_7 = *(const LAS f32x4*)(Amv + 3292); r1 = RHS[12288 + c]; __builtin_amdgcn_sched_barrier(0); c0 -= A0_0[0] * x[32]; c1 -= A0_0[1] * x[33]; c2 -= A0_0[2] * x[34]; c3 -= A0_0[3] * x[35]; c0 -= A0_1[0] * x[36]; c1 -= A0_1[1] * x[37]; c2 -= A0_1[2] * x[38]; c3 -= A0_1[3] * x[39]; c0 -= A0_2[0] * x[40]; c1 -= A0_2[1] * x[41]; c2 -= A0_2[2] * x[42]; c3 -= A0_2[3] * x[43]; c0 -= A0_3[0] * x[44]; c1 -= A0_3[1] * x[45]; c2 -= A0_3[2] * x[46]; x[47] = (c0 + c1) + (c2 + c3); __builtin_amdgcn_sched_barrier(0);
            A0_0 = *(const LAS f32x4*)(Amv + 3296); A0_1 = *(const LAS f32x4*)(Amv + 3300); A0_2 = *(const LAS f32x4*)(Amv + 3304); A0_3 = *(const LAS f32x4*)(Amv + 3308); __builtin_amdgcn_sched_barrier(0); c0 = r1; c1 = 0.f; c2 = 0.f; c3 = 0.f; c0 -= A1_0[0] * x[0]; c1 -= A1_0[1] * x[1]; c2 -= A1_0[2] * x[2]; c3 -= A1_0[3] * x[3]; c0 -= A1_1[0] * x[4]; c1 -= A1_1[1] * x[5]; c2 -= A1_1[2] * x[6]; c3 -= A1_1[3] * x[7]; c0 -= A1_2[0] * x[8]; c1 -= A1_2[1] * x[9]; c2 -= A1_2[2] * x[10]; c3 -= A1_2[3] * x[11]; c0 -= A1_3[0] * x[12]; c1 -= A1_3[1] * x[13]; c2 -= A1_3[2] * x[14]; c3 -= A1_3[3] * x[15]; c0 -= A1_4[0] * x[16]; c1 -= A1_4[1] * x[17]; c2 -= A1_4[2] * x[18]; c3 -= A1_4[3] * x[19]; c0 -= A1_5[0] * x[20]; c1 -= A1_5[1] * x[21]; c2 -= A1_5[2] * x[22]; c3 -= A1_5[3] * x[23]; c0 -= A1_6[0] * x[24]; c1 -= A1_6[1] * x[25]; c2 -= A1_6[2] * x[26]; c3 -= A1_6[3] * x[27]; c0 -= A1_7[0] * x[28]; c1 -= A1_7[1] * x[29]; c2 -= A1_7[2] * x[30]; c3 -= A1_7[3] * x[31]; __builtin_amdgcn_sched_barrier(0);
            A1_0 = *(const LAS f32x4*)(Amv + 3332); A1_1 = *(const LAS f32x4*)(Amv + 3336); A1_2 = *(const LAS f32x4*)(Amv + 3340); A1_3 = *(const LAS f32x4*)(Amv + 3344); A1_4 = *(const LAS f32x4*)(Amv + 3348); A1_5 = *(const LAS f32x4*)(Amv + 3352); A1_6 = *(const LAS f32x4*)(Amv + 3356); A1_7 = *(const LAS f32x4*)(Amv + 3360); r1 = RHS[12544 + c]; __builtin_amdgcn_sched_barrier(0); c0 -= A0_0[0] * x[32]; c1 -= A0_0[1] * x[33]; c2 -= A0_0[2] * x[34]; c3 -= A0_0[3] * x[35]; c0 -= A0_1[0] * x[36]; c1 -= A0_1[1] * x[37]; c2 -= A0_1[2] * x[38]; c3 -= A0_1[3] * x[39]; c0 -= A0_2[0] * x[40]; c1 -= A0_2[1] * x[41]; c2 -= A0_2[2] * x[42]; c3 -= A0_2[3] * x[43]; c0 -= A0_3[0] * x[44]; c1 -= A0_3[1] * x[45]; c2 -= A0_3[2] * x[46]; c3 -= A0_3[3] * x[47]; x[48] = (c0 + c1) + (c2 + c3); __builtin_amdgcn_sched_barrier(0);
            A0_0 = *(const LAS f32x4*)(Amv + 3364); A0_1 = *(const LAS f32x4*)(Amv + 3368); A0_2 = *(const LAS f32x4*)(Amv + 3372); A0_3 = *(const LAS f32x4*)(Amv + 3376); A0_4 = *(const LAS f32x4*)(Amv + 3380); __builtin_amdgcn_sched_barrier(0); c0 = r1; c1 = 0.f; c2 = 0.f; c3 = 0.f; c0 -= A1_0[0] * x[0]; c1 -= A1_0[1] * x[1]; c2 -= A1_0[2] * x[2]; c3 -= A1_0[3] * x[3]; c0 -= A1_1[0] * x[4]; c1 -= A1_1[1] * x[5]; c2 -= A1_1[2] * x[6]; c3 -= A1_1[3] * x[7]; c0 -= A1_2[0] * x[8]; c1 -= A1_2[1] * x[9]; c2 -= A1_2[2] * x[10]; c3 -= A1_2[3] * x[11]; c0 -= A1_3[0] * x[12]; c1 -= A1_3[1] * x[13]; c2 -= A1_3[2] * x[14]; c3 -= A1_3[3] * x[15]; c0 -= A1_4[0] * x[16]; c1 -= A1_4[1] * x[17]; c2 -= A1_4[2] * x[18]; c3 -= A1_4[3] * x[19]; c0 -= A1_5[0] * x[20]; c1 -= A1_5[1] * x[21]; c2 -= A1_5[2] * x[22]; c3 -= A1_5[3] * x[23]; c0 -= A1_6[0] * x[24]; c1 -= A1_6[1] * x[25]; c2 -= A1_6[2] * x[26]; c3 -= A1_6[3] * x[27]; c0 -= A1_7[0] * x[28]; c1 -= A1_7[1] * x[29]; c2 -= A1_7[2] * x[30]; c3 -= A1_7[3] * x[31]; __builtin_amdgcn_sched_barrier(0);
            A1_0 = *(const LAS f32x4*)(Amv + 3400); A1_1 = *(const LAS f32x4*)(Amv + 3404); A1_2 = *(const LAS f32x4*)(Amv + 3408); A1_3 = *(const LAS f32x4*)(Amv + 3412); A1_4 = *(const LAS f32x4*)(Amv + 3416); A1_5 = *(const LAS f32x4*)(Amv + 3420); A1_6 = *(const LAS f32x4*)(Amv + 3424); A1_7 = *(const LAS f32x4*)(Amv + 3428); r1 = RHS[12800 + c]; __builtin_amdgcn_sched_barrier(0); c0 -= A0_0[0] * x[32]; c1 -= A0_0[1] * x[33]; c2 -= A0_0[2] * x[34]; c3 -= A0_0[3] * x[35]; c0 -= A0_1[0] * x[36]; c1 -= A0_1[1] * x[37]; c2 -= A0_1[2] * x[38]; c3 -= A0_1[3] * x[39]; c0 -= A0_2[0] * x[40]; c1 -= A0_2[1] * x[41]; c2 -= A0_2[2] * x[42]; c3 -= A0_2[3] * x[43]; c0 -= A0_3[0] * x[44]; c1 -= A0_3[1] * x[45]; c2 -= A0_3[2] * x[46]; c3 -= A0_3[3] * x[47]; c0 -= A0_4[0] * x[48]; x[49] = (c0 + c1) + (c2 + c3); __builtin_amdgcn_sched_barrier(0);
            A0_0 = *(const LAS f32x4*)(Amv + 3432); A0_1 = *(const LAS f32x4*)(Amv + 3436); A0_2 = *(const LAS f32x4*)(Amv + 3440); A0_3 = *(const LAS f32x4*)(Amv + 3444); A0_4 = *(const LAS f32x4*)(Amv + 3448); __builtin_amdgcn_sched_barrier(0); c0 = r1; c1 = 0.f; c2 = 0.f; c3 = 0.f; c0 -= A1_0[0] * x[0]; c1 -= A1_0[1] * x[1]; c2 -= A1_0[2] * x[2]; c3 -= A1_0[3] * x[3]; c0 -= A1_1[0] * x[4]; c1 -= A1_1[1] * x[5]; c2 -= A1_1[2] * x[6]; c3 -= A1_1[3] * x[7]; c0 -= A1_2[0] * x[8]; c1 -= A1_2[1] * x[9]; c2 -= A1_2[2] * x[10]; c3 -= A1_2[3] * x[11]; c0 -= A1_3[0] * x[12]; c1 -= A1_3[1] * x[13]; c2 -= A1_3[2] * x[14]; c3 -= A1_3[3] * x[15]; c0 -= A1_4[0] * x[16]; c1 -= A1_4[1] * x[17]; c2 -= A1_4[2] * x[18]; c3 -= A1_4[3] * x[19]; c0 -= A1_5[0] * x[20]; c1 -= A1_5[1] * x[21]; c2 -= A1_5[2] * x[22]; c3 -= A1_5[3] * x[23]; c0 -= A1_6[0] * x[24]; c1 -= A1_6[1] * x[25]; c2 -= A1_6[2] * x[26]; c3 -= A1_6[3] * x[27]; c0 -= A1_7[0] * x[28]; c1 -= A1_7[1] * x[29]; c2 -= A1_7[2] * x[30]; c3 -= A1_7[3] * x[31]; __builtin_amdgcn_sched_barrier(0);
            A1_0 = *(const LAS f32x4*)(Amv + 3468); A1_1 = *(const LAS f32x4*)(Amv + 3472); A1_2 = *(const LAS f32x4*)(Amv + 3476); A1_3 = *(const LAS f32x4*)(Amv + 3480); A1_4 = *(const LAS f32x4*)(Amv + 3484); A1_5 = *(const LAS f32x4*)(Amv + 3488); A1_6 = *(const LAS f32x4*)(Amv + 3492); A1_7 = *(const LAS f32x4*)(Amv + 3496); r1 = RHS[13056 + c]; __builtin_amdgcn_sched_barrier(0); c0 -= A0_0[0] * x[32]; c1 -= A0_0[1] * x[33]; c2 -= A0_0[2] * x[34]; c3 -= A0_0[3] * x[35]; c0 -= A0_1[0] * x[36]; c1 -= A0_1[1] * x[37]; c2 -= A0_1[2] * x[38]; c3 -= A0_1[3] * x[39]; c0 -= A0_2[0] * x[40]; c1 -= A0_2[1] * x[41]; c2 -= A0_2[2] * x[42]; c3 -= A0_2[3] * x[43]; c0 -= A0_3[0] * x[44]; c1 -= A0_3[1] * x[45]; c2 -= A0_3[2] * x[46]; c3 -= A0_3[3] * x[47]; c0 -= A0_4[0] * x[48]; c1 -= A0_4[1] * x[49]; x[50] = (c0 + c1) + (c2 + c3); __builtin_amdgcn_sched_barrier(0);
            A0_0 = *(const LAS f32x4*)(Amv + 3500); A0_1 = *(const LAS f32x4*)(Amv + 3504); A0_2 = *(const LAS f32x4*)(Amv + 3508); A0_3 = *(const LAS f32x4*)(Amv + 3512); A0_4 = *(const LAS f32x4*)(Amv + 3516); __builtin_amdgcn_sched_barrier(0); c0 = r1; c1 = 0.f; c2 = 0.f; c3 = 0.f; c0 -= A1_0[0] * x[0]; c1 -= A1_0[1] * x[1]; c2 -= A1_0[2] * x[2]; c3 -= A1_0[3] * x[3]; c0 -= A1_1[0] * x[4]; c1 -= A1_1[1] * x[5]; c2 -= A1_1[2] * x[6]; c3 -= A1_1[3] * x[7]; c0 -= A1_2[0] * x[8]; c1 -= A1_2[1] * x[9]; c2 -= A1_2[2] * x[10]; c3 -= A1_2[3] * x[11]; c0 -= A1_3[0] * x[12]; c1 -= A1_3[1] * x[13]; c2 -= A1_3[2] * x[14]; c3 -= A1_3[3] * x[15]; c0 -= A1_4[0] * x[16]; c1 -= A1_4[1] * x[17]; c2 -= A1_4[2] * x[18]; c3 -= A1_4[3] * x[19]; c0 -= A1_5[0] * x[20]; c1 -= A1_5[1] * x[21]; c2 -= A1_5[2] * x[22]; c3 -= A1_5[3] * x[23]; c0 -= A1_6[0] * x[24]; c1 -= A1_6[1] * x[25]; c2 -= A1_6[2] * x[26]; c3 -= A1_6[3] * x[27]; c0 -= A1_7[0] * x[28]; c1 -= A1_7[1] * x[29]; c2 -= A1_7[2] * x[30]; c3 -= A1_7[3] * x[31]; __builtin_amdgcn_sched_barrier(0);
            A1_0 = *(const LAS f32x4*)(Amv + 3536); A1_1 = *(const LAS f32x4*)(Amv + 3540); A1_2 = *(const LAS f32x4*)(Amv + 3544); A1_3 = *(const LAS f32x4*)(Amv + 3548); A1_4 = *(const LAS f32x4*)(Amv + 3552); A1_5 = *(const LAS f32x4*)(Amv + 3556); A1_6 = *(const LAS f32x4*)(Amv + 3560); A1_7 = *(const LAS f32x4*)(Amv + 3564); r1 = RHS[13312 + c]; __builtin_amdgcn_sched_barrier(0); c0 -= A0_0[0] * x[32]; c1 -= A0_0[1] * x[33]; c2 -= A0_0[2] * x[34]; c3 -= A0_0[3] * x[35]; c0 -= A0_1[0] * x[36]; c1 -= A0_1[1] * x[37]; c2 -= A0_1[2] * x[38]; c3 -= A0_1[3] * x[39]; c0 -= A0_2[0] * x[40]; c1 -= A0_2[1] * x[41]; c2 -= A0_2[2] * x[42]; c3 -= A0_2[3] * x[43]; c0 -= A0_3[0] * x[44]; c1 -= A0_3[1] * x[45]; c2 -= A0_3[2] * x[46]; c3 -= A0_3[3] * x[47]; c0 -= A0_4[0] * x[48]; c1 -= A0_4[1] * x[49]; c2 -= A0_4[2] * x[50]; x[51] = (c0 + c1) + (c2 + c3); __builtin_amdgcn_sched_barrier(0);
            A0_0 = *(const LAS f32x4*)(Amv + 3568); A0_1 = *(const LAS f32x4*)(Amv + 3572); A0_2 = *(const LAS f32x4*)(Amv + 3576); A0_3 = *(const LAS f32x4*)(Amv + 3580); A0_4 = *(const LAS f32x4*)(Amv + 3584); __builtin_amdgcn_sched_barrier(0); c0 = r1; c1 = 0.f; c2 = 0.f; c3 = 0.f; c0 -= A1_0[0] * x[0]; c1 -= A1_0[1] * x[1]; c2 -= A1_0[2] * x[2]; c3 -= A1_0[3] * x[3]; c0 -= A1_1[0] * x[4]; c1 -= A1_1[1] * x[5]; c2 -= A1_1[2] * x[6]; c3 -= A1_1[3] * x[7]; c0 -= A1_2[0] * x[8]; c1 -= A1_2[1] * x[9]; c2 -= A1_2[2] * x[10]; c3 -= A1_2[3] * x[11]; c0 -= A1_3[0] * x[12]; c1 -= A1_3[1] * x[13]; c2 -= A1_3[2] * x[14]; c3 -= A1_3[3] * x[15]; c0 -= A1_4[0] * x[16]; c1 -= A1_4[1] * x[17]; c2 -= A1_4[2] * x[18]; c3 -= A1_4[3] * x[19]; c0 -= A1_5[0] * x[20]; c1 -= A1_5[1] * x[21]; c2 -= A1_5[2] * x[22]; c3 -= A1_5[3] * x[23]; c0 -= A1_6[0] * x[24]; c1 -= A1_6[1] * x[25]; c2 -= A1_6[2] * x[26]; c3 -= A1_6[3] * x[27]; c0 -= A1_7[0] * x[28]; c1 -= A1_7[1] * x[29]; c2 -= A1_7[2] * x[30]; c3 -= A1_7[3] * x[31]; __builtin_amdgcn_sched_barrier(0);
            A1_0 = *(const LAS f32x4*)(Amv + 3604); A1_1 = *(const LAS f32x4*)(Amv + 3608); A1_2 = *(const LAS f32x4*)(Amv + 3612); A1_3 = *(const LAS f32x4*)(Amv + 3616); A1_4 = *(const LAS f32x4*)(Amv + 3620); A1_5 = *(const LAS f32x4*)(Amv + 3624); A1_6 = *(const LAS f32x4*)(Amv + 3628); A1_7 = *(const LAS f32x4*)(Amv + 3632); r1 = RHS[13568 + c]; __builtin_amdgcn_sched_barrier(0); c0 -= A0_0[0] * x[32]; c1 -= A0_0[1] * x[33]; c2 -= A0_0[2] * x[34]; c3 -= A0_0[3] * x[35]; c0 -= A0_1[0] * x[36]; c1 -= A0_1[1] * x[37]; c2 -= A0_1[2] * x[38]; c3 -= A0_1[3] * x[39]; c0 -= A0_2[0] * x[40]; c1 -= A0_2[1] * x[41]; c2 -= A0_2[2] * x[42]; c3 -= A0_2[3] * x[43]; c0 -= A0_3[0] * x[44]; c1 -= A0_3[1] * x[45]; c2 -= A0_3[2] * x[46]; c3 -= A0_3[3] * x[47]; c0 -= A0_4[0] * x[48]; c1 -= A0_4[1] * x[49]; c2 -= A0_4[2] * x[50]; c3 -= A0_4[3] * x[51]; x[52] = (c0 + c1) + (c2 + c3); __builtin_amdgcn_sched_barrier(0);
            A0_0 = *(const LAS f32x4*)(Amv + 3636); A0_1 = *(const LAS f32x4*)(Amv + 3640); A0_2 = *(const LAS f32x4*)(Amv + 3644); A0_3 = *(const LAS f32x4*)(Amv + 3648); A0_4 = *(const LAS f32x4*)(Amv + 3652); A0_5 = *(const LAS f32x4*)(Amv + 3656); __builtin_amdgcn_sched_barrier(0); c0 = r1; c1 = 0.f; c2 = 0.f; c3 = 0.f; c0 -= A1_0[0] * x[0]; c1 -= A1_0[1] * x[1]; c2 -= A1_0[2] * x[2]; c3 -= A1_0[3] * x[3]; c0 -= A1_1[0] * x[4]; c1 -= A1_1[1] * x[5]; c2 -= A1_1[2] * x[6]; c3 -= A1_1[3] * x[7]; c0 -= A1_2[0] * x[8]; c1 -= A1_2[1] * x[9]; c2 -= A1_2[2] * x[10]; c3 -= A1_2[3] * x[11]; c0 -= A1_3[0] * x[12]; c1 -= A1_3[1] * x[13]; c2 -= A1_3[2] * x[14]; c3 -= A1_3[3] * x[15]; c0 -= A1_4[0] * x[16]; c1 -= A1_4[1] * x[17]; c2 -= A1_4[2] * x[18]; c3 -= A1_4[3] * x[19]; c0 -= A1_5[0] * x[20]; c1 -= A1_5[1] * x[21]; c2 -= A1_5[2] * x[22]; c3 -= A1_5[3] * x[23]; c0 -= A1_6[0] * x[24]; c1 -= A1_6[1] * x[25]; c2 -= A1_6[2] * x[26]; c3 -= A1_6[3] * x[27]; c0 -= A1_7[0] * x[28]; c1 -= A1_7[1] * x[29]; c2 -= A1_7[2] * x[30]; c3 -= A1_7[3] * x[31]; __builtin_amdgcn_sched_barrier(0);
            A1_0 = *(const LAS f32x4*)(Amv + 3672); A1_1 = *(const LAS f32x4*)(Amv + 3676); A1_2 = *(const LAS f32x4*)(Amv + 3680); A1_3 = *(const LAS f32x4*)(Amv + 3684); A1_4 = *(const LAS f32x4*)(Amv + 3688); A1_5 = *(const LAS f32x4*)(Amv + 3692); A1_6 = *(const LAS f32x4*)(Amv + 3696); A1_7 = *(const LAS f32x4*)(Amv + 3700); r1 = RHS[13824 + c]; __builtin_amdgcn_sched_barrier(0); c0 -= A0_0[0] * x[32]; c1 -= A0_0[1] * x[33]; c2 -= A0_0[2] * x[34]; c3 -= A0_0[3] * x[35]; c0 -= A0_1[0] * x[36]; c1 -= A0_1[1] * x[37]; c2 -= A0_1[2] * x[38]; c3 -= A0_1[3] * x[39]; c0 -= A0_2[0] * x[40]; c1 -= A0_2[1] * x[41]; c2 -= A0_2[2] * x[42]; c3 -= A0_2[3] * x[43]; c0 -= A0_3[0] * x[44]; c1 -= A0_3[1] * x[45]; c2 -= A0_3[2] * x[46]; c3 -= A0_3[3] * x[47]; c0 -= A0_4[0] * x[48]; c1 -= A0_4[1] * x[49]; c2 -= A0_4[2] * x[50]; c3 -= A0_4[3] * x[51]; c0 -= A0_5[0] * x[52]; x[53] = (c0 + c1) + (c2 + c3); __builtin_amdgcn_sched_barrier(0);
            A0_0 = *(const LAS f32x4*)(Amv + 3704); A0_1 = *(const LAS f32x4*)(Amv + 3708); A0_2 = *(const LAS f32x4*)(Amv + 3712); A0_3 = *(const LAS f32x4*)(Amv + 3716); A0_4 = *(const LAS f32x4*)(Amv + 3720); A0_5 = *(const LAS f32x4*)(Amv + 3724); __builtin_amdgcn_sched_barrier(0); c0 = r1; c1 = 0.f; c2 = 0.f; c3 = 0.f; c0 -= A1_0[0] * x[0]; c1 -= A1_0[1] * x[1]; c2 -= A1_0[2] * x[2]; c3 -= A1_0[3] * x[3]; c0 -= A1_1[0] * x[4]; c1 -= A1_1[1] * x[5]; c2 -= A1_1[2] * x[6]; c3 -= A1_1[3] * x[7]; c0 -= A1_2[0] * x[8]; c1 -= A1_2[1] * x[9]; c2 -= A1_2[2] * x[10]; c3 -= A1_2[3] * x[11]; c0 -= A1_3[0] * x[12]; c1 -= A1_3[1] * x[13]; c2 -= A1_3[2] * x[14]; c3 -= A1_3[3] * x[15]; c0 -= A1_4[0] * x[16]; c1 -= A1_4[1] * x[17]; c2 -= A1_4[2] * x[18]; c3 -= A1_4[3] * x[19]; c0 -= A1_5[0] * x[20]; c1 -= A1_5[1] * x[21]; c2 -= A1_5[2] * x[22]; c3 -= A1_5[3] * x[23]; c0 -= A1_6[0] * x[24]; c1 -= A1_6[1] * x[25]; c2 -= A1_6[2] * x[26]; c3 -= A1_6[3] * x[27]; c0 -= A1_7[0] * x[28]; c1 -= A1_7[1] * x[29]; c2 -= A1_7[2] * x[30]; c3 -= A1_7[3] * x[31]; __builtin_amdgcn_sched_barrier(0);
            A1_0 = *(const LAS f32x4*)(Amv + 3740); A1_1 = *(const LAS f32x4*)(Amv + 3744); A1_2 = *(const LAS f32x4*)(Amv + 3748); A1_3 = *(const LAS f32x4*)(Amv + 3752); A1_4 = *(const LAS f32x4*)(Amv + 3756); A1_5 = *(const LAS f32x4*)(Amv + 3760); A1_6 = *(const LAS f32x4*)(Amv + 3764); A1_7 = *(const LAS f32x4*)(Amv + 3768); r1 = RHS[14080 + c]; __builtin_amdgcn_sched_barrier(0); c0 -= A0_0[0] * x[32]; c1 -= A0_0[1] * x[33]; c2 -= A0_0[2] * x[34]; c3 -= A0_0[3] * x[35]; c0 -= A0_1[0] * x[36]; c1 -= A0_1[1] * x[37]; c2 -= A0_1[2] * x[38]; c3 -= A0_1[3] * x[39]; c0 -= A0_2[0] * x[40]; c1 -= A0_2[1] * x[41]; c2 -= A0_2[2] * x[42]; c3 -= A0_2[3] * x[43]; c0 -= A0_3[0] * x[44]; c1 -= A0_3[1] * x[45]; c2 -= A0_3[2] * x[46]; c3 -= A0_3[3] * x[47]; c0 -= A0_4[0] * x[48]; c1 -= A0_4[1] * x[49]; c2 -= A0_4[2] * x[50]; c3 -= A0_4[3] * x[51]; c0 -= A0_5[0] * x[52]; c1 -= A0_5[1] * x[53]; x[54] = (c0 + c1) + (c2 + c3); __builtin_amdgcn_sched_barrier(0);
            A0_0 = *(const LAS f32x4*)(Amv + 3772); A0_1 = *(const LAS f32x4*)(Amv + 3776); A0_2 = *(const LAS f32x4*)(Amv + 3780); A0_3 = *(const LAS f32x4*)(Amv + 3784); A0_4 = *(const LAS f32x4*)(Amv + 3788); A0_5 = *(const LAS f32x4*)(Amv + 3792); __builtin_amdgcn_sched_barrier(0); c0 = r1; c1 = 0.f; c2 = 0.f; c3 = 0.f; c0 -= A1_0[0] * x[0]; c1 -= A1_0[1] * x[1]; c2 -= A1_0[2] * x[2]; c3 -= A1_0[3] * x[3]; c0 -= A1_1[0] * x[4]; c1 -= A1_1[1] * x[5]; c2 -= A1_1[2] * x[6]; c3 -= A1_1[3] * x[7]; c0 -= A1_2[0] * x[8]; c1 -= A1_2[1] * x[9]; c2 -= A1_2[2] * x[10]; c3 -= A1_2[3] * x[11]; c0 -= A1_3[0] * x[12]; c1 -= A1_3[1] * x[13]; c2 -= A1_3[2] * x[14]; c3 -= A1_3[3] * x[15]; c0 -= A1_4[0] * x[16]; c1 -= A1_4[1] * x[17]; c2 -= A1_4[2] * x[18]; c3 -= A1_4[3] * x[19]; c0 -= A1_5[0] * x[20]; c1 -= A1_5[1] * x[21]; c2 -= A1_5[2] * x[22]; c3 -= A1_5[3] * x[23]; c0 -= A1_6[0] * x[24]; c1 -= A1_6[1] * x[25]; c2 -= A1_6[2] * x[26]; c3 -= A1_6[3] * x[27]; c0 -= A1_7[0] * x[28]; c1 -= A1_7[1] * x[29]; c2 -= A1_7[2] * x[30]; c3 -= A1_7[3] * x[31]; __builtin_amdgcn_sched_barrier(0);
            A1_0 = *(const LAS f32x4*)(Amv + 3808); A1_1 = *(const LAS f32x4*)(Amv + 3812); A1_2 = *(const LAS f32x4*)(Amv + 3816); A1_3 = *(const LAS f32x4*)(Amv + 3820); A1_4 = *(const LAS f32x4*)(Amv + 3824); A1_5 = *(const LAS f32x4*)(Amv + 3828); A1_6 = *(const LAS f32x4*)(Amv + 3832); A1_7 = *(const LAS f32x4*)(Amv + 3836); r1 = RHS[14336 + c]; __builtin_amdgcn_sched_barrier(0); c0 -= A0_0[0] * x[32]; c1 -= A0_0[1] * x[33]; c2 -= A0_0[2] * x[34]; c3 -= A0_0[3] * x[35]; c0 -= A0_1[0] * x[36]; c1 -= A0_1[1] * x[37]; c2 -= A0_1[2] * x[38]; c3 -= A0_1[3] * x[39]; c0 -= A0_2[0] * x[40]; c1 -= A0_2[1] * x[41]; c2 -= A0_2[2] * x[42]; c3 -= A0_2[3] * x[43]; c0 -= A0_3[0] * x[44]; c1 -= A0_3[1] * x[45]; c2 -= A0_3[2] * x[46]; c3 -= A0_3[3] * x[47]; c0 -= A0_4[0] * x[48]; c1 -= A0_4[1] * x[49]; c2 -= A0_4[2] * x[50]; c3 -= A0_4[3] * x[51]; c0 -= A0_5[0] * x[52]; c1 -= A0_5[1] * x[53]; c2 -= A0_5[2] * x[54]; x[55] = (c0 + c1) + (c2 + c3); __builtin_amdgcn_sched_barrier(0);
            A0_0 = *(const LAS f32x4*)(Amv + 3840); A0_1 = *(const LAS f32x4*)(Amv + 3844); A0_2 = *(const LAS f32x4*)(Amv + 3848); A0_3 = *(const LAS f32x4*)(Amv + 3852); A0_4 = *(const LAS f32x4*)(Amv + 3856); A0_5 = *(const LAS f32x4*)(Amv + 3860); __builtin_amdgcn_sched_barrier(0); c0 = r1; c1 = 0.f; c2 = 0.f; c3 = 0.f; c0 -= A1_0[0] * x[0]; c1 -= A1_0[1] * x[1]; c2 -= A1_0[2] * x[2]; c3 -= A1_0[3] * x[3]; c0 -= A1_1[0] * x[4]; c1 -= A1_1[1] * x[5]; c2 -= A1_1[2] * x[6]; c3 -= A1_1[3] * x[7]; c0 -= A1_2[0] * x[8]; c1 -= A1_2[1] * x[9]; c2 -= A1_2[2] * x[10]; c3 -= A1_2[3] * x[11]; c0 -= A1_3[0] * x[12]; c1 -= A1_3[1] * x[13]; c2 -= A1_3[2] * x[14]; c3 -= A1_3[3] * x[15]; c0 -= A1_4[0] * x[16]; c1 -= A1_4[1] * x[17]; c2 -= A1_4[2] * x[18]; c3 -= A1_4[3] * x[19]; c0 -= A1_5[0] * x[20]; c1 -= A1_5[1] * x[21]; c2 -= A1_5[2] * x[22]; c3 -= A1_5[3] * x[23]; c0 -= A1_6[0] * x[24]; c1 -= A1_6[1] * x[25]; c2 -= A1_6[2] * x[26]; c3 -= A1_6[3] * x[27]; c0 -= A1_7[0] * x[28]; c1 -= A1_7[1] * x[29]; c2 -= A1_7[2] * x[30]; c3 -= A1_7[3] * x[31]; __builtin_amdgcn_sched_barrier(0);
            A1_0 = *(const LAS f32x4*)(Amv + 3876); A1_1 = *(const LAS f32x4*)(Amv + 3880); A1_2 = *(const LAS f32x4*)(Amv + 3884); A1_3 = *(const LAS f32x4*)(Amv + 3888); A1_4 = *(const LAS f32x4*)(Amv + 3892); A1_5 = *(const LAS f32x4*)(Amv + 3896); A1_6 = *(const LAS f32x4*)(Amv + 3900); A1_7 = *(const LAS f32x4*)(Amv + 3904); r1 = RHS[14592 + c]; __builtin_amdgcn_sched_barrier(0); c0 -= A0_0[0] * x[32]; c1 -= A0_0[1] * x[33]; c2 -= A0_0[2] * x[34]; c3 -= A0_0[3] * x[35]; c0 -= A0_1[0] * x[36]; c1 -= A0_1[1] * x[37]; c2 -= A0_1[2] * x[38]; c3 -= A0_1[3] * x[39]; c0 -= A0_2[0] * x[40]; c1 -= A0_2[1] * x[41]; c2 -= A0_2[2] * x[42]; c3 -= A0_2[3] * x[43]; c0 -= A0_3[0] * x[44]; c1 -= A0_3[1] * x[45]; c2 -= A0_3[2] * x[46]; c3 -= A0_3[3] * x[47]; c0 -= A0_4[0] * x[48]; c1 -= A0_4[1] * x[49]; c2 -= A0_4[2] * x[50]; c3 -= A0_4[3] * x[51]; c0 -= A0_5[0] * x[52]; c1 -= A0_5[1] * x[53]; c2 -= A0_5[2] * x[54]; c3 -= A0_5[3] * x[55]; x[56] = (c0 + c1) + (c2 + c3); __builtin_amdgcn_sched_barrier(0);
            A0_0 = *(const LAS f32x4*)(Amv + 3908); A0_1 = *(const LAS f32x4*)(Amv + 3912); A0_2 = *(const LAS f32x4*)(Amv + 3916); A0_3 = *(const LAS f32x4*)(Amv + 3920); A0_4 = *(const LAS f32x4*)(Amv + 3924); A0_5 = *(const LAS f32x4*)(Amv + 3928); A0_6 = *(const LAS f32x4*)(Amv + 3932); __builtin_amdgcn_sched_barrier(0); c0 = r1; c1 = 0.f; c2 = 0.f; c3 = 0.f; c0 -= A1_0[0] * x[0]; c1 -= A1_0[1] * x[1]; c2 -= A1_0[2] * x[2]; c3 -= A1_0[3] * x[3]; c0 -= A1_1[0] * x[4]; c1 -= A1_1[1] * x[5]; c2 -= A1_1[2] * x[6]; c3 -= A1_1[3] * x[7]; c0 -= A1_2[0] * x[8]; c1 -= A1_2[1] * x[9]; c2 -= A1_2[2] * x[10]; c3 -= A1_2[3] * x[11]; c0 -= A1_3[0] * x[12]; c1 -= A1_3[1] * x[13]; c2 -= A1_3[2] * x[14]; c3 -= A1_3[3] * x[15]; c0 -= A1_4[0] * x[16]; c1 -= A1_4[1] * x[17]; c2 -= A1_4[2] * x[18]; c3 -= A1_4[3] * x[19]; c0 -= A1_5[0] * x[20]; c1 -= A1_5[1] * x[21]; c2 -= A1_5[2] * x[22]; c3 -= A1_5[3] * x[23]; c0 -= A1_6[0] * x[24]; c1 -= A1_6[1] * x[25]; c2 -= A1_6[2] * x[26]; c3 -= A1_6[3] * x[27]; c0 -= A1_7[0] * x[28]; c1 -= A1_7[1] * x[29]; c2 -= A1_7[2] * x[30]; c3 -= A1_7[3] * x[31]; __builtin_amdgcn_sched_barrier(0);
            A1_0 = *(const LAS f32x4*)(Amv + 3944); A1_1 = *(const LAS f32x4*)(Amv + 3948); A1_2 = *(const LAS f32x4*)(Amv + 3952); A1_3 = *(const LAS f32x4*)(Amv + 3956); A1_4 = *(const LAS f32x4*)(Amv + 3960); A1_5 = *(const LAS f32x4*)(Amv + 3964); A1_6 = *(const LAS f32x4*)(Amv + 3968); A1_7 = *(const LAS f32x4*)(Amv + 3972); r1 = RHS[14848 + c]; __builtin_amdgcn_sched_barrier(0); c0 -= A0_0[0] * x[32]; c1 -= A0_0[1] * x[33]; c2 -= A0_0[2] * x[34]; c3 -= A0_0[3] * x[35]; c0 -= A0_1[0] * x[36]; c1 -= A0_1[1] * x[37]; c2 -= A0_1[2] * x[38]; c3 -= A0_1[3] * x[39]; c0 -= A0_2[0] * x[40]; c1 -= A0_2[1] * x[41]; c2 -= A0_2[2] * x[42]; c3 -= A0_2[3] * x[43]; c0 -= A0_3[0] * x[44]; c1 -= A0_3[1] * x[45]; c2 -= A0_3[2] * x[46]; c3 -= A0_3[3] * x[47]; c0 -= A0_4[0] * x[48]; c1 -= A0_4[1] * x[49]; c2 -= A0_4[2] * x[50]; c3 -= A0_4[3] * x[51]; c0 -= A0_5[0] * x[52]; c1 -= A0_5[1] * x[53]; c2 -= A0_5[2] * x[54]; c3 -= A0_5[3] * x[55]; c0 -= A0_6[0] * x[56]; x[57] = (c0 + c1) + (c2 + c3); __builtin_amdgcn_sched_barrier(0);
            A0_0 = *(const LAS f32x4*)(Amv + 3976); A0_1 = *(const LAS f32x4*)(Amv + 3980); A0_2 = *(const LAS f32x4*)(Amv + 3984); A0_3 = *(const LAS f32x4*)(Amv + 3988); A0_4 = *(const LAS f32x4*)(Amv + 3992); A0_5 = *(const LAS f32x4*)(Amv + 3996); A0_6 = *(const LAS f32x4*)(Amv + 4000); __builtin_amdgcn_sched_barrier(0); c0 = r1; c1 = 0.f; c2 = 0.f; c3 = 0.f; c0 -= A1_0[0] * x[0]; c1 -= A1_0[1] * x[1]; c2 -= A1_0[2] * x[2]; c3 -= A1_0[3] * x[3]; c0 -= A1_1[0] * x[4]; c1 -= A1_1[1] * x[5]; c2 -= A1_1[2] * x[6]; c3 -= A1_1[3] * x[7]; c0 -= A1_2[0] * x[8]; c1 -= A1_2[1] * x[9]; c2 -= A1_2[2] * x[10]; c3 -= A1_2[3] * x[11]; c0 -= A1_3[0] * x[12]; c1 -= A1_3[1] * x[13]; c2 -= A1_3[2] * x[14]; c3 -= A1_3[3] * x[15]; c0 -= A1_4[0] * x[16]; c1 -= A1_4[1] * x[17]; c2 -= A1_4[2] * x[18]; c3 -= A1_4[3] * x[19]; c0 -= A1_5[0] * x[20]; c1 -= A1_5[1] * x[21]; c2 -= A1_5[2] * x[22]; c3 -= A1_5[3] * x[23]; c0 -= A1_6[0] * x[24]; c1 -= A1_6[1] * x[25]; c2 -= A1_6[2] * x[26]; c3 -= A1_6[3] * x[27]; c0 -= A1_7[0] * x[28]; c1 -= A1_7[1] * x[29]; c2 -= A1_7[2] * x[30]; c3 -= A1_7[3] * x[31]; __builtin_amdgcn_sched_barrier(0);
            A1_0 = *(const LAS f32x4*)(Amv + 4012); A1_1 = *(const LAS f32x4*)(Amv + 4016); A1_2 = *(const LAS f32x4*)(Amv + 4020); A1_3 = *(const LAS f32x4*)(Amv + 4024); A1_4 = *(const LAS f32x4*)(Amv + 4028); A1_5 = *(const LAS f32x4*)(Amv + 4032); A1_6 = *(const LAS f32x4*)(Amv + 4036); A1_7 = *(const LAS f32x4*)(Amv + 4040); r1 = RHS[15104 + c]; __builtin_amdgcn_sched_barrier(0); c0 -= A0_0[0] * x[32]; c1 -= A0_0[1] * x[33]; c2 -= A0_0[2] * x[34]; c3 -= A0_0[3] * x[35]; c0 -= A0_1[0] * x[36]; c1 -= A0_1[1] * x[37]; c2 -= A0_1[2] * x[38]; c3 -= A0_1[3] * x[39]; c0 -= A0_2[0] * x[40]; c1 -= A0_2[1] * x[41]; c2 -= A0_2[2] * x[42]; c3 -= A0_2[3] * x[43]; c0 -= A0_3[0] * x[44]; c1 -= A0_3[1] * x[45]; c2 -= A0_3[2] * x[46]; c3 -= A0_3[3] * x[47]; c0 -= A0_4[0] * x[48]; c1 -= A0_4[1] * x[49]; c2 -= A0_4[2] * x[50]; c3 -= A0_4[3] * x[51]; c0 -= A0_5[0] * x[52]; c1 -= A0_5[1] * x[53]; c2 -= A0_5[2] * x[54]; c3 -= A0_5[3] * x[55]; c0 -= A0_6[0] * x[56]; c1 -= A0_6[1] * x[57]; x[58] = (c0 + c1) + (c2 + c3); __builtin_amdgcn_sched_barrier(0);
            A0_0 = *(const LAS f32x4*)(Amv + 4044); A0_1 = *(const LAS f32x4*)(Amv + 4048); A0_2 = *(const LAS f32x4*)(Amv + 4052); A0_3 = *(const LAS f32x4*)(Amv + 4056); A0_4 = *(const LAS f32x4*)(Amv + 4060); A0_5 = *(const LAS f32x4*)(Amv + 4064); A0_6 = *(const LAS f32x4*)(Amv + 4068); __builtin_amdgcn_sched_barrier(0); c0 = r1; c1 = 0.f; c2 = 0.f; c3 = 0.f; c0 -= A1_0[0] * x[0]; c1 -= A1_0[1] * x[1]; c2 -= A1_0[2] * x[2]; c3 -= A1_0[3] * x[3]; c0 -= A1_1[0] * x[4]; c1 -= A1_1[1] * x[5]; c2 -= A1_1[2] * x[6]; c3 -= A1_1[3] * x[7]; c0 -= A1_2[0] * x[8]; c1 -= A1_2[1] * x[9]; c2 -= A1_2[2] * x[10]; c3 -= A1_2[3] * x[11]; c0 -= A1_3[0] * x[12]; c1 -= A1_3[1] * x[13]; c2 -= A1_3[2] * x[14]; c3 -= A1_3[3] * x[15]; c0 -= A1_4[0] * x[16]; c1 -= A1_4[1] * x[17]; c2 -= A1_4[2] * x[18]; c3 -= A1_4[3] * x[19]; c0 -= A1_5[0] * x[20]; c1 -= A1_5[1] * x[21]; c2 -= A1_5[2] * x[22]; c3 -= A1_5[3] * x[23]; c0 -= A1_6[0] * x[24]; c1 -= A1_6[1] * x[25]; c2 -= A1_6[2] * x[26]; c3 -= A1_6[3] * x[27]; c0 -= A1_7[0] * x[28]; c1 -= A1_7[1] * x[29]; c2 -= A1_7[2] * x[30]; c3 -= A1_7[3] * x[31]; __builtin_amdgcn_sched_barrier(0);
            A1_0 = *(const LAS f32x4*)(Amv + 4080); A1_1 = *(const LAS f32x4*)(Amv + 4084); A1_2 = *(const LAS f32x4*)(Amv + 4088); A1_3 = *(const LAS f32x4*)(Amv + 4092); A1_4 = *(const LAS f32x4*)(Amv + 4096); A1_5 = *(const LAS f32x4*)(Amv + 4100); A1_6 = *(const LAS f32x4*)(Amv + 4104); A1_7 = *(const LAS f32x4*)(Amv + 4108); r1 = RHS[15360 + c]; __builtin_amdgcn_sched_barrier(0); c0 -= A0_0[0] * x[32]; c1 -= A0_0[1] * x[33]; c2 -= A0_0[2] * x[34]; c3 -= A0_0[3] * x[35]; c0 -= A0_1[0] * x[36]; c1 -= A0_1[1] * x[37]; c2 -= A0_1[2] * x[38]; c3 -= A0_1[3] * x[39]; c0 -= A0_2[0] * x[40]; c1 -= A0_2[1] * x[41]; c2 -= A0_2[2] * x[42]; c3 -= A0_2[3] * x[43]; c0 -= A0_3[0] * x[44]; c1 -= A0_3[1] * x[45]; c2 -= A0_3[2] * x[46]; c3 -= A0_3[3] * x[47]; c0 -= A0_4[0] * x[48]; c1 -= A0_4[1] * x[49]; c2 -= A0_4[2] * x[50]; c3 -= A0_4[3] * x[51]; c0 -= A0_5[0] * x[52]; c1 -= A0_5[1] * x[53]; c2 -= A0_5[2] * x[54]; c3 -= A0_5[3] * x[55]; c0 -= A0_6[0] * x[56]; c1 -= A0_6[1] * x[57]; c2 -= A0_6[2] * x[58]; x[59] = (c0 + c1) + (c2 + c3); __builtin_amdgcn_sched_barrier(0);
            A0_0 = *(const LAS f32x4*)(Amv + 4112); A0_1 = *(const LAS f32x4*)(Amv + 4116); A0_2 = *(const LAS f32x4*)(Amv + 4120); A0_3 = *(const LAS f32x4*)(Amv + 4124); A0_4 = *(const LAS f32x4*)(Amv + 4128); A0_5 = *(const LAS f32x4*)(Amv + 4132); A0_6 = *(const LAS f32x4*)(Amv + 4136); __builtin_amdgcn_sched_barrier(0); c0 = r1; c1 = 0.f; c2 = 0.f; c3 = 0.f; c0 -= A1_0[0] * x[0]; c1 -= A1_0[1] * x[1]; c2 -= A1_0[2] * x[2]; c3 -= A1_0[3] * x[3]; c0 -= A1_1[0] * x[4]; c1 -= A1_1[1] * x[5]; c2 -= A1_1[2] * x[6]; c3 -= A1_1[3] * x[7]; c0 -= A1_2[0] * x[8]; c1 -= A1_2[1] * x[9]; c2 -= A1_2[2] * x[10]; c3 -= A1_2[3] * x[11]; c0 -= A1_3[0] * x[12]; c1 -= A1_3[1] * x[13]; c2 -= A1_3[2] * x[14]; c3 -= A1_3[3] * x[15]; c0 -= A1_4[0] * x[16]; c1 -= A1_4[1] * x[17]; c2 -= A1_4[2] * x[18]; c3 -= A1_4[3] * x[19]; c0 -= A1_5[0] * x[20]; c1 -= A1_5[1] * x[21]; c2 -= A1_5[2] * x[22]; c3 -= A1_5[3] * x[23]; c0 -= A1_6[0] * x[24]; c1 -= A1_6[1] * x[25]; c2 -= A1_6[2] * x[26]; c3 -= A1_6[3] * x[27]; c0 -= A1_7[0] * x[28]; c1 -= A1_7[1] * x[29]; c2 -= A1_7[2] * x[30]; c3 -= A1_7[3] * x[31]; __builtin_amdgcn_sched_barrier(0);
            A1_0 = *(const LAS f32x4*)(Amv + 4148); A1_1 = *(const LAS f32x4*)(Amv + 4152); A1_2 = *(const LAS f32x4*)(Amv + 4156); A1_3 = *(const LAS f32x4*)(Amv + 4160); A1_4 = *(const LAS f32x4*)(Amv + 4164); A1_5 = *(const LAS f32x4*)(Amv + 4168); A1_6 = *(const LAS f32x4*)(Amv + 4172); A1_7 = *(const LAS f32x4*)(Amv + 4176); r1 = RHS[15616 + c]; __builtin_amdgcn_sched_barrier(0); c0 -= A0_0[0] * x[32]; c1 -= A0_0[1] * x[33]; c2 -= A0_0[2] * x[34]; c3 -= A0_0[3] * x[35]; c0 -= A0_1[0] * x[36]; c1 -= A0_1[1] * x[37]; c2 -= A0_1[2] * x[38]; c3 -= A0_1[3] * x[39]; c0 -= A0_2[0] * x[40]; c1 -= A0_2[1] * x[41]; c2 -= A0_2[2] * x[42]; c3 -= A0_2[3] * x[43]; c0 -= A0_3[0] * x[44]; c1 -= A0_3[1] * x[45]; c2 -= A0_3[2] * x[46]; c3 -= A0_3[3] * x[47]; c0 -= A0_4[0] * x[48]; c1 -= A0_4[1] * x[49]; c2 -= A0_4[2] * x[50]; c3 -= A0_4[3] * x[51]; c0 -= A0_5[0] * x[52]; c1 -= A0_5[1] * x[53]; c2 -= A0_5[2] * x[54]; c3 -= A0_5[3] * x[55]; c0 -= A0_6[0] * x[56]; c1 -= A0_6[1] * x[57]; c2 -= A0_6[2] * x[58]; c3 -= A0_6[3] * x[59]; x[60] = (c0 + c1) + (c2 + c3); __builtin_amdgcn_sched_barrier(0);
            A0_0 = *(const LAS f32x4*)(Amv + 4180); A0_1 = *(const LAS f32x4*)(Amv + 4184); A0_2 = *(const LAS f32x4*)(Amv + 4188); A0_3 = *(const LAS f32x4*)(Amv + 4192); A0_4 = *(const LAS f32x4*)(Amv + 4196); A0_5 = *(const LAS f32x4*)(Amv + 4200); A0_6 = *(const LAS f32x4*)(Amv + 4204); A0_7 = *(const LAS f32x4*)(Amv + 4208); __builtin_amdgcn_sched_barrier(0); c0 = r1; c1 = 0.f; c2 = 0.f; c3 = 0.f; c0 -= A1_0[0] * x[0]; c1 -= A1_0[1] * x[1]; c2 -= A1_0[2] * x[2]; c3 -= A1_0[3] * x[3]; c0 -= A1_1[0] * x[4]; c1 -= A1_1[1] * x[5]; c2 -= A1_1[2] * x[6]; c3 -= A1_1[3] * x[7]; c0 -= A1_2[0] * x[8]; c1 -= A1_2[1] * x[9]; c2 -= A1_2[2] * x[10]; c3 -= A1_2[3] * x[11]; c0 -= A1_3[0] * x[12]; c1 -= A1_3[1] * x[13]; c2 -= A1_3[2] * x[14]; c3 -= A1_3[3] * x[15]; c0 -= A1_4[0] * x[16]; c1 -= A1_4[1] * x[17]; c2 -= A1_4[2] * x[18]; c3 -= A1_4[3] * x[19]; c0 -= A1_5[0] * x[20]; c1 -= A1_5[1] * x[21]; c2 -= A1_5[2] * x[22]; c3 -= A1_5[3] * x[23]; c0 -= A1_6[0] * x[24]; c1 -= A1_6[1] * x[25]; c2 -= A1_6[2] * x[26]; c3 -= A1_6[3] * x[27]; c0 -= A1_7[0] * x[28]; c1 -= A1_7[1] * x[29]; c2 -= A1_7[2] * x[30]; c3 -= A1_7[3] * x[31]; __builtin_amdgcn_sched_barrier(0);
            A1_0 = *(const LAS f32x4*)(Amv + 4216); A1_1 = *(const LAS f32x4*)(Amv + 4220); A1_2 = *(const LAS f32x4*)(Amv + 4224); A1_3 = *(const LAS f32x4*)(Amv + 4228); A1_4 = *(const LAS f32x4*)(Amv + 4232); A1_5 = *(const LAS f32x4*)(Amv + 4236); A1_6 = *(const LAS f32x4*)(Amv + 4240); A1_7 = *(const LAS f32x4*)(Amv + 4244); r1 = RHS[15872 + c]; __builtin_amdgcn_sched_barrier(0); c0 -= A0_0[0] * x[32]; c1 -= A0_0[1] * x[33]; c2 -= A0_0[2] * x[34]; c3 -= A0_0[3] * x[35]; c0 -= A0_1[0] * x[36]; c1 -= A0_1[1] * x[37]; c2 -= A0_1[2] * x[38]; c3 -= A0_1[3] * x[39]; c0 -= A0_2[0] * x[40]; c1 -= A0_2[1] * x[41]; c2 -= A0_2[2] * x[42]; c3 -= A0_2[3] * x[43]; c0 -= A0_3[0] * x[44]; c1 -= A0_3[1] * x[45]; c2 -= A0_3[2] * x[46]; c3 -= A0_3[3] * x[47]; c0 -= A0_4[0] * x[48]; c1 -= A0_4[1] * x[49]; c2 -= A0_4[2] * x[50]; c3 -= A0_4[3] * x[51]; c0 -= A0_5[0] * x[52]; c1 -= A0_5[1] * x[53]; c2 -= A0_5[2] * x[54]; c3 -= A0_5[3] * x[55]; c0 -= A0_6[0] * x[56]; c1 -= A0_6[1] * x[57]; c2 -= A0_6[2] * x[58]; c3 -= A0_6[3] * x[59]; c0 -= A0_7[0] * x[60]; x[61] = (c0 + c1) + (c2 + c3); __builtin_amdgcn_sched_barrier(0);
            A0_0 = *(const LAS f32x4*)(Amv + 4248); A0_1 = *(const LAS f32x4*)(Amv + 4252); A0_2 = *(const LAS f32x4*)(Amv + 4256); A0_3 = *(const LAS f32x4*)(Amv + 4260); A0_4 = *(const LAS f32x4*)(Amv + 4264); A0_5 = *(const LAS f32x4*)(Amv + 4268); A0_6 = *(const LAS f32x4*)(Amv + 4272); A0_7 = *(const LAS f32x4*)(Amv + 4276); __builtin_amdgcn_sched_barrier(0); c0 = r1; c1 = 0.f; c2 = 0.f; c3 = 0.f; c0 -= A1_0[0] * x[0]; c1 -= A1_0[1] * x[1]; c2 -= A1_0[2] * x[2]; c3 -= A1_0[3] * x[3]; c0 -= A1_1[0] * x[4]; c1 -= A1_1[1] * x[5]; c2 -= A1_1[2] * x[6]; c3 -= A1_1[3] * x[7]; c0 -= A1_2[0] * x[8]; c1 -= A1_2[1] * x[9]; c2 -= A1_2[2] * x[10]; c3 -= A1_2[3] * x[11]; c0 -= A1_3[0] * x[12]; c1 -= A1_3[1] * x[13]; c2 -= A1_3[2] * x[14]; c3 -= A1_3[3] * x[15]; c0 -= A1_4[0] * x[16]; c1 -= A1_4[1] * x[17]; c2 -= A1_4[2] * x[18]; c3 -= A1_4[3] * x[19]; c0 -= A1_5[0] * x[20]; c1 -= A1_5[1] * x[21]; c2 -= A1_5[2] * x[22]; c3 -= A1_5[3] * x[23]; c0 -= A1_6[0] * x[24]; c1 -= A1_6[1] * x[25]; c2 -= A1_6[2] * x[26]; c3 -= A1_6[3] * x[27]; c0 -= A1_7[0] * x[28]; c1 -= A1_7[1] * x[29]; c2 -= A1_7[2] * x[30]; c3 -= A1_7[3] * x[31]; __builtin_amdgcn_sched_barrier(0);
            A1_0 = *(const LAS f32x4*)(Amv + 4284); A1_1 = *(const LAS f32x4*)(Amv + 4288); A1_2 = *(const LAS f32x4*)(Amv + 4292); A1_3 = *(const LAS f32x4*)(Amv + 4296); A1_4 = *(const LAS f32x4*)(Amv + 4300); A1_5 = *(const LAS f32x4*)(Amv + 4304); A1_6 = *(const LAS f32x4*)(Amv + 4308); A1_7 = *(const LAS f32x4*)(Amv + 4312); r1 = RHS[16128 + c]; __builtin_amdgcn_sched_barrier(0); c0 -= A0_0[0] * x[32]; c1 -= A0_0[1] * x[33]; c2 -= A0_0[2] * x[34]; c3 -= A0_0[3] * x[35]; c0 -= A0_1[0] * x[36]; c1 -= A0_1[1] * x[37]; c2 -= A0_1[2] * x[38]; c3 -= A0_1[3] * x[39]; c0 -= A0_2[0] * x[40]; c1 -= A0_2[1] * x[41]; c2 -= A0_2[2] * x[42]; c3 -= A0_2[3] * x[43]; c0 -= A0_3[0] * x[44]; c1 -= A0_3[1] * x[45]; c2 -= A0_3[2] * x[46]; c3 -= A0_3[3] * x[47]; c0 -= A0_4[0] * x[48]; c1 -= A0_4[1] * x[49]; c2 -= A0_4[2] * x[50]; c3 -= A0_4[3] * x[51]; c0 -= A0_5[0] * x[52]; c1 -= A0_5[1] * x[53]; c2 -= A0_5[2] * x[54]; c3 -= A0_5[3] * x[55]; c0 -= A0_6[0] * x[56]; c1 -= A0_6[1] * x[57]; c2 -= A0_6[2] * x[58]; c3 -= A0_6[3] * x[59]; c0 -= A0_7[0] * x[60]; c1 -= A0_7[1] * x[61]; x[62] = (c0 + c1) + (c2 + c3); __builtin_amdgcn_sched_barrier(0);
            A0_0 = *(const LAS f32x4*)(Amv + 4316); A0_1 = *(const LAS f32x4*)(Amv + 4320); A0_2 = *(const LAS f32x4*)(Amv + 4324); A0_3 = *(const LAS f32x4*)(Amv + 4328); A0_4 = *(const LAS f32x4*)(Amv + 4332); A0_5 = *(const LAS f32x4*)(Amv + 4336); A0_6 = *(const LAS f32x4*)(Amv + 4340); A0_7 = *(const LAS f32x4*)(Amv + 4344); __builtin_amdgcn_sched_barrier(0); c0 = r1; c1 = 0.f; c2 = 0.f; c3 = 0.f; c0 -= A1_0[0] * x[0]; c1 -= A1_0[1] * x[1]; c2 -= A1_0[2] * x[2]; c3 -= A1_0[3] * x[3]; c0 -= A1_1[0] * x[4]; c1 -= A1_1[1] * x[5]; c2 -= A1_1[2] * x[6]; c3 -= A1_1[3] * x[7]; c0 -= A1_2[0] * x[8]; c1 -= A1_2[1] * x[9]; c2 -= A1_2[2] * x[10]; c3 -= A1_2[3] * x[11]; c0 -= A1_3[0] * x[12]; c1 -= A1_3[1] * x[13]; c2 -= A1_3[2] * x[14]; c3 -= A1_3[3] * x[15]; c0 -= A1_4[0] * x[16]; c1 -= A1_4[1] * x[17]; c2 -= A1_4[2] * x[18]; c3 -= A1_4[3] * x[19]; c0 -= A1_5[0] * x[20]; c1 -= A1_5[1] * x[21]; c2 -= A1_5[2] * x[22]; c3 -= A1_5[3] * x[23]; c0 -= A1_6[0] * x[24]; c1 -= A1_6[1] * x[25]; c2 -= A1_6[2] * x[26]; c3 -= A1_6[3] * x[27]; c0 -= A1_7[0] * x[28]; c1 -= A1_7[1] * x[29]; c2 -= A1_7[2] * x[30]; c3 -= A1_7[3] * x[31]; __builtin_amdgcn_sched_barrier(0);
            __builtin_amdgcn_sched_barrier(0); c0 -= A0_0[0] * x[32]; c1 -= A0_0[1] * x[33]; c2 -= A0_0[2] * x[34]; c3 -= A0_0[3] * x[35]; c0 -= A0_1[0] * x[36]; c1 -= A0_1[1] * x[37]; c2 -= A0_1[2] * x[38]; c3 -= A0_1[3] * x[39]; c0 -= A0_2[0] * x[40]; c1 -= A0_2[1] * x[41]; c2 -= A0_2[2] * x[42]; c3 -= A0_2[3] * x[43]; c0 -= A0_3[0] * x[44]; c1 -= A0_3[1] * x[45]; c2 -= A0_3[2] * x[46]; c3 -= A0_3[3] * x[47]; c0 -= A0_4[0] * x[48]; c1 -= A0_4[1] * x[49]; c2 -= A0_4[2] * x[50]; c3 -= A0_4[3] * x[51]; c0 -= A0_5[0] * x[52]; c1 -= A0_5[1] * x[53]; c2 -= A0_5[2] * x[54]; c3 -= A0_5[3] * x[55]; c0 -= A0_6[0] * x[56]; c1 -= A0_6[1] * x[57]; c2 -= A0_6[2] * x[58]; c3 -= A0_6[3] * x[59]; c0 -= A0_7[0] * x[60]; c1 -= A0_7[1] * x[61]; c2 -= A0_7[2] * x[62]; x[63] = (c0 + c1) + (c2 + c3); __builtin_amdgcn_sched_barrier(0);
            if (c < 128) {
                bf16* ub = GUT + ch * 8192 + (size_t)((c >> 5) * 8) * 256 + (c & 31) * 4;
#pragma unroll
                for (int mi = 0; mi < 2; ++mi)
#pragma unroll
                    for (int g = 0; g < 4; ++g)
#pragma unroll
                        for (int hh = 0; hh < 2; ++hh) { const int i0 = mi * 32 + 8 * g + 4 * hh; v2u o; o.x = pk2(x[i0], x[i0 + 1]); o.y = pk2(x[i0 + 2], x[i0 + 3]);
                            *(v2u*)(ub + (mi * 4 + g) * 256 + hh * 128) = o; }
            } else {
                const int k = c - 128; bf16* wb = GW + ch * 8192 + ((k >> 4) * 64 + ((k >> 3) & 1) * 32) * 8 + (k & 7);
#pragma unroll
                for (int i = 0; i < 64; ++i) wb[((i >> 5) * 8 * 64 + (i & 31)) * 8] = (bf16)f2bf(x[i]);
            }
        }
        LBAR();
    }
}

struct GdnFr { s16x8 a[8]; s16x8 c[4]; s16x8 d[4]; v2u u[4]; float egl; };
__device__ __forceinline__ void phase_gdn_scan(const Args& A, LAS unsigned char* lds, int vcu, int G, int tid, int lane, int wave) {
    unsigned char* ws = A.ws;
    const bf16* GW = (const bf16*)(ws + WS_GW); const bf16* GQG = (const bf16*)(ws + WS_GQG); const bf16* GKDT = (const bf16*)(ws + WS_GKDT); const bf16* GUT = (const bf16*)(ws + WS_GUT); const bf16* GQKM = (const bf16*)(ws + WS_GQKM);
    const float* EGL = (const float*)(ws + WS_EGL); bf16* OB = (bf16*)(ws + WS_OB);
    LAS bf16* ST = (LAS bf16*)lds; LAS bf16* VT = (LAS bf16*)(lds + 17408);
    const int r32 = lane & 31, hi = lane >> 5;
    const int grp = wave >> 2, mi = (wave >> 1) & 1, ni = wave & 1, di = wave >> 1, nd = wave & 1;
    for (int chain = vcu; chain < 256; chain += G) {
        const int b = chain >> 3, h = (chain >> 1) & 3, half = chain & 1;
        for (int e = tid; e < 17408 / 4; e += NTHR) ((LAS unsigned*)lds)[e] = 0u;
        __syncthreads();
        f32x16v Sacc = {};
#define GDN_LOAD(f, nn) do { const size_t ch_ = ((size_t)b * 32 + (nn)) * 4 + h; \
            const bf16* ab_ = (grp == 0 ? GW : GQG) + ch_ * 8192 + (mi * 8 * 64 + lane) * 8; \
            _Pragma("unroll") for (int kk = 0; kk < 8; ++kk) f.a[kk] = *(const s16x8*)(ab_ + kk * 512); \
            { const bf16* cb_ = GQKM + ch_ * 4096 + (mi * 4 * 64 + lane) * 8; _Pragma("unroll") for (int kk = 0; kk < 4; ++kk) f.c[kk] = *(const s16x8*)(cb_ + kk * 512); } \
            { const bf16* ub_ = GUT + ch_ * 8192 + (size_t)(((half * 2 + ni) * 2 + mi) * 4) * 256 + lane * 4; _Pragma("unroll") for (int g = 0; g < 4; ++g) f.u[g] = *(const v2u*)(ub_ + g * 256); } \
            const bf16* db_ = GKDT + ch_ * 8192 + (di * 4 * 64 + lane) * 8; _Pragma("unroll") for (int kk = 0; kk < 4; ++kk) f.d[kk] = *(const s16x8*)(db_ + kk * 512); \
            f.egl = EGL[ch_]; } while (0)
#define GDN_COMPUTE(f, nn) do { f32x16v Dv = {}; const LAS bf16* sb_ = ST + (ni * 32 + r32) * 136 + hi * 8; \
            _Pragma("unroll") for (int kk = 0; kk < 8; ++kk) Dv = __builtin_amdgcn_mfma_f32_32x32x16_bf16(f.a[kk], *(const LAS s16x8*)(sb_ + kk * 16), Dv, 0, 0, 0); \
            if (grp == 0) { _Pragma("unroll") for (int g = 0; g < 4; ++g) { const v2u uu = f.u[g]; \
                const float v0 = __uint_as_float(uu.x << 16) - Dv[4 * g], v1 = __uint_as_float(uu.x & 0xffff0000u) - Dv[4 * g + 1], v2 = __uint_as_float(uu.y << 16) - Dv[4 * g + 2], v3 = __uint_as_float(uu.y & 0xffff0000u) - Dv[4 * g + 3]; \
                v2u pk_; pk_.x = pk2(v0, v1); pk_.y = pk2(v2, v3); *(LAS v2u*)(VT + (ni * 32 + r32) * 72 + mi * 32 + 8 * g + 4 * hi) = pk_; } } \
            LBAR(); \
            if (grp == 1) { const LAS bf16* vb_ = VT + (ni * 32 + r32) * 72 + hi * 8; \
                _Pragma("unroll") for (int kk = 0; kk < 4; ++kk) Dv = __builtin_amdgcn_mfma_f32_32x32x16_bf16(f.c[kk], *(const LAS s16x8*)(vb_ + kk * 16), Dv, 0, 0, 0); \
                bf16* ob_ = OB + ((size_t)b * SEQ + (nn) * 64 + mi * 32) * 512 + h * 128 + half * 64 + ni * 32 + r32; \
                _Pragma("unroll") for (int r = 0; r < 16; ++r) ob_[(size_t)crow16(r, hi) * 512] = (bf16)f2bf(Dv[r]); } \
            { const LAS bf16* vb2_ = VT + (nd * 32 + r32) * 72 + hi * 8; Sacc = Sacc * f.egl; \
              _Pragma("unroll") for (int kk = 0; kk < 4; ++kk) Sacc = __builtin_amdgcn_mfma_f32_32x32x16_bf16(f.d[kk], *(const LAS s16x8*)(vb2_ + kk * 16), Sacc, 0, 0, 0); \
              _Pragma("unroll") for (int g = 0; g < 4; ++g) { v2u pk_; pk_.x = pk2(Sacc[4 * g], Sacc[4 * g + 1]); pk_.y = pk2(Sacc[4 * g + 2], Sacc[4 * g + 3]); *(LAS v2u*)(ST + (nd * 32 + r32) * 136 + di * 32 + 8 * g + 4 * hi) = pk_; } } \
            LBAR(); } while (0)
        GdnFr fa, fb;
        GDN_LOAD(fa, 0);
        for (int n = 0; n < 32; n += 2) {
            GDN_LOAD(fb, n + 1);
            GDN_COMPUTE(fa, n);
            if (n + 2 < 32) GDN_LOAD(fa, n + 2);
            GDN_COMPUTE(fb, n + 1);
        }
#undef GDN_LOAD
#undef GDN_COMPUTE
        __syncthreads();
    }
}

struct GdnFr2 { s16x8 a[8]; v2u x[8]; float egl; };
__device__ __forceinline__ void phase_gdn_scan2(const Args& A, LAS unsigned char* lds, int vcu, int G, int tid, int lane, int wave) {
    unsigned char* ws = A.ws;
    const bf16* GW = (const bf16*)(ws + WS_GW); const bf16* GQG = (const bf16*)(ws + WS_GQG); const bf16* GKDT = (const bf16*)(ws + WS_GKDT); const bf16* GUT = (const bf16*)(ws + WS_GUT); const bf16* GQKM = (const bf16*)(ws + WS_GQKM);
    const float* EGL = (const float*)(ws + WS_EGL); bf16* OB = (bf16*)(ws + WS_OB);
    LAS bf16* ST = (LAS bf16*)lds; LAS bf16* VT = (LAS bf16*)(lds + 17408);
    const int r32 = lane & 31, hi = lane >> 5;
    const bool roleV = wave < 2, roleO = (wave >> 1) == 1, roleS = wave >= 4;
    const int mi = wave & 1, di = wave & 3;
    for (int chain = vcu; chain < 256; chain += G) {
        const int b = chain >> 3, h = (chain >> 1) & 3, half = chain & 1;
        for (int e = tid; e < 17408 / 4; e += NTHR) ((LAS unsigned*)lds)[e] = 0u;
        __syncthreads();
        f32x16v acc0 = {}, acc1 = {};
#define G2_LOAD(f, nn) do { const int n_ = (nn) < 32 ? (nn) : 31; const size_t ch_ = ((size_t)b * 32 + n_) * 4 + h; \
            const bf16* pa_ = roleV ? GW + ch_ * 8192 + (mi * 8 * 64 + lane) * 8 : roleO ? GQG + ch_ * 8192 + (mi * 8 * 64 + lane) * 8 : GKDT + ch_ * 8192 + (di * 4 * 64 + lane) * 8; \
            _Pragma("unroll") for (int kk = 0; kk < 8; ++kk) { const int kq_ = roleS ? (kk & 3) : kk; f.a[kk] = *(const s16x8*)(pa_ + kq_ * 512); } \
            const bf16* px_ = roleV ? GUT + ch_ * 8192 + (size_t)((half * 2) * 2 + mi) * 1024 + lane * 4 : GQKM + ch_ * 4096 + (mi * 4 * 64) * 8 + lane * 8; \
            _Pragma("unroll") for (int j = 0; j < 8; ++j) { const int ox_ = roleV ? (j >> 2) * 2048 + (j & 3) * 256 : (j >> 1) * 512 + (j & 1) * 4; f.x[j] = *(const v2u*)(px_ + ox_); } \
            f.egl = EGL[ch_]; } while (0)
#define G2_COMPUTE(f, nn) do { if ((nn) < 32) { \
            if (!roleS) { acc0 = f32x16v{}; acc1 = f32x16v{}; const LAS bf16* sb0_ = ST + r32 * 136 + hi * 8; const LAS bf16* sb1_ = ST + (32 + r32) * 136 + hi * 8; \
                _Pragma("unroll") for (int kk = 0; kk < 8; ++kk) { acc0 = __builtin_amdgcn_mfma_f32_32x32x16_bf16(f.a[kk], *(const LAS s16x8*)(sb0_ + kk * 16), acc0, 0, 0, 0); \
                                                                 acc1 = __builtin_amdgcn_mfma_f32_32x32x16_bf16(f.a[kk], *(const LAS s16x8*)(sb1_ + kk * 16), acc1, 0, 0, 0); } \
                if (roleV) { _Pragma("unroll") for (int g = 0; g < 4; ++g) { \
                    { const v2u uu = f.x[g]; v2u pk_; pk_.x = pk2(__uint_as_float(uu.x << 16) - acc0[4 * g], __uint_as_float(uu.x & 0xffff0000u) - acc0[4 * g + 1]); pk_.y = pk2(__uint_as_float(uu.y << 16) - acc0[4 * g + 2], __uint_as_float(uu.y & 0xffff0000u) - acc0[4 * g + 3]); \
                      *(LAS v2u*)(VT + r32 * 72 + mi * 32 + 8 * g + 4 * hi) = pk_; } \
                    { const v2u uu = f.x[4 + g]; v2u pk_; pk_.x = pk2(__uint_as_float(uu.x << 16) - acc1[4 * g], __uint_as_float(uu.x & 0xffff0000u) - acc1[4 * g + 1]); pk_.y = pk2(__uint_as_float(uu.y << 16) - acc1[4 * g + 2], __uint_as_float(uu.y & 0xffff0000u) - acc1[4 * g + 3]); \
                      *(LAS v2u*)(VT + (32 + r32) * 72 + mi * 32 + 8 * g + 4 * hi) = pk_; } } } } \
            LBAR(); \
            { const LAS bf16* vb0_ = VT + r32 * 72 + hi * 8; const LAS bf16* vb1_ = VT + (32 + r32) * 72 + hi * 8; \
              if (roleO) { \
                _Pragma("unroll") for (int kk = 0; kk < 4; ++kk) { v4u q_; q_.x = f.x[2 * kk].x; q_.y = f.x[2 * kk].y; q_.z = f.x[2 * kk + 1].x; q_.w = f.x[2 * kk + 1].y; const s16x8 fr_ = __builtin_bit_cast(s16x8, q_); \
                    acc0 = __builtin_amdgcn_mfma_f32_32x32x16_bf16(fr_, *(const LAS s16x8*)(vb0_ + kk * 16), acc0, 0, 0, 0); acc1 = __builtin_amdgcn_mfma_f32_32x32x16_bf16(fr_, *(const LAS s16x8*)(vb1_ + kk * 16), acc1, 0, 0, 0); } \
                bf16* ob_ = OB + ((size_t)b * SEQ + (nn) * 64 + mi * 32) * 512 + h * 128 + half * 64 + r32; \
                _Pragma("unroll") for (int r = 0; r < 16; ++r) { ob_[(size_t)crow16(r, hi) * 512] = (bf16)f2bf(acc0[r]); ob_[(size_t)crow16(r, hi) * 512 + 32] = (bf16)f2bf(acc1[r]); } } \
              if (roleS) { acc0 = acc0 * f.egl; acc1 = acc1 * f.egl; \
                _Pragma("unroll") for (int kk = 0; kk < 4; ++kk) { acc0 = __builtin_amdgcn_mfma_f32_32x32x16_bf16(f.a[kk], *(const LAS s16x8*)(vb0_ + kk * 16), acc0, 0, 0, 0); acc1 = __builtin_amdgcn_mfma_f32_32x32x16_bf16(f.a[kk], *(const LAS s16x8*)(vb1_ + kk * 16), acc1, 0, 0, 0); } \
                _Pragma("unroll") for (int g = 0; g < 4; ++g) { v2u pk_; pk_.x = pk2(acc0[4 * g], acc0[4 * g + 1]); pk_.y = pk2(acc0[4 * g + 2], acc0[4 * g + 3]); *(LAS v2u*)(ST + r32 * 136 + di * 32 + 8 * g + 4 * hi) = pk_; \
                                                                   pk_.x = pk2(acc1[4 * g], acc1[4 * g + 1]); pk_.y = pk2(acc1[4 * g + 2], acc1[4 * g + 3]); *(LAS v2u*)(ST + (32 + r32) * 136 + di * 32 + 8 * g + 4 * hi) = pk_; } } } \
            LBAR(); } } while (0)
        GdnFr2 f0, f1, f2;
        G2_LOAD(f0, 0); G2_LOAD(f1, 1);
        for (int n = 0; n < 33; n += 3) {
            G2_LOAD(f2, n + 2); G2_COMPUTE(f0, n);
            G2_LOAD(f0, n + 3); G2_COMPUTE(f1, n + 1);
            G2_LOAD(f1, n + 4); G2_COMPUTE(f2, n + 2);
        }
#undef G2_LOAD
#undef G2_COMPUTE
        __syncthreads();
    }
}

__device__ __forceinline__ void phase_gate0(const Args& A, int vcu, int G, int lane, int wave) {
    unsigned char* ws = A.ws;
    const bf16* OA = (const bf16*)(ws + WS_OA); const bf16* OBp = (const bf16*)(ws + WS_OB);
    const bf16* PAZ = (const bf16*)(ws + WS_P) + 1 * PSTRIDE + 512;
    const bf16* PBZ = (const bf16*)(ws + WS_P) + 3 * PSTRIDE + 512;
    bf16* MIX = (bf16*)(ws + WS_XB);
    const float l1 = wave_sum(A.lq1[lane] * A.lk1[lane]), l2 = wave_sum(A.lq2[lane] * A.lk2[lane]);
    const float lam = expf(l1) - expf(l2) + 0.2f;
    const int e0 = (8 * lane) & 127; float sub[8], hn[8];
#pragma unroll
    for (int i = 0; i < 8; ++i) { sub[i] = A.subln[e0 + i] * 0.8f; hn[i] = A.head_norm[e0 + i]; }
    const int gw = vcu * NWAVES + wave, NGW = G * NWAVES;
    for (int m = gw; m < M; m += NGW) {
        const v4u o0 = *(const v4u*)(OA + (size_t)m * 1024 + 8 * lane), o1 = *(const v4u*)(OA + (size_t)m * 1024 + 512 + 8 * lane);
        const v4u az = *(const v4u*)(PAZ + (size_t)m * 1024 + 8 * lane), bz = *(const v4u*)(PBZ + (size_t)m * 1024 + 8 * lane);
        const v4u ob = *(const v4u*)(OBp + (size_t)m * 512 + 8 * lane);
        float f0[8], f1[8], fz[8], d[8], r[8];
        unpack8(o0, f0); unpack8(o1, f1); unpack8(az, fz);
        float ss = 0.f;
#pragma unroll
        for (int i = 0; i < 8; ++i) { d[i] = f0[i] - lam * f1[i]; ss += d[i] * d[i]; }
        ss = row16_sum(ss);
        float rs = __builtin_amdgcn_rsqf(ss * (1.f / 128.f) + EPS);
#pragma unroll
        for (int i = 0; i < 8; ++i) r[i] = d[i] * rs * sub[i] * silu_f(fz[i]);
        v4u w; w.x = pk2(r[0], r[1]); w.y = pk2(r[2], r[3]); w.z = pk2(r[4], r[5]); w.w = pk2(r[6], r[7]);
        *(v4u*)(MIX + (size_t)m * 1024 + 8 * lane) = w;
        unpack8(ob, f0); unpack8(bz, fz);
        ss = 0.f;
#pragma unroll
        for (int i = 0; i < 8; ++i) ss += f0[i] * f0[i];
        ss = row16_sum(ss);
        rs = __builtin_amdgcn_rsqf(ss * (1.f / 128.f) + EPS);
#pragma unroll
        for (int i = 0; i < 8; ++i) r[i] = f0[i] * rs * hn[i] * silu_f(fz[i]);
        w.x = pk2(r[0], r[1]); w.y = pk2(r[2], r[3]); w.z = pk2(r[4], r[5]); w.w = pk2(r[6], r[7]);
        *(v4u*)(MIX + (size_t)m * 1024 + 512 + 8 * lane) = w;
    }
}

template <bool NEXT> __device__ __forceinline__ void phase_residual(const Args& A, LAS unsigned char* lds, const float* xin, const float* postw, int vcu, int G, int tid, int lane, int wave) {
    unsigned char* ws = A.ws;
    const bf16* Y = (const bf16*)(ws + WS_OA); bf16* XB = (bf16*)(ws + WS_XB); float* LOGF = (float*)(ws + WS_CUM);
    LAS float* wl = (LAS float*)lds;
    if (NEXT) { stage_small_w<16>(wl, A.w_in_c, IN_C, A.pre + D, tid); __syncthreads(); }
    f32x4 pw[4];
#pragma unroll
    for (int j = 0; j < 4; ++j) pw[j] = ((const f32x4*)postw)[64 * j + lane];
    const float fb = NEXT ? A.fbias[lane & 15] : 0.f;
    const int gw = vcu * NWAVES + wave, NGW = G * NWAVES;
    for (int m = gw; m < M; m += NGW) {
        const f32x4* xr = (const f32x4*)(xin + (size_t)m * D) + lane; const v2u* yr = (const v2u*)(Y + (size_t)m * D) + lane;
        f32x4 v[4], y[4];
#pragma unroll
        for (int j = 0; j < 4; ++j) { v[j] = xr[64 * j]; const v2u yy = yr[64 * j]; y[j].x = __uint_as_float(yy.x << 16); y[j].y = __uint_as_float(yy.x & 0xffff0000u); y[j].z = __uint_as_float(yy.y << 16); y[j].w = __uint_as_float(yy.y & 0xffff0000u); }
        const float ry = __builtin_amdgcn_rsqf(wave_sum(sumsq4(y)) * (1.f / D) + EPS);
#pragma unroll
        for (int j = 0; j < 4; ++j) v[j] = v[j] + y[j] * ry * pw[j];
        f32x4* orow = (f32x4*)(A.out + (size_t)m * D) + lane;
#pragma unroll
        for (int j = 0; j < 4; ++j) orow[64 * j] = v[j];
        if (NEXT) {
            const float rstd = __builtin_amdgcn_rsqf(wave_sum(sumsq4(v)) * (1.f / D) + EPS);
            store_row_bf16(XB + (size_t)m * D, v, rstd, lane);
            const float mine = small_dots<16>(wl, v, lane);
            if (lane < 16) { const float z = mine * rstd + fb; const float lf = fminf(z, 0.f) - log1pf(expf(-fabsf(z))); const int b = m / SEQ, sidx = m % SEQ; LOGF[((size_t)b * 16 + lane) * SEQ + sidx] = lf; }
        }
    }
}

__device__ __forceinline__ void phase_cumsum(const Args& A, int vcu, int G, int lane, int wave) {
    float* C = (float*)(A.ws + WS_CUM);
    const int gw = vcu * NWAVES + wave, NGW = G * NWAVES;
    for (int sq = gw; sq < BATCH * 16; sq += NGW) {
        f32x4* p = (f32x4*)(C + (size_t)sq * SEQ + 32 * lane); f32x4 v[8]; float run = 0.f;
#pragma unroll
        for (int j = 0; j < 8; ++j) { v[j] = p[j]; v[j].x += run; v[j].y += v[j].x; v[j].z += v[j].y; v[j].w += v[j].z; run = v[j].w; }
        float inc = run;
#pragma unroll
        for (int o = 1; o < 64; o <<= 1) { const float t = __shfl_up(inc, o); if (lane >= o) inc += t; }
        const float excl = inc - run;
#pragma unroll
        for (int j = 0; j < 8; ++j) { v[j] = v[j] + excl; p[j] = v[j]; }
    }
}

__device__ __forceinline__ void phase_gate1(const Args& A, int vcu, int G, int tid) {
    unsigned char* ws = A.ws;
    const v4u* O = (const v4u*)(ws + WS_OA); const v4u* Z = (const v4u*)((const bf16*)(ws + WS_P) + 3 * PSTRIDE); v4u* MIX = (v4u*)(ws + WS_XB);
    const size_t n = (size_t)M * 1024 / 8;
    for (size_t i = (size_t)vcu * NTHR + tid; i < n; i += (size_t)G * NTHR) {
        const v4u o = O[i], z = Z[i]; float fo[8], fz[8]; unpack8(o, fo); unpack8(z, fz);
#pragma unroll
        for (int k = 0; k < 8; ++k) fo[k] *= silu_f(fz[k]);
        v4u w; w.x = pk2(fo[0], fo[1]); w.y = pk2(fo[2], fo[3]); w.z = pk2(fo[4], fo[5]); w.w = pk2(fo[6], fo[7]);
        MIX[i] = w;
    }
}

__global__ void __launch_bounds__(NTHR, 2) trunk_fwd(Args A) {
    extern __shared__ __attribute__((aligned(16))) unsigned char lds_raw[];
    cg::grid_group grid = cg::this_grid();
    LAS unsigned char* lds = (LAS unsigned char*)lds_raw;
    const int tid = threadIdx.x, lane = tid & 63, wave = __builtin_amdgcn_readfirstlane(tid >> 6);
    const int G = gridDim.x, bx = blockIdx.x; const int vcu = (G % 8 == 0) ? (bx % 8) * (G / 8) + bx / 8 : bx;
    unsigned char* ws = A.ws;
    bf16* XB = (bf16*)(ws + WS_XB); bf16* P = (bf16*)(ws + WS_P); bf16* OA = (bf16*)(ws + WS_OA);
    volatile LAS unsigned* bst = (volatile LAS unsigned*)(lds + 147456 - 16);
    if (tid < 4) ((LAS unsigned*)(lds + 147456 - 16))[tid] = 0u;
    __syncthreads();
    const XcdBarrier xbar = xcd_barrier_post((unsigned*)(ws + WS_BAR), bst);
#define GSYNC() xcd_barrier(xbar)

    phase_prologue(A, lds, vcu, G, tid, lane, wave);
    grid.sync();
    {   pg8::Gemm g{XB, (const bf16*)(ws + WS_W1T), M, NP, D}; pg8::StaticOrder S; S.init(M, NP, G, bx);
        EpiRope E{P, (const float*)(ws + WS_CS)};
        pg8::gemm_phase<EpiRope, pg8::StaticOrder, PG8_ALIGN, PG8_SP2>(lds, g, S, E); }
    GSYNC();
    phase_gdn_prep(A, lds, vcu, G, tid, lane, wave);
    GSYNC();
    phase_gdn_scan2(A, lds, vcu, G, tid, lane, wave);
    {   const attn_body::AttnTensors AT{(const attn_body::bf16*)P, (const attn_body::bf16*)(P + 512), (const attn_body::bf16*)(P + PSTRIDE), (attn_body::bf16*)OA, nullptr, nullptr};
        const attn_body::StaticOrder S(vcu, G, 1024);
        attn_body::attn_phase<false>((char*)lds_raw, AT, S); }
    GSYNC();
    phase_gate0(A, vcu, G, lane, wave);
    GSYNC();
    {   pg8::Gemm g{XB, (const bf16*)(ws + WS_WO1T), M, D, D}; pg8::StaticOrder S; S.init(M, D, G, bx);
        pg8::EpiBf16<0> E{OA, D, nullptr, 0, 0, 1.f};
        pg8::gemm_phase<pg8::EpiBf16<0>, pg8::StaticOrder, PG8_ALIGN, PG8_SP2>(lds, g, S, E); }
    GSYNC();
    phase_residual<true>(A, lds, A.x, A.post, vcu, G, tid, lane, wave);
    GSYNC();
    phase_cumsum(A, vcu, G, lane, wave);
    {   pg8::Gemm g{XB, (const bf16*)(ws + WS_W2T), M, NP, D}; pg8::StaticOrder S; S.init(M, NP, G, bx);
        pg8::EpiBf16<0> E{P, D, nullptr, 1024, PSTRIDE, 1.f};
        pg8::gemm_phase<pg8::EpiBf16<0>, pg8::StaticOrder, PG8_ALIGN, PG8_SP2>(lds, g, S, E); }
    GSYNC();
    {   const attn_body::AttnTensors AT{(const attn_body::bf16*)P, (const attn_body::bf16*)(P + PSTRIDE), (const attn_body::bf16*)(P + 2 * PSTRIDE), (attn_body::bf16*)XB, (const float*)(ws + WS_CUM), (const attn_body::bf16*)(P + 3 * PSTRIDE)};
        const attn_body::StaticOrder S(vcu, G, 2048);
        attn_body::attn_phase<true>((char*)lds_raw, AT, S); }
    GSYNC();
    {   pg8::Gemm g{XB, (const bf16*)(ws + WS_WO2T), M, D, D}; pg8::StaticOrder S; S.init(M, D, G, bx);
        pg8::EpiBf16<0> E{OA, D, nullptr, 0, 0, 1.f};
        pg8::gemm_phase<pg8::EpiBf16<0>, pg8::StaticOrder, PG8_ALIGN, PG8_SP2>(lds, g, S, E); }
    GSYNC();
    phase_residual<false>(A, lds, A.out, A.post + D, vcu, G, tid, lane, wave);
}

extern "C" void kernel_launch(void* const* d_in, const int* in_sizes, int n_in, void* d_out, int out_size, void* d_ws, size_t ws_size, hipStream_t stream) {
    static int grid = 0;
    if (grid == 0) {
        if (n_in != 18 || out_size != M * D || ws_size < WS_END) { fprintf(stderr, "kernel_launch: unexpected shapes (n_in %d out %d ws %zu)\n", n_in, out_size, ws_size); grid = -1; return; }
        int dev = 0, cus = 0, per_cu = 0;
        hipGetDevice(&dev); hipDeviceGetAttribute(&cus, hipDeviceAttributeMultiprocessorCount, dev);
        if (hipFuncSetAttribute((const void*)trunk_fwd, hipFuncAttributeMaxDynamicSharedMemorySize, LDS_BYTES) != hipSuccess) { fprintf(stderr, "kernel_launch: hipFuncSetAttribute failed\n"); grid = -1; return; }
        if (hipOccupancyMaxActiveBlocksPerMultiprocessor(&per_cu, (const void*)trunk_fwd, NTHR, LDS_BYTES) != hipSuccess || per_cu < 1) { fprintf(stderr, "kernel_launch: occupancy query gives %d\n", per_cu); per_cu = 1; }
        (void)hipGetLastError();
        grid = cus * 1;
    }
    if (grid < 0) return;
    Args a{};
    a.x = (const float*)d_in[0]; a.pos = (const int*)d_in[1]; a.pre = (const float*)d_in[2]; a.post = (const float*)d_in[3]; a.w_in_ab = (const float*)d_in[4];
    a.lq1 = (const float*)d_in[5]; a.lk1 = (const float*)d_in[6]; a.lq2 = (const float*)d_in[7]; a.lk2 = (const float*)d_in[8]; a.subln = (const float*)d_in[9];
    a.convw = (const float*)d_in[10]; a.a_log = (const float*)d_in[11]; a.dt_bias = (const float*)d_in[12]; a.head_norm = (const float*)d_in[13]; a.w_out_ab = (const float*)d_in[14];
    a.w_in_c = (const float*)d_in[15]; a.fbias = (const float*)d_in[16]; a.w_out_c = (const float*)d_in[17];
    a.out = (float*)d_out; a.ws = (unsigned char*)d_ws;
    if (hipMemsetAsync((char*)d_ws + WS_BAR, 0, XCD_BAR_WORDS * 4, stream) != hipSuccess) { fprintf(stderr, "kernel_launch: memset failed\n"); return; }
    void* args[] = {&a};
    hipError_t e = hipLaunchCooperativeKernel((const void*)trunk_fwd, dim3(grid), dim3(NTHR), args, LDS_BYTES, stream);
    if (e != hipSuccess) fprintf(stderr, "kernel_launch: cooperative launch failed: %s (grid %d)\n", hipGetErrorString(e), grid);
}
```

```cpp
#include <hip/hip_runtime.h>
#include <cstdio>
#include <cstdint>
namespace pg8 {
#define PG8_LAS __attribute__((address_space(3)))
typedef unsigned short bf16_t;
typedef short bf16x8 __attribute__((ext_vector_type(8)));
typedef float f32x4 __attribute__((ext_vector_type(4)));
typedef unsigned u32x4 __attribute__((ext_vector_type(4)));
constexpr int BM = 256, BK = 64, HALF = 128, HTB = HALF * BK * 2  , STAGE_BYTES = 8 * HTB, NXCD = 8, WGM = 8;

__host__ __device__ __forceinline__ int lds_byte(int r, int c) { const int st = (r >> 4) * 2 + (c >> 5), rr = r & 15, cc = c & 31, ob = rr * 64 + cc * 2; return st * 1024 + (ob ^ (((ob >> 9) & 1) << 5)); }
__host__ __device__ __forceinline__ void stage_rc(int b, int& R, int& C) { const int st = b / 1024, sb = b % 1024, swz = sb ^ (((sb >> 9) & 1) << 5); R = (st >> 1) * 16 + swz / 64; C = (st & 1) * 32 + (swz % 64) / 2; }
__host__ __device__ __forceinline__ int perm32(int rho) { const int n = rho >> 4, i = rho & 15; return 8 * (i >> 2) + 4 * n + (i & 3); }

struct Unit { int pm, pn; };
struct Gemm { const bf16_t* A; const bf16_t* Bt; int M, N, K; };

struct StaticOrder {
    int nM, nN, nwg, G, c;
    __host__ __device__ void init(int M, int N, int G_, int c_) { nM = M / BM; nN = N / BM; nwg = nM * nN; G = G_; c = c_; }
    __host__ __device__ bool next(int i, Unit& u) const {
        const long L = (long)i * G + c; if (L >= nwg) return false;
        int wgid = (int)L; { const int q = nwg / NXCD, r = nwg % NXCD, xcd = wgid % NXCD, off = wgid / NXCD; wgid = (xcd < r ? xcd * (q + 1) : r * (q + 1) + (xcd - r) * q) + off; }
        const int nig = WGM * nN, gid = wgid / nig, fm = gid * WGM, gsz = (nM - fm) < WGM ? (nM - fm) : WGM;
        u.pm = fm + ((wgid % nig) % gsz); u.pn = (wgid % nig) / gsz; return true;
    }
    __device__ __forceinline__ void a_ready(const Unit&) const {}
    __device__ __forceinline__ void done(const Unit&) const {}
};

__device__ __forceinline__ unsigned cvt_pk_bf16(float lo, float hi) { unsigned r; asm volatile("v_cvt_pk_bf16_f32 %0, %1, %2" : "=v"(r) : "v"(lo), "v"(hi)); return r; }
typedef float f32x2 __attribute__((ext_vector_type(2)));
__device__ __forceinline__ f32x2 gelu_pk(f32x2 v) {
    const f32x2 av = __builtin_elementwise_abs(v), d = av * 0.2316418882f + 1.0f;
    f32x2 t; t.x = __builtin_amdgcn_rcpf(d.x); t.y = __builtin_amdgcn_rcpf(d.y);
    f32x2 q = t * 0.5307027145f + (-0.7265760135f); q = q * t + 0.7107068705f; q = q * t + (-0.142248368f); q = q * t + 0.127414796f; q = q * t;
    const f32x2 s = (v * v) * (-0.72134752044f);
    f32x2 e; e.x = __builtin_amdgcn_exp2f(s.x); e.y = __builtin_amdgcn_exp2f(s.y);
    const f32x2 m = v * (q * e), r = v - m;
    f32x2 o; o.x = v.x < 0.f ? m.x : r.x; o.y = v.y < 0.f ? m.y : r.y; return o;
}

template <int ACT  > struct EpiBf16 {
    static constexpr bool PERM = true, AFTER_DRAIN = false; static_assert(ACT == 0 || ACT == 1, "EpiBf16: ACT is 0 (none) or 1 (gelu_pk)");
    bf16_t* O; int ldc; const float* bias; int split_cols; size_t split_stride; float scale0;
    __device__ __forceinline__ void operator()(const f32x4 (&acc)[2][2][4][2], const Unit& u, int wr, int wc, int fr, int fq) const {
        const int row0 = u.pm * BM + wr * 64 + fr; int colt = u.pn * BM; bf16_t* base = O;
        float sc = 1.f; if (split_cols) { const int t = colt / split_cols; base += (size_t)t * split_stride; colt -= t * split_cols; if (t == 0) sc = scale0; }
        const int col0 = colt + wc * 32 + 8 * fq, bcol0 = u.pn * BM + wc * 32 + 8 * fq;
        f32x4 bv[2][2];
#pragma unroll
        for (int bj = 0; bj < 2; ++bj)
#pragma unroll
            for (int n = 0; n < 2; ++n) bv[bj][n] = bias ? *(const f32x4*)(bias + bcol0 + bj * HALF + 4 * n) : (f32x4){0.f, 0.f, 0.f, 0.f};
#pragma unroll
        for (int ai = 0; ai < 2; ++ai)
#pragma unroll
            for (int m = 0; m < 4; ++m) { bf16_t* rowp = base + (size_t)(row0 + ai * HALF + m * 16) * ldc + col0;
#pragma unroll
                for (int bj = 0; bj < 2; ++bj) { f32x4 v0 = acc[ai][bj][m][0] + bv[bj][0], v1 = acc[ai][bj][m][1] + bv[bj][1];
                    if (ACT == 1) { f32x2 a = gelu_pk((f32x2){v0[0], v0[1]}), b = gelu_pk((f32x2){v0[2], v0[3]}), c = gelu_pk((f32x2){v1[0], v1[1]}), d = gelu_pk((f32x2){v1[2], v1[3]});
                        v0 = (f32x4){a.x, a.y, b.x, b.y}; v1 = (f32x4){c.x, c.y, d.x, d.y}; }
                    v0 = v0 * sc; v1 = v1 * sc; u32x4 w; w.x = cvt_pk_bf16(v0[0], v0[1]); w.y = cvt_pk_bf16(v0[2], v0[3]); w.z = cvt_pk_bf16(v1[0], v1[1]); w.w = cvt_pk_bf16(v1[2], v1[3]);
                    *(u32x4*)(rowp + bj * HALF) = w; } }
    }
};
template <class Epi, class Sched, bool ALIGN_EPI = false, bool SP2 = false>
__device__ __forceinline__ void gemm_phase(PG8_LAS unsigned char* lds, const Gemm g, const Sched& S, const Epi& E) {
    int tid_ = threadIdx.x; asm volatile("" : "+v"(tid_)); const int tid = tid_, wid = __builtin_amdgcn_readfirstlane(tid >> 6), lane = tid & 63, wr = wid >> 2, wc = wid & 3, fr = lane & 15, fq = lane >> 4;
    const int K = g.K, nt = K / BK;
    unsigned voffA[2], voffB[2];
#pragma unroll
    for (int i = 0; i < 2; ++i) { int R, C; stage_rc(tid * 16 + i * 8192, R, C); const int Rb = Epi::PERM ? ((R & ~31) + perm32(R & 31)) : R;
        voffA[i] = (unsigned)(R * K + C) * 2u; voffB[i] = (unsigned)(Rb * K + C) * 2u; }
    const size_t kstep = (size_t)(BK * 2);
    const size_t hstep = (size_t)HALF * K * 2;
    const size_t tstep = 2 * hstep;
    const unsigned ldsw = (unsigned)wid * 1024u;
    const int aoff = lds_byte(wr * 64 + fr, fq * 8), boff = lds_byte(wc * 32 + fr, fq * 8);
#define PG8_SA(b, h) (((b) * 2 + (h)) * HTB)
#define PG8_SB(b, h) ((4 + (b) * 2 + (h)) * HTB)
#define PG8_STAGE(bufoff, gbase, voff) do { _Pragma("unroll") for (int _i = 0; _i < 2; ++_i) \
        __builtin_amdgcn_global_load_lds((const unsigned*)((const char*)(gbase) + (voff)[_i]), (PG8_LAS unsigned*)(lds + (bufoff) + ldsw + _i * 8192), 16, 0, 0); } while (0)
#define PG8_LDA(dst, b, h) do { _Pragma("unroll") for (int m = 0; m < 4; ++m) _Pragma("unroll") for (int k = 0; k < 2; ++k) dst[m][k] = *(const PG8_LAS bf16x8*)(lds + PG8_SA(b, h) + aoff + m * 2048 + k * 1024); } while (0)
#define PG8_LDB(dst, b, h) do { _Pragma("unroll") for (int n = 0; n < 2; ++n) _Pragma("unroll") for (int k = 0; k < 2; ++k) dst[n][k] = *(const PG8_LAS bf16x8*)(lds + PG8_SB(b, h) + boff + n * 2048 + k * 1024); } while (0)
#define PG8_MMA(ai, bj, At, Bt) do { __builtin_amdgcn_s_setprio(1); _Pragma("unroll") for (int m = 0; m < 4; ++m) _Pragma("unroll") for (int n = 0; n < 2; ++n) _Pragma("unroll") for (int k = 0; k < 2; ++k) \
        acc[ai][bj][m][n] = __builtin_amdgcn_mfma_f32_16x16x32_bf16(Bt[n][k], At[m][k], acc[ai][bj][m][n], 0, 0, 0); __builtin_amdgcn_s_setprio(0); } while (0)
#define PG8_WAIT_V(n) asm volatile("s_waitcnt vmcnt(" #n ")" ::: "memory")
#define PG8_WAIT_L(n) asm volatile("s_waitcnt lgkmcnt(" #n ")" ::: "memory")
#define PG8_BAR __builtin_amdgcn_s_barrier()
#define PG8_SCHED __builtin_amdgcn_sched_barrier(0)
    Unit cur, nxt; int ui = 0;
    if (!S.next(0, cur)) return;
    f32x4 acc[2][2][4][2];
#pragma unroll
    for (int a = 0; a < 2; ++a)
#pragma unroll
        for (int b = 0; b < 2; ++b)
#pragma unroll
            for (int m = 0; m < 4; ++m)
#pragma unroll
                for (int n = 0; n < 2; ++n) acc[a][b][m][n] = (f32x4){0.f, 0.f, 0.f, 0.f};
    bf16x8 At[4][2], B0[2][2], B1[2][2];
    const char* cA = (const char*)g.A + (size_t)cur.pm * tstep; const char* cB = (const char*)g.Bt + (size_t)cur.pn * tstep;
    S.a_ready(cur);
    if constexpr (SP2) {
        PG8_STAGE(PG8_SB(0, 0), cB, voffB); PG8_STAGE(PG8_SB(0, 1), cB + hstep, voffB); PG8_STAGE(PG8_SA(0, 0), cA, voffA); PG8_STAGE(PG8_SA(0, 1), cA + hstep, voffA);
        if (wr == 1) PG8_BAR;
        PG8_WAIT_V(2); PG8_BAR;
        PG8_STAGE(PG8_SB(1, 0), cB + kstep, voffB); PG8_STAGE(PG8_SA(1, 0), cA + kstep, voffA); PG8_STAGE(PG8_SB(1, 1), cB + hstep + kstep, voffB);
        PG8_WAIT_V(6); PG8_BAR;
    } else {
        PG8_STAGE(PG8_SB(0, 0), cB, voffB); PG8_STAGE(PG8_SA(0, 0), cA, voffA); PG8_STAGE(PG8_SB(0, 1), cB + hstep, voffB); PG8_STAGE(PG8_SA(0, 1), cA + hstep, voffA);
        if (wr == 1) PG8_BAR;
        PG8_WAIT_V(4); PG8_BAR;
        PG8_STAGE(PG8_SB(1, 0), cB + kstep, voffB); PG8_STAGE(PG8_SA(1, 0), cA + kstep, voffA); PG8_STAGE(PG8_SB(1, 1), cB + hstep + kstep, voffB);
        PG8_WAIT_V(6); PG8_BAR;
    }
    for (;;) {
        const bool has_next = S.next(ui + 1, nxt);
        const char* nA = has_next ? (const char*)g.A + (size_t)nxt.pm * tstep : cA; const char* nB = has_next ? (const char*)g.Bt + (size_t)nxt.pn * tstep : cB;
        for (int t = 0; t < nt; t += 2) {
            const bool last = (t == nt - 2);
            const char* a1 = cA + (size_t)(t + 1) * kstep;
            const char* a2 = last ? nA : cA + (size_t)(t + 2) * kstep; const char* b2 = last ? nB : cB + (size_t)(t + 2) * kstep;
            const char* a3 = a2 + kstep; const char* b3 = b2 + kstep;
            if (last && has_next) S.a_ready(nxt);
            if constexpr (SP2) {
            PG8_LDB(B0, 0, 0); PG8_LDB(B1, 0, 1); PG8_SCHED; PG8_LDA(At, 0, 0); PG8_STAGE(PG8_SA(1, 1), a1 + hstep, voffA);
            PG8_WAIT_V(8); PG8_WAIT_L(0); PG8_BAR; PG8_MMA(0, 0, At, B0); PG8_MMA(0, 1, At, B1); PG8_BAR; PG8_SCHED;
            PG8_LDA(At, 0, 1); PG8_STAGE(PG8_SB(0, 0), b2, voffB); PG8_STAGE(PG8_SB(0, 1), b2 + hstep, voffB); PG8_STAGE(PG8_SA(0, 0), a2, voffA);
            PG8_WAIT_V(8); PG8_WAIT_L(0); PG8_BAR; PG8_MMA(1, 0, At, B0); PG8_MMA(1, 1, At, B1); PG8_BAR; PG8_SCHED;
            PG8_LDB(B0, 1, 0); PG8_LDB(B1, 1, 1); PG8_SCHED; PG8_LDA(At, 1, 0); PG8_STAGE(PG8_SA(0, 1), a2 + hstep, voffA);
            PG8_WAIT_V(8); PG8_WAIT_L(0); PG8_BAR; PG8_MMA(0, 0, At, B0); PG8_MMA(0, 1, At, B1); PG8_BAR; PG8_SCHED;
            PG8_LDA(At, 1, 1); PG8_STAGE(PG8_SB(1, 0), b3, voffB); PG8_STAGE(PG8_SB(1, 1), b3 + hstep, voffB); PG8_STAGE(PG8_SA(1, 0), a3, voffA);
            PG8_WAIT_V(8); PG8_WAIT_L(0); PG8_BAR; PG8_MMA(1, 0, At, B0); PG8_MMA(1, 1, At, B1); PG8_BAR; PG8_SCHED;
            } else {
            PG8_LDB(B0, 0, 0); PG8_SCHED; PG8_LDA(At, 0, 0); PG8_STAGE(PG8_SA(1, 1), a1 + hstep, voffA);
            PG8_WAIT_L(8); PG8_BAR; PG8_WAIT_L(0); PG8_MMA(0, 0, At, B0); PG8_BAR; PG8_SCHED;
            PG8_LDB(B1, 0, 1); PG8_STAGE(PG8_SB(0, 0), b2, voffB);
            PG8_BAR; PG8_WAIT_L(0); PG8_MMA(0, 1, At, B1); PG8_BAR;
            PG8_LDA(At, 0, 1); PG8_STAGE(PG8_SA(0, 0), a2, voffA);
            PG8_BAR; PG8_WAIT_L(0); PG8_MMA(1, 0, At, B0); PG8_BAR; PG8_SCHED;
            PG8_STAGE(PG8_SB(0, 1), b2 + hstep, voffB);
            PG8_WAIT_V(6); PG8_BAR; PG8_MMA(1, 1, At, B1); PG8_BAR;
            PG8_LDB(B0, 1, 0); PG8_SCHED; PG8_LDA(At, 1, 0); PG8_STAGE(PG8_SA(0, 1), a2 + hstep, voffA);
            PG8_WAIT_L(8); PG8_BAR; PG8_WAIT_L(0); PG8_MMA(0, 0, At, B0); PG8_BAR; PG8_SCHED;
            PG8_LDB(B1, 1, 1); PG8_STAGE(PG8_SB(1, 0), b3, voffB);
            PG8_BAR; PG8_WAIT_L(0); PG8_MMA(0, 1, At, B1); PG8_BAR;
            PG8_LDA(At, 1, 1); PG8_STAGE(PG8_SA(1, 0), a3, voffA);
            PG8_BAR; PG8_WAIT_L(0); PG8_MMA(1, 0, At, B0); PG8_BAR; PG8_SCHED;
            PG8_STAGE(PG8_SB(1, 1), b3 + hstep, voffB);
            PG8_WAIT_V(6); PG8_BAR; PG8_MMA(1, 1, At, B1); PG8_BAR;
            }
        }
        if constexpr (ALIGN_EPI) { if (wr == 0) PG8_BAR; }
        if constexpr (!Epi::AFTER_DRAIN) { E(acc, cur, wr, wc, fr, fq); S.done(cur); }
        if (!has_next) break;
#pragma unroll
        for (int a = 0; a < 2; ++a)
#pragma unroll
            for (int b = 0; b < 2; ++b)
#pragma unroll
                for (int m = 0; m < 4; ++m)
#pragma unroll
                    for (int n = 0; n < 2; ++n) acc[a][b][m][n] = (f32x4){0.f, 0.f, 0.f, 0.f};
        cur = nxt; cA = nA; cB = nB; ++ui;
        if constexpr (ALIGN_EPI) { if (wr == 1) PG8_BAR; }
    }
    PG8_WAIT_V(0);
    if constexpr (!ALIGN_EPI) { if (wr == 0) PG8_BAR; }
    PG8_BAR;
    if constexpr (Epi::AFTER_DRAIN) { E.fused(acc, cur, wr, wc, fr, fq, lds, wid, lane); S.done(cur); }
#undef PG8_SA
#undef PG8_SB
#undef PG8_STAGE
#undef PG8_LDA
#undef PG8_LDB
#undef PG8_MMA
#undef PG8_WAIT_V
#undef PG8_WAIT_L
#undef PG8_BAR
#undef PG8_SCHED
}
}

#ifndef PG8_SP2
#define PG8_SP2 true
#endif
#ifndef PG8_ALIGN
#define PG8_ALIGN true
#endif
#include <hip/hip_bf16.h>
#include <cmath>
namespace attn_body {
using bf16=__hip_bfloat16;
using bf16x8=__attribute__((ext_vector_type(8)))short;
using s16x4=__attribute__((ext_vector_type(4)))short;
using f32x16=__attribute__((ext_vector_type(16)))float;
using u32x4=__attribute__((ext_vector_type(4)))unsigned;
using f32x4_t=__attribute__((ext_vector_type(4)))float;
constexpr int BATCH=32,NHEAD=16,SEQ=2048,D=64,DM=NHEAD*D;
constexpr int NW=8,QBLK=32,QB=QBLK*NW,KVBLK=64,NQB=SEQ/QB;
constexpr int ATTN_PITCH=DM, ATTN_UNIT_ROWS=QB;
__device__ __forceinline__ int crow(int r,int hi){return (r&3)+8*(r>>2)+4*hi;}
#define SBAR() __builtin_amdgcn_sched_barrier(0)
__device__ __forceinline__ void cmask(f32x16&p0,f32x16&p1,int jb,int qrel,int hi){
  const float NEG=-INFINITY; int kb=64*jb+4*hi;
  #pragma unroll
  for(int r=0;r<16;++r){int kv=kb+(r&3)+8*(r>>2); if(kv>qrel)p0[r]=NEG; if(kv+32>qrel)p1[r]=NEG;}
}

constexpr int NSLOT=3, SLOTB=8192;
constexpr int LDS_K=0, LDS_V=NSLOT*SLOTB, LDS_WS=2*NSLOT*SLOTB, LDS_OST=LDS_WS+NW*64*4, LDS_BIAS=LDS_OST+NW*4096, LDS_BYTES=LDS_BIAS+SEQ*4;
constexpr float C2=0.125f*1.4426950408889634f;
__device__ __forceinline__ void glds16(const void*gsrc,unsigned lds_dst){unsigned keep;
  asm volatile("s_mov_b32 %0, m0\n\ts_mov_b32 m0, %2\n\ts_nop 0\n\tglobal_load_lds_dwordx4 %1, off\n\ts_mov_b32 m0, %0":"=&s"(keep):"v"(gsrc),"s"(lds_dst):"memory");}
__device__ __forceinline__ float max3f(float a,float b,float c){float r;asm("v_max3_f32 %0, %1, %2, %3":"=v"(r):"v"(a),"v"(b),"v"(c));return r;}
__device__ __forceinline__ float max2f(float a,float b){float r;asm("v_max_f32_e32 %0, %1, %2":"=v"(r):"v"(a),"v"(b));return r;}
__device__ __forceinline__ float fadd_s(float a,float b){float r;asm("v_add_f32_e32 %0, %1, %2":"=v"(r):"v"(a),"v"(b));return r;}
__device__ __forceinline__ float fsub_s(float a,float b){float r;asm("v_sub_f32_e32 %0, %1, %2":"=v"(r):"v"(a),"v"(b));return r;}
typedef float f32x2_t __attribute__((ext_vector_type(2))); typedef __bf16 bf16x2_t __attribute__((ext_vector_type(2)));
__device__ __forceinline__ unsigned cvtpk_s(float lo,float hi){f32x2_t v={lo,hi};bf16x2_t b=__builtin_convertvector(v,bf16x2_t);return __builtin_bit_cast(unsigned,b);}
#define WAIT_BAR(N) asm volatile("s_waitcnt vmcnt(" #N ") lgkmcnt(0)\n\ts_barrier":::"memory")

__device__ __forceinline__ void qkt(f32x16&p0,f32x16&p1,const char*Kslot,const bf16x8*qr,const f32x16&negm0,const f32x16&negm1,int r32,int hi){
  const char*kb=Kslot+hi*1024+r32*16;
  #pragma unroll
  for(int d0=0;d0<4;++d0){
    const bf16x8 b0=*reinterpret_cast<const bf16x8*>(kb+d0*2048);
    const bf16x8 b1=*reinterpret_cast<const bf16x8*>(kb+d0*2048+512);
    if(d0==0){p0=__builtin_amdgcn_mfma_f32_32x32x16_bf16(b0,qr[0],negm0,0,0,0);p1=__builtin_amdgcn_mfma_f32_32x32x16_bf16(b1,qr[0],negm1,0,0,0);}
    else{p0=__builtin_amdgcn_mfma_f32_32x32x16_bf16(b0,qr[d0],p0,0,0,0);p1=__builtin_amdgcn_mfma_f32_32x32x16_bf16(b1,qr[d0],p1,0,0,0);}}
}
typedef __attribute__((address_space(3))) const char* lds_cptr;
typedef short v4i16_t __attribute__((ext_vector_type(4)));
__device__ __forceinline__ void kload8(bf16x8*kf,lds_cptr kp){
  kf[0]=*(const __attribute__((address_space(3))) bf16x8*)(kp);      kf[1]=*(const __attribute__((address_space(3))) bf16x8*)(kp+512);
  kf[2]=*(const __attribute__((address_space(3))) bf16x8*)(kp+2048); kf[3]=*(const __attribute__((address_space(3))) bf16x8*)(kp+2560);
  kf[4]=*(const __attribute__((address_space(3))) bf16x8*)(kp+4096); kf[5]=*(const __attribute__((address_space(3))) bf16x8*)(kp+4608);
  kf[6]=*(const __attribute__((address_space(3))) bf16x8*)(kp+6144); kf[7]=*(const __attribute__((address_space(3))) bf16x8*)(kp+6656);
}
__device__ __forceinline__ void kload2(bf16x8*kf,lds_cptr kp,int j){ kf[2*j]=*(const __attribute__((address_space(3))) bf16x8*)(kp+j*2048); kf[2*j+1]=*(const __attribute__((address_space(3))) bf16x8*)(kp+j*2048+512); }
__device__ __forceinline__ s16x4 vtr(lds_cptr p){ return __builtin_bit_cast(s16x4,__builtin_amdgcn_ds_read_tr16_b64_v4i16((__attribute__((address_space(3))) v4i16_t*)p)); }
__device__ __forceinline__ float rowmax(const f32x16&p0,const f32x16&p1){
  float a=max3f(p0[0],p0[1],p1[0]),b=max3f(p0[2],p0[3],p1[1]);a=max3f(a,p1[2],p1[3]);
  #pragma unroll
  for(int r=4;r<16;r+=4){a=max3f(a,p0[r],p0[r+1]);b=max3f(b,p0[r+2],p0[r+3]);a=max3f(a,p1[r],p1[r+1]);b=max3f(b,p1[r+2],p1[r+3]);}
  const float m=max2f(a,b);
  auto rr=__builtin_amdgcn_permlane32_swap(__float_as_uint(m),__float_as_uint(m),false,false);
  return max2f(__uint_as_float(rr[0]),__uint_as_float(rr[1]));
}
__device__ __forceinline__ void pv(f32x16*o,int vb,bf16x8 pa0,bf16x8 pa1,bf16x8 pa2,bf16x8 pa3){
  #pragma unroll
  for(int d0=0;d0<2;++d0){s16x4 lo[4],hi[4];
    #pragma unroll
    for(int ks=0;ks<4;++ks){
      asm volatile("ds_read_b64_tr_b16 %0,%1 offset:%c2":"=&v"(lo[ks]):"v"(vb),"i"(d0*4096+ks*1024):"memory");
      asm volatile("ds_read_b64_tr_b16 %0,%1 offset:%c2":"=&v"(hi[ks]):"v"(vb),"i"(d0*4096+ks*1024+512):"memory");}
    asm volatile("s_waitcnt lgkmcnt(0)":::"memory");SBAR();
    #define PK(k) (bf16x8){lo[k][0],lo[k][1],lo[k][2],lo[k][3],hi[k][0],hi[k][1],hi[k][2],hi[k][3]}
    o[d0]=__builtin_amdgcn_mfma_f32_32x32x16_bf16(pa0,PK(0),o[d0],0,0,0);
    o[d0]=__builtin_amdgcn_mfma_f32_32x32x16_bf16(pa1,PK(1),o[d0],0,0,0);
    o[d0]=__builtin_amdgcn_mfma_f32_32x32x16_bf16(pa2,PK(2),o[d0],0,0,0);
    o[d0]=__builtin_amdgcn_mfma_f32_32x32x16_bf16(pa3,PK(3),o[d0],0,0,0);
    #undef PK
  }
}

#ifndef ATTN_STORE16
#define ATTN_STORE16(p,v) (*(u32x4*)(p)=(v))
#endif
template<int THRL,bool BIAS> __device__ __forceinline__ void attn_unit(int b,int qb,const bf16*Q,const bf16*__restrict__ K,const bf16*__restrict__ V,bf16*O,const float*__restrict__ cum,const bf16*__restrict__ Zg,char*shm){
  int tid_=threadIdx.x; asm volatile("":"+v"(tid_)); const int tid=tid_,lane=tid&63,r32=lane&31,hi=lane>>5; const int wid=__builtin_amdgcn_readfirstlane(tid>>6);
  const long rowbase=(long)b*SEQ; const int q0=qb*QB;
  const bf16*Qw=Q+(rowbase+q0+wid*QBLK)*DM;
  const bf16*Kh=K+rowbase*DM,*Vh=V+rowbase*DM;
  const unsigned lds0=(unsigned)(uintptr_t)shm;
  float*wsf=(float*)(shm+LDS_WS)+wid*64;
  const bf16*ksrc=Kh+(long)lane*DM+wid*8;
  const bf16*vsrc=Vh+(long)(16*(wid&3)+(lane>>2))*DM+(wid>>2)*32+(lane&3)*8;
  const unsigned kdst=lds0+LDS_K+wid*1024, vdst=lds0+LDS_V+wid*1024;
  #define DMA_K(t,slot) glds16(ksrc+(long)(t)*KVBLK*DM,(unsigned)__builtin_amdgcn_readfirstlane(kdst+(slot)))
  #define DMA_V(t,slot) glds16(vsrc+(long)(t)*KVBLK*DM,(unsigned)__builtin_amdgcn_readfirstlane(vdst+(slot)))
  const int vb0=(int)(lds0+LDS_V)+((lane>>4)&1)*32+(lane&3)*8+(4*hi+((lane&15)>>2))*64;
  const char*Kbase=shm+LDS_K; bf16x8 kf[8];
  const lds_cptr shm3=(lds_cptr)shm; const lds_cptr kp0=shm3+LDS_K+hi*1024+r32*16; const lds_cptr vp0=shm3+LDS_V+((lane>>4)&1)*32+(lane&3)*8+(4*hi+((lane&15)>>2))*64;
  const int NT=(q0+QB)/KVBLK;
  const __attribute__((address_space(3))) float* biasl=(const __attribute__((address_space(3))) float*)((lds_cptr)shm+LDS_BIAS);
  float bv_[4]={0.f,0.f,0.f,0.f}; float cref=0.f;
  if(BIAS){ const int nb=q0+QB; cref=cum[q0];
    _Pragma("unroll") for(int j=0;j<4;++j){const int idx=tid+512*j; bv_[j]=(idx<nb)?cum[idx]:0.f;}
    if(tid<QB){ (void)*(volatile const unsigned*)(Zg+(rowbase+q0+tid)*DM); } }
  DMA_K(0,0);DMA_V(0,0);DMA_K(1,SLOTB);
  bf16x8 qr[4];
  #pragma unroll
  for(int d0=0;d0<4;++d0)qr[d0]=*reinterpret_cast<const bf16x8*>(&Qw[(long)r32*DM+d0*16+hi*8]);
  float mhat=0.f,l_reg=0.f;f32x16 o[2];o[0]=f32x16{};o[1]=f32x16{};f32x16 negm=f32x16{};if(!BIAS){asm volatile("":"+v"(negm));}
  const int qrel=wid*QBLK+r32;
  #define CMASK(P0,P1,t) do{int jb_=(t)-(NT-4); if(jb_>=0)cmask(P0,P1,jb_,qrel,hi);}while(0)
  bool resc=false;
  #define START(P0,P1) do{ const float rm=rowmax(P0,P1); resc=false; \
    { const float dl=rm; mhat=fadd_s(mhat,dl); \
      _Pragma("unroll") for(int r=0;r<16;++r){P0[r]=fsub_s(P0[r],dl);P1[r]=fsub_s(P1[r],dl);} \
      if(!BIAS){ _Pragma("unroll") for(int r=0;r<16;++r)negm[r]=-mhat; asm volatile("":"+v"(negm)); } } \
    _Pragma("unroll") for(int r=0;r<16;++r)P0[r]=__builtin_amdgcn_exp2f(P0[r]); }while(0)
  #define RESC() do{ if(resc){ asm volatile("s_waitcnt lgkmcnt(0)":::"memory"); \
      _Pragma("unroll") for(int d_=0;d_<2;++d_) _Pragma("unroll") for(int r=0;r<16;++r)o[d_][r]*=wsf[crow(r,hi)]; } }while(0)
  if(wid>=4)__builtin_amdgcn_s_setprio(1);
  f32x16 pA0,pA1,pB0,pB1;
  int sl_prev=0,sl_cur=0,sl_next=SLOTB;
  #define ROT() do{sl_prev=sl_cur;sl_cur=sl_next;sl_next=(sl_next==(NSLOT-1)*SLOTB)?0:sl_next+SLOTB;}while(0)
  DMA_K(2,2*SLOTB);
  if(BIAS){ const int nb=q0+QB;
    _Pragma("unroll") for(int j=0;j<4;++j){const int idx=tid+512*j; if(idx<nb)((__attribute__((address_space(3))) float*)((__attribute__((address_space(3))) char*)shm+LDS_BIAS))[idx]=(cref-bv_[j])*1.4426950408889634f;} }
  WAIT_BAR(3);
  f32x16 bi0=f32x16{},bi1=f32x16{};
  if(BIAS){ _Pragma("unroll") for(int g_=0;g_<4;++g_){ const f32x4_t a_=*(const __attribute__((address_space(3))) f32x4_t*)(biasl+8*g_+4*hi); const f32x4_t b_=*(const __attribute__((address_space(3))) f32x4_t*)(biasl+32+8*g_+4*hi);
      _Pragma("unroll") for(int i_=0;i_<4;++i_){bi0[4*g_+i_]=a_[i_];bi1[4*g_+i_]=b_[i_];} } }
  qkt(pA0,pA1,Kbase,qr,bi0,bi1,r32,hi);asm volatile("s_nop 15\n\ts_nop 7":"+v"(pA0),"+v"(pA1));CMASK(pA0,pA1,0);
  START(pA0,pA1);
  _Pragma("unroll") for(int r=0;r<16;++r)pA1[r]=__builtin_amdgcn_exp2f(pA1[r]);
  if(BIAS){ const __attribute__((address_space(3))) float* bt_=biasl+64+4*hi;
    _Pragma("unroll") for(int g_=0;g_<4;++g_){ const f32x4_t a_=*(const __attribute__((address_space(3))) f32x4_t*)(bt_+8*g_); const f32x4_t b_=*(const __attribute__((address_space(3))) f32x4_t*)(bt_+32+8*g_);
      _Pragma("unroll") for(int i_=0;i_<4;++i_){pB0[4*g_+i_]=a_[i_]-mhat;pB1[4*g_+i_]=b_[i_]-mhat;} } }
  WAIT_BAR(0);
  DMA_K(3,0);DMA_V(1,SLOTB);
  ROT();
  kload8(kf,kp0+sl_cur);
  WAIT_BAR(2);
  s16x4 vlo[8],vhi[8]; u32x4 pw0,pw1,pw2,pw3;
  #define PKW(P,B) cvtpk_s(P[B],P[B+1])
  #define PAF(k) __builtin_bit_cast(bf16x8,pw##k)
  #define VFR(i) (bf16x8){vlo[i][0],vlo[i][1],vlo[i][2],vlo[i][3],vhi[i][0],vhi[i][1],vhi[i][2],vhi[i][3]}
  #define PIN(x) asm volatile("":"+v"(x))
  #define MX3(a,b,c) __builtin_fmaxf(__builtin_fmaxf((a),(b)),(c))
  #define GAPA(MF,A0,A1,A2,A3,W0,W1,PW) do{ MF; sacc+=A0; sacc+=A1; sacc+=A2; sacc+=A3; PIN(sacc); W0; W1; PIN(PW); SBAR(); }while(0)
  #define EX(v) __builtin_amdgcn_exp2f(v)
  #define GAPB(MF,X,B) do{ MF; X[B]=EX(X[B]); X[B+1]=EX(X[B+1]); X[B+2]=EX(X[B+2]); X[B+3]=EX(X[B+3]); PIN(X); SBAR(); }while(0)
  #define BGAP(X,B,NXT) do{ if(BIAS){ bw_=*(const __attribute__((address_space(3))) f32x4_t*)(bn_+(NXT)); X[B]=bq_[0]-mhat; X[(B)+1]=bq_[1]-mhat; X[(B)+2]=bq_[2]-mhat; X[(B)+3]=bq_[3]-mhat; bq_=bw_; } }while(0)
  #define VRD(i) do{ vlo[i]=vtr(vp_+(((i)>>2)*4096+((i)&3)*1024)); vhi[i]=vtr(vp_+(((i)>>2)*4096+((i)&3)*1024+512)); }while(0)
  #define KRD(G,j) do{ if(G){ kload2(kf,kp0+sl_next,j); SBAR(); } }while(0)
  #define STEP(C0,C1,P0,P1,t,GK,GV,GL) do{ SBAR(); \
    const lds_cptr vp_=vp0+sl_prev; \
    VRD(0); SBAR(); float sacc=(P0[0]+P0[1]); \
    GAPA(C0=__builtin_amdgcn_mfma_f32_32x32x16_bf16(kf[0],qr[0],(BIAS?C0:negm),0,0,0), P0[2],P0[3],P0[4],P0[5],     pw0[0]=PKW(P0,0), pw0[1]=PKW(P0,2), pw0); \
    VRD(4); SBAR(); GAPA(C1=__builtin_amdgcn_mfma_f32_32x32x16_bf16(kf[1],qr[0],(BIAS?C1:negm),0,0,0), P0[6],P0[7],P0[8],P0[9],     pw0[2]=PKW(P0,4), pw0[3]=PKW(P0,6), pw0); \
    VRD(1); SBAR(); GAPA(C0=__builtin_amdgcn_mfma_f32_32x32x16_bf16(kf[2],qr[1],C0,0,0,0),   P0[10],P0[11],P0[12],P0[13], pw1[0]=PKW(P0,8), pw1[1]=PKW(P0,10), pw1); \
    VRD(5); SBAR(); GAPA(C1=__builtin_amdgcn_mfma_f32_32x32x16_bf16(kf[3],qr[1],C1,0,0,0),   P0[14],P0[15],P1[0],P1[1],   pw1[2]=PKW(P0,12),pw1[3]=PKW(P0,14), pw1); \
    VRD(2); SBAR(); GAPA(C0=__builtin_amdgcn_mfma_f32_32x32x16_bf16(kf[4],qr[2],C0,0,0,0),   P1[2],P1[3],P1[4],P1[5],     pw2[0]=PKW(P1,0), pw2[1]=PKW(P1,2), pw2); \
    VRD(6); SBAR(); GAPA(C1=__builtin_amdgcn_mfma_f32_32x32x16_bf16(kf[5],qr[2],C1,0,0,0),   P1[6],P1[7],P1[8],P1[9],     pw2[2]=PKW(P1,4), pw2[3]=PKW(P1,6), pw2); \
    VRD(3); SBAR(); GAPA(C0=__builtin_amdgcn_mfma_f32_32x32x16_bf16(kf[6],qr[3],C0,0,0,0),   P1[10],P1[11],P1[12],P1[13], pw3[0]=PKW(P1,8), pw3[1]=PKW(P1,10), pw3); \
    VRD(7); SBAR(); GAPA(C1=__builtin_amdgcn_mfma_f32_32x32x16_bf16(kf[7],qr[3],C1,0,0,0),   P1[14],P1[15],0.f,0.f,       pw3[2]=PKW(P1,12),pw3[3]=PKW(P1,14), pw3); \
    l_reg+=sacc; \
    if(GK){DMA_K((t)+3,sl_cur);} if(GV){DMA_V((t)+1,sl_next);} \
    CMASK(C0,C1,t); \
    { float a=MX3(C0[0],C0[1],C1[0]),b=MX3(C0[2],C0[3],C1[1]); a=MX3(a,C1[2],C1[3]); \
      _Pragma("unroll") for(int r=4;r<16;r+=4){a=MX3(a,C0[r],C0[r+1]);b=MX3(b,C0[r+2],C0[r+3]);a=MX3(a,C1[r],C1[r+1]);b=MX3(b,C1[r+2],C1[r+3]);} \
      float rm=__builtin_fmaxf(a,b); { auto rr=__builtin_amdgcn_permlane32_swap(__float_as_uint(rm),__float_as_uint(rm),false,false); rm=__builtin_fmaxf(__uint_as_float(rr[0]),__uint_as_float(rr[1])); } \
      resc=false; \
      if(__builtin_expect(__any(rm>(float)THRL),0)){ const float dl=__builtin_fmaxf(rm,0.f); mhat+=dl; \
        _Pragma("unroll") for(int r=0;r<16;++r){C0[r]-=dl;C1[r]-=dl;} \
        if(!BIAS){ _Pragma("unroll") for(int r=0;r<16;++r)negm[r]=-mhat; asm volatile("":"+v"(negm)); } \
        const float f=__builtin_amdgcn_exp2f(-dl); l_reg*=f; if(hi==0)wsf[r32]=f; resc=true; } } \
    SBAR(); \
    const __attribute__((address_space(3))) float* bn_=biasl+64*((t)+1)+4*hi; f32x4_t bq_=f32x4_t{},bw_=f32x4_t{}; \
    if(BIAS){ bq_=*(const __attribute__((address_space(3))) f32x4_t*)(bn_); SBAR(); } \
    BGAP(P0,0,8);  GAPB(o[0]=__builtin_amdgcn_mfma_f32_32x32x16_bf16(PAF(0),VFR(0),o[0],0,0,0), C0,0); \
    BGAP(P0,4,16); GAPB(o[1]=__builtin_amdgcn_mfma_f32_32x32x16_bf16(PAF(0),VFR(4),o[1],0,0,0), C0,4); \
    BGAP(P0,8,24); KRD(GL,0); GAPB(o[0]=__builtin_amdgcn_mfma_f32_32x32x16_bf16(PAF(1),VFR(1),o[0],0,0,0), C0,8); \
    BGAP(P0,12,32); KRD(GL,1); GAPB(o[1]=__builtin_amdgcn_mfma_f32_32x32x16_bf16(PAF(1),VFR(5),o[1],0,0,0), C0,12); \
    BGAP(P1,0,40); KRD(GL,2); GAPB(o[0]=__builtin_amdgcn_mfma_f32_32x32x16_bf16(PAF(2),VFR(2),o[0],0,0,0), C1,0); \
    BGAP(P1,4,48); KRD(GL,3); GAPB(o[1]=__builtin_amdgcn_mfma_f32_32x32x16_bf16(PAF(2),VFR(6),o[1],0,0,0), C1,4); \
    BGAP(P1,8,56); GAPB(o[0]=__builtin_amdgcn_mfma_f32_32x32x16_bf16(PAF(3),VFR(3),o[0],0,0,0), C1,8); \
    BGAP(P1,12,56); GAPB(o[1]=__builtin_amdgcn_mfma_f32_32x32x16_bf16(PAF(3),VFR(7),o[1],0,0,0), C1,12); \
    }while(0)
  int t=1;
  #undef CMASK
  #define CMASK(P0,P1,t) do{}while(0)
  for(;t+5<NT;t+=2){
    STEP(pB0,pB1,pA0,pA1,t,true,true,true);     WAIT_BAR(2); RESC(); ROT();
    STEP(pA0,pA1,pB0,pB1,t+1,true,true,true);   WAIT_BAR(2); RESC(); ROT();
  }
  #undef CMASK
  #define CMASK(P0,P1,t) do{int jb_=(t)-(NT-4); if(jb_>=0)cmask(P0,P1,jb_,qrel,hi);}while(0)
  #define ENDW(tt) do{ if((tt)+3<NT){WAIT_BAR(2);} else if((tt)+2<NT){WAIT_BAR(1);} else {WAIT_BAR(0);} }while(0)
  for(;t+1<NT;t+=2){
    STEP(pB0,pB1,pA0,pA1,t,(t+3<NT),(t+1<NT),(t+1<NT));       ENDW(t);   RESC(); ROT();
    STEP(pA0,pA1,pB0,pB1,t+1,(t+4<NT),(t+2<NT),(t+2<NT));     ENDW(t+1); RESC(); ROT();
  }
  STEP(pB0,pB1,pA0,pA1,NT-1,false,false,false); RESC();
  { float sacc=pB0[0]+pB0[1]; _Pragma("unroll") for(int r=2;r<16;++r)sacc+=pB0[r]; _Pragma("unroll") for(int r=0;r<16;++r)sacc+=pB1[r]; l_reg+=sacc;
    pw0=(u32x4){PKW(pB0,0),PKW(pB0,2),PKW(pB0,4),PKW(pB0,6)};pw1=(u32x4){PKW(pB0,8),PKW(pB0,10),PKW(pB0,12),PKW(pB0,14)};pw2=(u32x4){PKW(pB1,0),PKW(pB1,2),PKW(pB1,4),PKW(pB1,6)};pw3=(u32x4){PKW(pB1,8),PKW(pB1,10),PKW(pB1,12),PKW(pB1,14)};
    SBAR(); pv(o,vb0+sl_cur,PAF(0),PAF(1),PAF(2),PAF(3)); }
  #undef PKW
  #undef PAF
  #undef VFR
  #undef PIN
  #undef MX3
  #undef GAPA
  #undef GAPB
  #undef EX
  #undef VRD
  #undef BGAP
  #undef KRD
  #undef STEP
  #undef ENDW
  __builtin_amdgcn_s_setprio(0);
  u32x4 zg_[4]; if(BIAS){ const bf16*Zw=Zg+(rowbase+q0+wid*QBLK)*DM;
    #pragma unroll
    for(int i=0;i<4;++i)zg_[i]=*(const u32x4*)(Zw+(long)(i*8+(lane>>3))*DM+(lane&7)*8); }
  {auto rr=__builtin_amdgcn_permlane32_swap(__float_as_uint(l_reg),__float_as_uint(l_reg),false,false);l_reg=__uint_as_float(rr[0])+__uint_as_float(rr[1]);}
  if(hi==0)wsf[32+r32]=l_reg;asm volatile("s_waitcnt lgkmcnt(0)":::"memory");
  float rli[16];
  #pragma unroll
  for(int r=0;r<16;++r)rli[r]=__builtin_amdgcn_rcpf(wsf[32+crow(r,hi)]);
  bf16*Ow=O+(rowbase+q0+wid*QBLK)*DM;
  { bf16*stg=(bf16*)(shm+LDS_OST)+wid*2048;
    #pragma unroll
    for(int r=0;r<16;++r){const int orow=crow(r,hi);
      #pragma unroll
      for(int d0=0;d0<2;++d0)stg[orow*64+d0*32+r32]=__float2bfloat16(o[d0][r]*rli[r]);}
    asm volatile("s_waitcnt lgkmcnt(0)":::"memory");
    #pragma unroll
    for(int i=0;i<4;++i){const int row=i*8+(lane>>3),ch=lane&7; u32x4 v=*(const u32x4*)(stg+row*64+ch*8);
      if(BIAS){ const u32x4 z=zg_[i];
        #pragma unroll
        for(int k=0;k<4;++k){ const float o0=__uint_as_float(v[k]<<16),o1=__uint_as_float(v[k]&0xffff0000u),z0=__uint_as_float(z[k]<<16),z1=__uint_as_float(z[k]&0xffff0000u);
          v[k]=cvtpk_s(o0*z0*__builtin_amdgcn_rcpf(1.f+__expf(-z0)),o1*z1*__builtin_amdgcn_rcpf(1.f+__expf(-z1))); } }
      ATTN_STORE16(Ow+(long)row*DM+ch*8,v);} }
  asm volatile("s_waitcnt lgkmcnt(0)\n\ts_barrier":::"memory");
  #undef DMA_K
  #undef DMA_V
  #undef CMASK
  #undef START
  #undef RESC
  #undef ROT
}
constexpr int LDS_V2=NSLOT*SLOTB, LDS_WS2=LDS_V2+NSLOT*2*SLOTB, LDS_OST2=LDS_WS2+NW*64*4, LDS_BYTES2=LDS_OST2+NW*8192;
template<int THRL> __device__ __forceinline__ void attn_unit128(int b,int qb,const bf16*Q,const bf16*__restrict__ K,const bf16*__restrict__ V,bf16*O,char*shm){ constexpr bool BIAS=false; const float*cum=nullptr; const bf16*Zg=nullptr; (void)cum; (void)Zg;
  int tid_=threadIdx.x; asm volatile("":"+v"(tid_)); const int tid=tid_,lane=tid&63,r32=lane&31,hi=lane>>5; const int wid=__builtin_amdgcn_readfirstlane(tid>>6);
  const long rowbase=(long)b*SEQ; const int q0=qb*QB;
  const bf16*Qw=Q+(rowbase+q0+wid*QBLK)*DM;
  const bf16*Kh=K+rowbase*DM,*Vh=V+rowbase*DM;
  const unsigned lds0=(unsigned)(uintptr_t)shm;
  float*wsf=(float*)(shm+LDS_WS2)+wid*64;
  const bf16*ksrc=Kh+(long)lane*DM+wid*8;
  const bf16*vsrc=Vh+(long)(16*(wid&3)+(lane>>2))*DM+(wid>>2)*32+(lane&3)*8;
  const unsigned kdst=lds0+LDS_K+wid*1024, vdst=lds0+LDS_V2+wid*1024;
  #define DMA_K(t,slot) glds16(ksrc+(long)(t)*KVBLK*DM,(unsigned)__builtin_amdgcn_readfirstlane(kdst+(slot)))
  #define DMA_V(t,slot) do{ glds16(vsrc+(long)(t)*KVBLK*DM,(unsigned)__builtin_amdgcn_readfirstlane(vdst+2*(slot))); glds16(vsrc+64+(long)(t)*KVBLK*DM,(unsigned)__builtin_amdgcn_readfirstlane(vdst+8192+2*(slot))); }while(0)
  const int vb0=(int)(lds0+LDS_V2)+((lane>>4)&1)*32+(lane&3)*8+(4*hi+((lane&15)>>2))*64;
  const char*Kbase=shm+LDS_K; bf16x8 kf[8];
  const lds_cptr shm3=(lds_cptr)shm; const lds_cptr kp0=shm3+LDS_K+hi*1024+r32*16; const lds_cptr vp0=shm3+LDS_V2+((lane>>4)&1)*32+(lane&3)*8+(4*hi+((lane&15)>>2))*64;
  const int NT=(q0+QB)/KVBLK;
  const __attribute__((address_space(3))) float* biasl=(const __attribute__((address_space(3))) float*)((lds_cptr)shm+LDS_BIAS);
  float bv_[4]={0.f,0.f,0.f,0.f}; float cref=0.f;
  if(BIAS){ const int nb=q0+QB; cref=cum[q0];
    _Pragma("unroll") for(int j=0;j<4;++j){const int idx=tid+512*j; bv_[j]=(idx<nb)?cum[idx]:0.f;}
    if(tid<QB){ (void)*(volatile const unsigned*)(Zg+(rowbase+q0+tid)*DM); } }
  DMA_K(0,0);DMA_V(0,0);DMA_K(1,SLOTB);
  bf16x8 qr[4];
  #pragma unroll
  for(int d0=0;d0<4;++d0)qr[d0]=*reinterpret_cast<const bf16x8*>(&Qw[(long)r32*DM+d0*16+hi*8]);
  float mhat=0.f,l_reg=0.f;f32x16 o[4];o[0]=f32x16{};o[1]=f32x16{};o[2]=f32x16{};o[3]=f32x16{};const f32x16 zc=f32x16{};
  const int qrel=wid*QBLK+r32;
  #define CMASK(P0,P1,t) do{int jb_=(t)-(NT-4); if(jb_>=0)cmask(P0,P1,jb_,qrel,hi);}while(0)
  bool resc=false;
  #define START(P0,P1) do{ const float rm=rowmax(P0,P1); resc=false; \
    { const float dl=rm; mhat=fadd_s(mhat,dl); \
      _Pragma("unroll") for(int r=0;r<16;++r){P0[r]=fsub_s(P0[r],dl);P1[r]=fsub_s(P1[r],dl);} \
      } \
    _Pragma("unroll") for(int r=0;r<16;++r)P0[r]=__builtin_amdgcn_exp2f(P0[r]); }while(0)
  #define RESC() do{ if(resc){ asm volatile("s_waitcnt lgkmcnt(0)":::"memory"); \
      _Pragma("unroll") for(int d_=0;d_<4;++d_) _Pragma("unroll") for(int r=0;r<16;++r)o[d_][r]*=wsf[crow(r,hi)]; } }while(0)
  if(wid>=4)__builtin_amdgcn_s_setprio(1);
  f32x16 pA0,pA1,pB0,pB1;
  int sl_prev=0,sl_cur=0,sl_next=SLOTB;
  #define ROT() do{sl_prev=sl_cur;sl_cur=sl_next;sl_next=(sl_next==(NSLOT-1)*SLOTB)?0:sl_next+SLOTB;}while(0)
  DMA_K(2,2*SLOTB);
  if(BIAS){ const int nb=q0+QB;
    _Pragma("unroll") for(int j=0;j<4;++j){const int idx=tid+512*j; if(idx<nb)((__attribute__((address_space(3))) float*)((__attribute__((address_space(3))) char*)shm+LDS_BIAS))[idx]=(cref-bv_[j])*1.4426950408889634f;} }
  WAIT_BAR(4);
  f32x16 bi0=f32x16{},bi1=f32x16{};
  if(BIAS){ _Pragma("unroll") for(int g_=0;g_<4;++g_){ const f32x4_t a_=*(const __attribute__((address_space(3))) f32x4_t*)(biasl+8*g_+4*hi); const f32x4_t b_=*(const __attribute__((address_space(3))) f32x4_t*)(biasl+32+8*g_+4*hi);
      _Pragma("unroll") for(int i_=0;i_<4;++i_){bi0[4*g_+i_]=a_[i_];bi1[4*g_+i_]=b_[i_];} } }
  qkt(pA0,pA1,Kbase,qr,bi0,bi1,r32,hi);asm volatile("s_nop 15\n\ts_nop 7":"+v"(pA0),"+v"(pA1));CMASK(pA0,pA1,0);
  START(pA0,pA1);
  _Pragma("unroll") for(int r=0;r<16;++r)pA1[r]=__builtin_amdgcn_exp2f(pA1[r]);
  if(BIAS){ const __attribute__((address_space(3))) float* bt_=biasl+64+4*hi;
    _Pragma("unroll") for(int g_=0;g_<4;++g_){ const f32x4_t a_=*(const __attribute__((address_space(3))) f32x4_t*)(bt_+8*g_); const f32x4_t b_=*(const __attribute__((address_space(3))) f32x4_t*)(bt_+32+8*g_);
      _Pragma("unroll") for(int i_=0;i_<4;++i_){pB0[4*g_+i_]=a_[i_]-mhat;pB1[4*g_+i_]=b_[i_]-mhat;} } }
  WAIT_BAR(0);
  DMA_K(3,0);DMA_V(1,SLOTB);
  ROT();
  kload8(kf,kp0+sl_cur);
  WAIT_BAR(3);
  s16x4 vlo[4],vhi[4]; u32x4 pw0,pw1,pw2,pw3;
  #define PKW(P,B) cvtpk_s(P[B],P[B+1])
  #define PAF(k) __builtin_bit_cast(bf16x8,pw##k)
  #define VFR(i) (bf16x8){vlo[i][0],vlo[i][1],vlo[i][2],vlo[i][3],vhi[i][0],vhi[i][1],vhi[i][2],vhi[i][3]}
  #define PIN(x) asm volatile("":"+v"(x))
  #define MX3(a,b,c) __builtin_fmaxf(__builtin_fmaxf((a),(b)),(c))
  #define GAPA(MF,A0,A1,A2,A3,W0,W1,PW) do{ MF; sacc+=A0; sacc+=A1; sacc+=A2; sacc+=A3; PIN(sacc); W0; W1; PIN(PW); SBAR(); }while(0)
  #define EX(v) __builtin_amdgcn_exp2f(v)
  #define GAPB(MF,X,B) do{ MF; X[B]=EX(X[B]); X[B+1]=EX(X[B+1]); X[B+2]=EX(X[B+2]); X[B+3]=EX(X[B+3]); PIN(X); SBAR(); }while(0)
  #define BGAP(X,B,NXT) do{ if(BIAS){ bw_=*(const __attribute__((address_space(3))) f32x4_t*)(bn_+(NXT)); X[B]=bq_[0]-mhat; X[(B)+1]=bq_[1]-mhat; X[(B)+2]=bq_[2]-mhat; X[(B)+3]=bq_[3]-mhat; bq_=bw_; } }while(0)
  #define GAPB2(MF,X,B) do{ MF; X[B]=EX(X[B]); X[(B)+1]=EX(X[(B)+1]); PIN(X); SBAR(); }while(0)
  #define VLD(sl_,i) do{ vlo[sl_]=vtr(vp_+(((i)>>2)*4096+((i)&3)*1024)); vhi[sl_]=vtr(vp_+(((i)>>2)*4096+((i)&3)*1024+512)); }while(0)
  #define VFRS(i) (bf16x8){vlo[i][0],vlo[i][1],vlo[i][2],vlo[i][3],vhi[i][0],vhi[i][1],vhi[i][2],vhi[i][3]}
  #define VRD2(i) do{ vlo[i]=vtr(vp_+(8192+((i)>>2)*4096+((i)&3)*1024)); vhi[i]=vtr(vp_+(8192+((i)>>2)*4096+((i)&3)*1024+512)); }while(0)
  #define VRD(i) do{ vlo[i]=vtr(vp_+(((i)>>2)*4096+((i)&3)*1024)); vhi[i]=vtr(vp_+(((i)>>2)*4096+((i)&3)*1024+512)); }while(0)
  #define KRD(G,j) do{ if(G){ kload2(kf,kp0+sl_next,j); SBAR(); } }while(0)
  #define STEP(C0,C1,P0,P1,t,GK,GV,GL) do{ SBAR(); \
    const lds_cptr vp_=vp0+2*sl_prev; \
    float sacc=(P0[0]+P0[1]); \
    GAPA(C0=__builtin_amdgcn_mfma_f32_32x32x16_bf16(kf[0],qr[0],zc,0,0,0), P0[2],P0[3],P0[4],P0[5],     pw0[0]=PKW(P0,0), pw0[1]=PKW(P0,2), pw0); \
    GAPA(C1=__builtin_amdgcn_mfma_f32_32x32x16_bf16(kf[1],qr[0],zc,0,0,0), P0[6],P0[7],P0[8],P0[9],     pw0[2]=PKW(P0,4), pw0[3]=PKW(P0,6), pw0); \
    GAPA(C0=__builtin_amdgcn_mfma_f32_32x32x16_bf16(kf[2],qr[1],C0,0,0,0),   P0[10],P0[11],P0[12],P0[13], pw1[0]=PKW(P0,8), pw1[1]=PKW(P0,10), pw1); \
    GAPA(C1=__builtin_amdgcn_mfma_f32_32x32x16_bf16(kf[3],qr[1],C1,0,0,0),   P0[14],P0[15],P1[0],P1[1],   pw1[2]=PKW(P0,12),pw1[3]=PKW(P0,14), pw1); \
    VLD(0,0); SBAR(); GAPA(C0=__builtin_amdgcn_mfma_f32_32x32x16_bf16(kf[4],qr[2],C0,0,0,0),   P1[2],P1[3],P1[4],P1[5],     pw2[0]=PKW(P1,0), pw2[1]=PKW(P1,2), pw2); \
    VLD(1,4); SBAR(); GAPA(C1=__builtin_amdgcn_mfma_f32_32x32x16_bf16(kf[5],qr[2],C1,0,0,0),   P1[6],P1[7],P1[8],P1[9],     pw2[2]=PKW(P1,4), pw2[3]=PKW(P1,6), pw2); \
    VLD(2,1); SBAR(); GAPA(C0=__builtin_amdgcn_mfma_f32_32x32x16_bf16(kf[6],qr[3],C0,0,0,0),   P1[10],P1[11],P1[12],P1[13], pw3[0]=PKW(P1,8), pw3[1]=PKW(P1,10), pw3); \
    VLD(3,5); SBAR(); GAPA(C1=__builtin_amdgcn_mfma_f32_32x32x16_bf16(kf[7],qr[3],C1,0,0,0),   P1[14],P1[15],0.f,0.f,       pw3[2]=PKW(P1,12),pw3[3]=PKW(P1,14), pw3); \
    l_reg+=sacc; \
    if(GK){DMA_K((t)+3,sl_cur);} if(GV){DMA_V((t)+1,sl_next);} \
    _Pragma("unroll") for(int r=0;r<16;++r){C0[r]-=mhat;C1[r]-=mhat;} CMASK(C0,C1,t); \
    { float a=MX3(C0[0],C0[1],C1[0]),b=MX3(C0[2],C0[3],C1[1]); a=MX3(a,C1[2],C1[3]); \
      _Pragma("unroll") for(int r=4;r<16;r+=4){a=MX3(a,C0[r],C0[r+1]);b=MX3(b,C0[r+2],C0[r+3]);a=MX3(a,C1[r],C1[r+1]);b=MX3(b,C1[r+2],C1[r+3]);} \
      float rm=__builtin_fmaxf(a,b); { auto rr=__builtin_amdgcn_permlane32_swap(__float_as_uint(rm),__float_as_uint(rm),false,false); rm=__builtin_fmaxf(__uint_as_float(rr[0]),__uint_as_float(rr[1])); } \
      resc=false; \
      if(__builtin_expect(__any(rm>(float)THRL),0)){ const float dl=__builtin_fmaxf(rm,0.f); mhat+=dl; \
        _Pragma("unroll") for(int r=0;r<16;++r){C0[r]-=dl;C1[r]-=dl;} \
        const float f=__builtin_amdgcn_exp2f(-dl); l_reg*=f; if(hi==0)wsf[r32]=f; resc=true; } } \
    SBAR(); \
    GAPB2(o[0]=__builtin_amdgcn_mfma_f32_32x32x16_bf16(PAF(0),VFRS(0),o[0],0,0,0), C0,0); VLD(0,2); SBAR(); \
    GAPB2(o[1]=__builtin_amdgcn_mfma_f32_32x32x16_bf16(PAF(0),VFRS(1),o[1],0,0,0), C0,2); VLD(1,6); SBAR(); \
    KRD(GL,0); GAPB2(o[0]=__builtin_amdgcn_mfma_f32_32x32x16_bf16(PAF(1),VFRS(2),o[0],0,0,0), C0,4); VLD(2,3); SBAR(); \
    KRD(GL,1); GAPB2(o[1]=__builtin_amdgcn_mfma_f32_32x32x16_bf16(PAF(1),VFRS(3),o[1],0,0,0), C0,6); VLD(3,7); SBAR(); \
    KRD(GL,2); GAPB2(o[0]=__builtin_amdgcn_mfma_f32_32x32x16_bf16(PAF(2),VFRS(0),o[0],0,0,0), C0,8); VLD(0,8); SBAR(); \
    KRD(GL,3); GAPB2(o[1]=__builtin_amdgcn_mfma_f32_32x32x16_bf16(PAF(2),VFRS(1),o[1],0,0,0), C0,10); VLD(1,12); SBAR(); \
    GAPB2(o[0]=__builtin_amdgcn_mfma_f32_32x32x16_bf16(PAF(3),VFRS(2),o[0],0,0,0), C0,12); VLD(2,9); SBAR(); \
    GAPB2(o[1]=__builtin_amdgcn_mfma_f32_32x32x16_bf16(PAF(3),VFRS(3),o[1],0,0,0), C0,14); VLD(3,13); SBAR(); \
    GAPB2(o[2]=__builtin_amdgcn_mfma_f32_32x32x16_bf16(PAF(0),VFRS(0),o[2],0,0,0), C1,0); VLD(0,10); SBAR(); \
    GAPB2(o[3]=__builtin_amdgcn_mfma_f32_32x32x16_bf16(PAF(0),VFRS(1),o[3],0,0,0), C1,2); VLD(1,14); SBAR(); \
    GAPB2(o[2]=__builtin_amdgcn_mfma_f32_32x32x16_bf16(PAF(1),VFRS(2),o[2],0,0,0), C1,4); VLD(2,11); SBAR(); \
    GAPB2(o[3]=__builtin_amdgcn_mfma_f32_32x32x16_bf16(PAF(1),VFRS(3),o[3],0,0,0), C1,6); VLD(3,15); SBAR(); \
    GAPB2(o[2]=__builtin_amdgcn_mfma_f32_32x32x16_bf16(PAF(2),VFRS(0),o[2],0,0,0), C1,8); \
    GAPB2(o[3]=__builtin_amdgcn_mfma_f32_32x32x16_bf16(PAF(2),VFRS(1),o[3],0,0,0), C1,10); \
    GAPB2(o[2]=__builtin_amdgcn_mfma_f32_32x32x16_bf16(PAF(3),VFRS(2),o[2],0,0,0), C1,12); \
    GAPB2(o[3]=__builtin_amdgcn_mfma_f32_32x32x16_bf16(PAF(3),VFRS(3),o[3],0,0,0), C1,14); \
    }while(0)
  int t=1;
  #undef CMASK
  #define CMASK(P0,P1,t) do{}while(0)
  for(;t+5<NT;t+=2){
    STEP(pB0,pB1,pA0,pA1,t,true,true,true);     WAIT_BAR(3); RESC(); ROT();
    STEP(pA0,pA1,pB0,pB1,t+1,true,true,true);   WAIT_BAR(3); RESC(); ROT();
  }
  #undef CMASK
  #define CMASK(P0,P1,t) do{int jb_=(t)-(NT-4); if(jb_>=0)cmask(P0,P1,jb_,qrel,hi);}while(0)
  #define ENDW(tt) do{ if((tt)+3<NT){WAIT_BAR(3);} else if((tt)+2<NT){WAIT_BAR(2);} else {WAIT_BAR(0);} }while(0)
  for(;t+1<NT;t+=2){
    STEP(pB0,pB1,pA0,pA1,t,(t+3<NT),(t+1<NT),(t+1<NT));       ENDW(t);   RESC(); ROT();
    STEP(pA0,pA1,pB0,pB1,t+1,(t+4<NT),(t+2<NT),(t+2<NT));     ENDW(t+1); RESC(); ROT();
  }
  STEP(pB0,pB1,pA0,pA1,NT-1,false,false,false); RESC();
  { float sacc=pB0[0]+pB0[1]; _Pragma("unroll") for(int r=2;r<16;++r)sacc+=pB0[r]; _Pragma("unroll") for(int r=0;r<16;++r)sacc+=pB1[r]; l_reg+=sacc;
    pw0=(u32x4){PKW(pB0,0),PKW(pB0,2),PKW(pB0,4),PKW(pB0,6)};pw1=(u32x4){PKW(pB0,8),PKW(pB0,10),PKW(pB0,12),PKW(pB0,14)};pw2=(u32x4){PKW(pB1,0),PKW(pB1,2),PKW(pB1,4),PKW(pB1,6)};pw3=(u32x4){PKW(pB1,8),PKW(pB1,10),PKW(pB1,12),PKW(pB1,14)};
    SBAR(); pv(o,vb0+2*sl_cur,PAF(0),PAF(1),PAF(2),PAF(3)); pv(o+2,vb0+2*sl_cur+8192,PAF(0),PAF(1),PAF(2),PAF(3)); }
  #undef PKW
  #undef PAF
  #undef VFR
  #undef PIN
  #undef MX3
  #undef GAPA
  #undef GAPB
  #undef EX
  #undef VRD
  #undef VRD2
  #undef VLD
  #undef VFRS
  #undef GAPB2
  #undef BGAP
  #undef KRD
  #undef STEP
  #undef ENDW
  __builtin_amdgcn_s_setprio(0);
  u32x4 zg_[4]; if(BIAS){ const bf16*Zw=Zg+(rowbase+q0+wid*QBLK)*DM;
    #pragma unroll
    for(int i=0;i<4;++i)zg_[i]=*(const u32x4*)(Zw+(long)(i*8+(lane>>3))*DM+(lane&7)*8); }
  {auto rr=__builtin_amdgcn_permlane32_swap(__float_as_uint(l_reg),__float_as_uint(l_reg),false,false);l_reg=__uint_as_float(rr[0])+__uint_as_float(rr[1]);}
  if(hi==0)wsf[32+r32]=l_reg;asm volatile("s_waitcnt lgkmcnt(0)":::"memory");
  float rli[16];
  #pragma unroll
  for(int r=0;r<16;++r)rli[r]=__builtin_amdgcn_rcpf(wsf[32+crow(r,hi)]);
  bf16*Ow=O+(rowbase+q0+wid*QBLK)*DM;
  { bf16*stg=(bf16*)(shm+LDS_OST2)+wid*4096;
    #pragma unroll
    for(int r=0;r<16;++r){const int orow=crow(r,hi);
      #pragma unroll
      for(int d0=0;d0<4;++d0)stg[orow*128+d0*32+r32]=__float2bfloat16(o[d0][r]*rli[r]);}
    asm volatile("s_waitcnt lgkmcnt(0)":::"memory");
    #pragma unroll
    for(int i=0;i<8;++i){const int row=i*4+(lane>>4),ch=lane&15; const u32x4 v=*(const u32x4*)(stg+row*128+ch*8); ATTN_STORE16(Ow+(long)row*DM+ch*8,v);} }
  asm volatile("s_waitcnt lgkmcnt(0)\n\ts_barrier":::"memory");
  #undef DMA_K
  #undef DMA_V
  #undef CMASK
  #undef START
  #undef RESC
  #undef ROT
}
constexpr int ATTN_LDS_BYTES=LDS_BYTES;
struct AttnTensors { const bf16* Q; const bf16* K; const bf16* V; bf16* O; const float* cum; const bf16* Z; };
struct AttnUnit { int bh; int qb; };
struct StaticOrder {
  int vcu,G;
  __device__ __forceinline__ StaticOrder(int vcu_,int G_,int np_):vcu(vcu_),G(G_),NP_(np_){}
  int NP_;
  __device__ __forceinline__ bool next(int i,AttnUnit&u)const{ int P;
    if(NP_%G==0 && G%8==0){ const int ppc=NP_/G; if(i>=2*ppc)return false; const int g=vcu>>3,j=vcu&7,r=i>>1; P=(g*2*ppc+2*r+(j>>2))*4+(j&3); }
    else { P=vcu+(i>>1)*G; if(P>=NP_)return false; }
    const int s=P&3; u.bh=P>>2; u.qb=(i&1)?7-s:s; return true; }
};
template<bool BIAS,int THRL=8> __device__ __forceinline__ void attn_phase(char*lds,const AttnTensors&T,const StaticOrder&S){
  AttnUnit u;
  for(int i=0;S.next(i,u);++i){
    const int b=u.bh>>4, vh=u.bh&15;
    if(BIAS){ attn_unit<64,true>(b,u.qb,T.Q+vh*64,T.K+vh*64,T.V+vh*64,T.O+vh*64,T.cum+(long)u.bh*SEQ,T.Z+vh*64,lds); }
    else { const int b8=u.bh>>3, v8=u.bh&7; const int h=v8>>1,c=v8&1; const int sub=(h*2+c)*64;
      attn_unit128<THRL>(b8,u.qb,T.Q+sub,T.K+sub,T.V+h*128,T.O+c*512+h*128,lds); }
  }
}
#undef SBAR
#undef WAIT_BAR
}
#include <hip/hip_cooperative_groups.h>
namespace cg = cooperative_groups;
#define LAS __attribute__((address_space(3)))
typedef unsigned short bf16;
typedef unsigned v4u __attribute__((ext_vector_type(4)));
typedef unsigned v2u __attribute__((ext_vector_type(2)));
typedef float f32x4 __attribute__((ext_vector_type(4)));

constexpr int NWAVES = 8, NTHR = 512;
constexpr int BATCH = 32, SEQ = 2048, D = 1024, M = BATCH * SEQ;
constexpr int IN_AB = 4104, IN_C = 4112, NP = 4096;
constexpr float EPS = 1e-6f;
constexpr float QSCALE = 0.125f * 1.4426950408889634f;
constexpr size_t MiB = 1u << 20;
constexpr size_t WS_W1T = 2 * MiB, WS_WO1T = 10 * MiB, WS_W2T = 12 * MiB, WS_WO2T = 20 * MiB;
constexpr size_t WS_CS = 22 * MiB;
constexpr size_t WS_GB = 26 * MiB;
constexpr size_t WS_CUM = 28 * MiB;
constexpr size_t WS_XB = 32 * MiB;
constexpr size_t WS_P = 160 * MiB;
constexpr size_t WS_OA = 672 * MiB;
constexpr size_t WS_OB = 800 * MiB;
constexpr size_t WS_BAR = 0;
constexpr size_t WS_EGL = 1 * MiB;
constexpr size_t WS_GW = WS_XB, WS_GQG = WS_XB + 64 * MiB;
constexpr size_t WS_GKDT = 864 * MiB, WS_GUT = 928 * MiB, WS_GQKM = 992 * MiB;
constexpr size_t WS_END = 1024 * MiB;
constexpr size_t PSTRIDE = (size_t)M * 1024;
constexpr int LDS_BYTES = 147456;

__device__ __forceinline__ float bf2f(bf16 u) { return __uint_as_float((unsigned)u << 16); }
__device__ __forceinline__ unsigned f2bf(float f) { return attn_body::cvtpk_s(f, 0.f) & 0xffffu; }
__device__ __forceinline__ unsigned pk2(float lo, float hi) { return attn_body::cvtpk_s(lo, hi); }
#define LBAR() do { asm volatile("s_waitcnt lgkmcnt(0)" ::: "memory"); __builtin_amdgcn_s_barrier(); asm volatile("" ::: "memory"); } while (0)
__device__ __forceinline__ float dpp_f(float v, int ctrl_sel) {
    const int x = __float_as_int(v);
    int r = ctrl_sel == 0 ? __builtin_amdgcn_update_dpp(x, x, 0xB1, 0xF, 0xF, true) : ctrl_sel == 1 ? __builtin_amdgcn_update_dpp(x, x, 0x4E, 0xF, 0xF, true)
          : ctrl_sel == 2 ? __builtin_amdgcn_update_dpp(x, x, 0x141, 0xF, 0xF, true) : __builtin_amdgcn_update_dpp(x, x, 0x140, 0xF, 0xF, true);
    return __int_as_float(r);
}
__device__ __forceinline__ float row16_sum(float v) { v += dpp_f(v, 0); v += dpp_f(v, 1); v += dpp_f(v, 2); v += dpp_f(v, 3); return v; }
__device__ __forceinline__ float wave_sum(float v) {
    v = row16_sum(v);
    { auto r = __builtin_amdgcn_permlane16_swap(__float_as_uint(v), __float_as_uint(v), false, false); v = __uint_as_float(r[0]) + __uint_as_float(r[1]); }
    { auto r = __builtin_amdgcn_permlane32_swap(__float_as_uint(v), __float_as_uint(v), false, false); v = __uint_as_float(r[0]) + __uint_as_float(r[1]); }
    return v;
}
__device__ __forceinline__ float silu_f(float x) { return x * __builtin_amdgcn_rcpf(1.f + __expf(-x)); }
__device__ __forceinline__ void unpack8(v4u w, float* f) {
#pragma unroll
    for (int i = 0; i < 4; ++i) { f[2 * i] = __uint_as_float(w[i] << 16); f[2 * i + 1] = __uint_as_float(w[i] & 0xffff0000u); }
}

struct EpiRope {
    static constexpr bool PERM = true, AFTER_DRAIN = false;
    bf16* O; const float* cs;
    __device__ __forceinline__ void operator()(const pg8::f32x4 (&acc)[2][2][4][2], const pg8::Unit& u, int wr, int wc, int fr, int fq) const {
        const int row0 = u.pm * 256 + wr * 64 + fr; int colt = u.pn * 256;
        const int t = colt >> 10; bf16* base = O + (size_t)t * PSTRIDE; colt -= t << 10;
        const int col0 = colt + wc * 32 + 8 * fq;
        const bool rot = (t == 0) && ((wc & 1) == 0);
        const float sg = (fq == 0) ? -1.f : 1.f;
        f32x4 nx[4] = {{1.f, 1.f, 1.f, 1.f}, {1.f, 1.f, 1.f, 1.f}, {0.f, 0.f, 0.f, 0.f}, {0.f, 0.f, 0.f, 0.f}};
        if (rot) { const f32x4* cp = (const f32x4*)(cs + (size_t)row0 * 16); nx[0] = cp[0]; nx[1] = cp[1]; nx[2] = cp[2]; nx[3] = cp[3]; }
#pragma unroll
        for (int ai = 0; ai < 2; ++ai)
#pragma unroll
            for (int m = 0; m < 4; ++m) {
                const int row = row0 + ai * 128 + m * 16; bf16* rowp = base + (size_t)row * 1024 + col0;
                const f32x4 c0 = nx[0], c1 = nx[1], s0 = nx[2], s1 = nx[3];
                if (rot && (ai * 4 + m) < 7) { const int rown = row0 + ((ai * 4 + m + 1) >> 2) * 128 + ((ai * 4 + m + 1) & 3) * 16; const f32x4* cp = (const f32x4*)(cs + (size_t)rown * 16); nx[0] = cp[0]; nx[1] = cp[1]; nx[2] = cp[2]; nx[3] = cp[3]; }
#pragma unroll
                for (int bj = 0; bj < 2; ++bj) {
                    f32x4 v0 = acc[ai][bj][m][0], v1 = acc[ai][bj][m][1];
                    if (rot) {
                        f32x4 p0, p1;
#pragma unroll
                        for (int i = 0; i < 4; ++i) {
                            auto r0_ = __builtin_amdgcn_permlane16_swap(__float_as_uint(v0[i]), __float_as_uint(v0[i]), false, false); p0[i] = __uint_as_float((fq & 1) ? r0_[0] : r0_[1]);
                            auto r1_ = __builtin_amdgcn_permlane16_swap(__float_as_uint(v1[i]), __float_as_uint(v1[i]), false, false); p1[i] = __uint_as_float((fq & 1) ? r1_[0] : r1_[1]); }
                        if (fq < 2) { v0 = v0 * c0 + sg * (p0 * s0); v1 = v1 * c1 + sg * (p1 * s1); }
                    }
                    v4u w; w.x = pg8::cvt_pk_bf16(v0[0], v0[1]); w.y = pg8::cvt_pk_bf16(v0[2], v0[3]); w.z = pg8::cvt_pk_bf16(v1[0], v1[1]); w.w = pg8::cvt_pk_bf16(v1[2], v1[3]);
                    *(v4u*)(rowp + bj * 128) = w;
                }
            }
    }
};

#define XB_TMO      128
#define XB_XCNT(j)  (256  + 64 * (j))
#define XB_XSUB(j)  (1280 + 64 * (j))
#define XB_XGEN(j)  (2304 + 64 * (j))
#define XB_TOP      3328
#define XB_TOPGEN   3392
#define XCD_BAR_WORDS 3456
#define XB_SPIN_CAP (1u << 18)

__device__ __forceinline__ unsigned xb_ld(unsigned* p)              { return __hip_atomic_load(p, __ATOMIC_RELAXED, __HIP_MEMORY_SCOPE_AGENT); }
__device__ __forceinline__ unsigned xb_add(unsigned* p, unsigned v) { return __hip_atomic_fetch_add(p, v, __ATOMIC_RELAXED, __HIP_MEMORY_SCOPE_AGENT); }
__device__ __forceinline__ unsigned xb_xcc_id() { return (unsigned)__builtin_amdgcn_s_getreg((3 << 11) | 20) & 0xFu; }
#define XB_SPIN(cond, bar) do { unsigned _sp = 0; while (cond) { __builtin_amdgcn_s_sleep(1); \
    if ((++_sp & 255u) == 0u) { if (xb_ld(&(bar)[XB_TMO])) break; if (_sp > XB_SPIN_CAP) { atomicAdd(&(bar)[XB_TMO], 1u); break; } } } } while (0)

struct XcdBarrier {
    unsigned* bar; unsigned x;
    volatile LAS unsigned* st;
};

__device__ __forceinline__ XcdBarrier xcd_barrier_post(unsigned* bar, volatile LAS unsigned* st) {
    XcdBarrier b; b.bar = bar; b.x = xb_xcc_id(); b.st = st;
    if (threadIdx.x == 0) (void)xb_add(&bar[XB_XCNT(b.x)], 1u);
    return b;
}
__device__ __forceinline__ void xcd_barrier_complete(unsigned* bar, unsigned x, unsigned& nloc, unsigned& nx) {
    const unsigned G = gridDim.x * gridDim.y * gridDim.z;
    unsigned sum, cnt, mine, sp = 0u;
    for (;;) {
        sum = 0u; cnt = 0u; mine = 0u;
#pragma unroll
        for (unsigned j = 0; j < 16; ++j) { const unsigned c = xb_ld(&bar[XB_XCNT(j)]); sum += c; cnt += (c > 0u) ? 1u : 0u; mine = (j == x) ? c : mine; }
        if (sum == G) break;
        __builtin_amdgcn_s_sleep(1);
        if ((++sp & 255u) == 0u) { if (xb_ld(&bar[XB_TMO])) break; if (sp > XB_SPIN_CAP) { atomicAdd(&bar[XB_TMO], 1u); break; } }
    }
    nloc = mine > 0u ? mine : 1u; nx = cnt > 0u ? cnt : 1u;
}

__device__ __forceinline__ void xcd_barrier(const XcdBarrier& b) {
    asm volatile("s_waitcnt vmcnt(0)" ::: "memory");
    __syncthreads();
    if (threadIdx.x == 0) {
        unsigned* bar = b.bar;
        __builtin_amdgcn_s_waitcnt(0);
        unsigned nloc = b.st[0], nx = b.st[1];
        if (nloc == 0u) { xcd_barrier_complete(bar, b.x, nloc, nx); b.st[0] = nloc; b.st[1] = nx; }
        const unsigned old = xb_add(&bar[XB_XSUB(b.x)], 1u);
        const unsigned gen = old / nloc;
        if (old + 1u == (gen + 1u) * nloc) {
            __builtin_amdgcn_fence(__ATOMIC_RELEASE, "agent");
            asm volatile("s_waitcnt vmcnt(0)" ::: "memory");
            const unsigned og = xb_add(&bar[XB_TOP], 1u);
            const unsigned tg = og / nx;
            if (og + 1u == (tg + 1u) * nx) xb_add(&bar[XB_TOPGEN], 1u);
            else XB_SPIN(xb_ld(&bar[XB_TOPGEN]) == tg, bar);
            __builtin_amdgcn_fence(__ATOMIC_ACQUIRE, "agent");
            xb_add(&bar[XB_XGEN(b.x)], 1u);
            asm volatile("s_waitcnt vmcnt(0)" ::: "memory");
        } else {
            XB_SPIN(xb_ld(&bar[XB_XGEN(b.x)]) == gen, bar);
            __builtin_amdgcn_fence(__ATOMIC_ACQUIRE, "agent");
            asm volatile("s_waitcnt vmcnt(0)" ::: "memory");
        }
    }
    __syncthreads();
}

struct Args {
    const float* x; const int* pos; const float* pre; const float* post; const float* w_in_ab;
    const float* lq1; const float* lk1; const float* lq2; const float* lk2; const float* subln;
    const float* convw; const float* a_log; const float* dt_bias; const float* head_norm; const float* w_out_ab;
    const float* w_in_c; const float* fbias; const float* w_out_c;
    float* out; unsigned char* ws;
};

__device__ __forceinline__ void transpose_item(const float* W, int ldw, int K, int ncols, bf16* WT, const float* kscale, int qcols, LAS float* scr, int item, int lane) {
    const int nblk = ncols / 32, kb = item / nblk, nb = item % nblk, k0 = 64 * kb, n0 = 32 * nb;
    const float cscale = (n0 + (lane & 31)) < qcols ? QSCALE : 1.f;
#pragma unroll 8
    for (int i = 0; i < 32; ++i) { const int kk = 2 * i + (lane >> 5); const float ks = kscale ? kscale[k0 + kk] : 1.f;
        scr[kk * 33 + (lane & 31)] = W[(size_t)(k0 + kk) * ldw + n0 + (lane & 31)] * ks * cscale; }
    asm volatile("s_waitcnt lgkmcnt(0)" ::: "memory");
    const int c = lane & 7;
#pragma unroll
    for (int j = 0; j < 4; ++j) { const int n = (lane >> 3) + 8 * j; const LAS float* s = scr + (8 * c) * 33 + n;
        v4u o; o.x = pk2(s[0 * 33], s[1 * 33]); o.y = pk2(s[2 * 33], s[3 * 33]); o.z = pk2(s[4 * 33], s[5 * 33]); o.w = pk2(s[6 * 33], s[7 * 33]);
        *(v4u*)(WT + (size_t)(n0 + n) * K + k0 + 8 * c) = o; }
    asm volatile("s_waitcnt lgkmcnt(0)" ::: "memory");
}

template <int NC> __device__ __forceinline__ void stage_small_w(LAS float* wl, const float* W, int ldw, const float* pre, int tid) {
    for (int e = tid; e < NC * 1024; e += NTHR) { const int k = e / NC, c = e % NC; wl[c * 1024 + k] = W[(size_t)k * ldw + NP + c] * pre[k]; }
}
template <int NC> __device__ __forceinline__ float small_dots(const LAS float* wl, const f32x4 (&v)[4], int lane) {
    float mine = 0.f;
#pragma unroll 2
    for (int c = 0; c < NC; ++c) { float s = 0.f;
#pragma unroll
        for (int j = 0; j < 4; ++j) { const f32x4 w = *(const LAS f32x4*)(wl + c * 1024 + 256 * j + 4 * lane); s += (v[j].x * w.x + v[j].y * w.y) + (v[j].z * w.z + v[j].w * w.w); }
        s = wave_sum(s); mine = (lane == c) ? s : mine; }
    return mine;
}
__device__ __forceinline__ void store_row_bf16(bf16* orow, const f32x4 (&v)[4], float sc, int lane) {
    unsigned long long* o8 = (unsigned long long*)orow + lane;
#pragma unroll
    for (int j = 0; j < 4; ++j) o8[64 * j] = (unsigned long long)pk2(v[j].x * sc, v[j].y * sc) | ((unsigned long long)pk2(v[j].z * sc, v[j].w * sc) << 32);
}
__device__ __forceinline__ float sumsq4(const f32x4 (&v)[4]) { float s = 0.f;
#pragma unroll
    for (int j = 0; j < 4; ++j) s += (v[j].x * v[j].x + v[j].y * v[j].y) + (v[j].z * v[j].z + v[j].w * v[j].w);
    return s; }

__device__ __forceinline__ void phase_prologue(const Args& A, LAS unsigned char* lds, int vcu, int G, int tid, int lane, int wave) {
    unsigned char* ws = A.ws;
    LAS float* wl = (LAS float*)lds;
    LAS float* scr = (LAS float*)(lds + 32768 + wave * 12288);
    stage_small_w<8>(wl, A.w_in_ab, IN_AB, A.pre, tid);
    const int gw = vcu * NWAVES + wave, NGW = G * NWAVES;
    constexpr int I1 = 16 * 128, IO = 16 * 32;
    for (int it = gw; it < 2 * I1 + 2 * IO; it += NGW) {
        int r = it;
        if (r < I1) { transpose_item(A.w_in_ab, IN_AB, D, NP, (bf16*)(ws + WS_W1T), A.pre, 512, scr, r, lane); continue; } r -= I1;
        if (r < I1) { transpose_item(A.w_in_c, IN_C, D, NP, (bf16*)(ws + WS_W2T), A.pre + D, 1024, scr, r, lane); continue; } r -= I1;
        if (r < IO) { transpose_item(A.w_out_ab, D, D, D, (bf16*)(ws + WS_WO1T), nullptr, 0, scr, r, lane); continue; } r -= IO;
        transpose_item(A.w_out_c, D, D, D, (bf16*)(ws + WS_WO2T), nullptr, 0, scr, r, lane);
    }
    __syncthreads();
    bf16* XB = (bf16*)(ws + WS_XB); float* GB = (float*)(ws + WS_GB); float* CS = (float*)(ws + WS_CS);
    const int hh = lane & 3; const float alog = A.a_log[hh], dtb = A.dt_bias[hh];
    const float invf = powf(500000.0f, -(float)(lane & 7) * 0.125f);
    for (int m = gw; m < M; m += NGW) {
        const f32x4* xr = (const f32x4*)(A.x + (size_t)m * D) + lane; f32x4 v[4];
#pragma unroll
        for (int j = 0; j < 4; ++j) v[j] = xr[64 * j];
        const float rstd = __builtin_amdgcn_rsqf(wave_sum(sumsq4(v)) * (1.f / D) + EPS);
        store_row_bf16(XB + (size_t)m * D, v, rstd, lane);
        float mine = small_dots<8>(wl, v, lane) * rstd;
        if (lane < 4) GB[(size_t)m * 8 + lane] = 1.f / (1.f + expf(-mine));
        else if (lane < 8) { const float xx = mine + dtb; const float sp = xx > 20.f ? xx : log1pf(expf(xx)); GB[(size_t)m * 8 + lane] = -expf(alog) * sp; }
    }
    for (int q = 0; q < (M / NGW + 7) / 8; ++q) { const int ri = (lane >> 3) + 8 * q; const int m = gw + ri * NGW;
        if (m < M) { const float ang = (float)A.pos[m] * invf; const float sn = sinf(ang), cn = cosf(ang); CS[(size_t)m * 16 + (lane & 7)] = cn; CS[(size_t)m * 16 + 8 + (lane & 7)] = sn; } }
}

typedef short s16x8 __attribute__((ext_vector_type(8)));
typedef float f32x16v __attribute__((ext_vector_type(16)));
typedef float f32x2v __attribute__((ext_vector_type(2)));
__device__ __forceinline__ int crow16(int r, int hi) { return (r & 3) + 8 * (r >> 2) + 4 * hi; }
__device__ __forceinline__ void phase_gdn_prep(const Args& A, LAS unsigned char* lds, int vcu, int G, int tid, int lane, int wave) {
    unsigned char* ws = A.ws;
    const bf16* PQK = (const bf16*)(ws + WS_P) + 2 * PSTRIDE;
    const bf16* PVZ = (const bf16*)(ws + WS_P) + 3 * PSTRIDE;
    const float* GB = (const float*)(ws + WS_GB);
    bf16* GW = (bf16*)(ws + WS_GW); bf16* GQG = (bf16*)(ws + WS_GQG); bf16* GKDT = (bf16*)(ws + WS_GKDT); bf16* GUT = (bf16*)(ws + WS_GUT); bf16* GQKM = (bf16*)(ws + WS_GQKM);
    float* EGL = (float*)(ws + WS_EGL);
    LAS bf16* kb16 = (LAS bf16*)lds; LAS bf16* qb16 = (LAS bf16*)(lds + 17408);
    LAS float* RHS = (LAS float*)(lds + 34816); LAS float* Am = (LAS float*)(lds + 100352);
    LAS float* gcl = (LAS float*)(lds + 117760); LAS float* betal = (LAS float*)(lds + 118016);
    const int r32 = lane & 31, hi = lane >> 5;
    unsigned xraw[3][11]; float g_nx = 0.f, beta_nx = 0.f;
#define PREP_ISSUE(un) do { const int b_ = (un) >> 7, n_ = ((un) >> 2) & 31, h_ = (un) & 3; const long m0_ = (long)b_ * SEQ + n_ * 64; \
        g_nx = GB[(m0_ + lane) * 8 + 4 + h_]; beta_nx = GB[(m0_ + lane) * 8 + h_]; \
        _Pragma("unroll") for (int which = 0; which < 3; ++which) { const bf16* sp_ = (which < 2 ? PQK + which * 512 : PVZ) + h_ * 128 + 2 * lane; \
            _Pragma("unroll") for (int i = 0; i < 11; ++i) { long row_ = m0_ + wave * 8 + i - 3; row_ = row_ < 0 ? 0 : row_; xraw[which][i] = *(const unsigned*)(sp_ + row_ * 1024); } } } while (0)
    for (int unit = vcu; unit < 4096; unit += G) {
        const int b = unit >> 7, n = (unit >> 2) & 31, h = unit & 3;
        const int t0 = n * 64; const size_t m0 = (size_t)b * SEQ + t0; const size_t ch = unit;
        PREP_ISSUE(unit); const float g_l = g_nx, beta_l = beta_nx;
        float gc = g_l;
        {
            gc += __int_as_float(__builtin_amdgcn_update_dpp(0, __float_as_int(gc), 0x111, 0xF, 0xF, false));
            gc += __int_as_float(__builtin_amdgcn_update_dpp(0, __float_as_int(gc), 0x112, 0xF, 0xF, false));
            gc += __int_as_float(__builtin_amdgcn_update_dpp(0, __float_as_int(gc), 0x114, 0xF, 0xF, false));
            gc += __int_as_float(__builtin_amdgcn_update_dpp(0, __float_as_int(gc), 0x118, 0xF, 0xF, false));
            const float t0 = __int_as_float(__builtin_amdgcn_readlane(__float_as_int(gc), 15)), t1 = __int_as_float(__builtin_amdgcn_readlane(__float_as_int(gc), 31)), t2 = __int_as_float(__builtin_amdgcn_readlane(__float_as_int(gc), 47));
            const int rw = lane >> 4; gc += (rw == 1) ? t0 : (rw == 2) ? (t0 + t1) : (rw == 3) ? ((t0 + t1) + t2) : 0.f; }
        const float glast = __int_as_float(__builtin_amdgcn_readlane(__float_as_int(gc), 63));
        if (wave == 0) { gcl[lane] = gc; betal[lane] = beta_l; if (lane == 0) EGL[ch] = __expf(glast); }
        float val[3][8][2];
#pragma unroll
        for (int which = 0; which < 3; ++which) {
            const int chn = which * 512 + h * 128 + 2 * lane;
            f32x2v w[4];
#pragma unroll
            for (int j = 0; j < 4; ++j) w[j] = *(const f32x2v*)(A.convw + j * 1536 + chn);
            float x0[11], x1[11];
#pragma unroll
            for (int i = 0; i < 11; ++i) { const int tr = wave * 8 + i - 3; const unsigned u = (t0 + tr >= 0) ? xraw[which][i] : 0u;
                x0[i] = __uint_as_float(u << 16); x1[i] = __uint_as_float(u & 0xffff0000u); }
#pragma unroll
            for (int r = 0; r < 8; ++r) {
                const float y0 = w[0].x * x0[r] + w[1].x * x0[r + 1] + w[2].x * x0[r + 2] + w[3].x * x0[r + 3];
                const float y1 = w[0].y * x1[r] + w[1].y * x1[r + 1] + w[2].y * x1[r + 2] + w[3].y * x1[r + 3];
                val[which][r][0] = silu_f(y0); val[which][r][1] = silu_f(y1); }
        }
        float kd0[8], kd1[8];
        int zv_ = 0; asm volatile("" : "+v"(zv_)); const int iv0 = wave * 8 + zv_;
        LAS bf16* kbw = kb16 + (wave * 8) * 136 + 2 * lane; LAS bf16* qbw = qb16 + (wave * 8) * 136 + 2 * lane; LAS float* rhw = RHS + (wave * 8) * 256 + 2 * lane;
        bf16* gqw = GQG + ch * 8192 + (((wave >> 2) * 8 + (lane >> 3)) * 64 + ((lane >> 2) & 1) * 32 + (wave & 3) * 8) * 8 + 2 * (lane & 3);
#pragma unroll
        for (int r = 0; r < 8; ++r) {
            const float q0 = val[0][r][0], q1 = val[0][r][1], k0 = val[1][r][0], k1 = val[1][r][1];
            const float rq = __builtin_amdgcn_rsqf(wave_sum(q0 * q0 + q1 * q1) + EPS) * 0.08838834764831845f, rk = __builtin_amdgcn_rsqf(wave_sum(k0 * k0 + k1 * k1) + EPS);
            const float gci = __shfl(gc, iv0 + r), bi = __shfl(beta_l, iv0 + r);
            const float eg = __expf(gci), ed = __expf(glast - gci);
            const float qa = q0 * rq, qb = q1 * rq, ka = k0 * rk, kb = k1 * rk;
            *(LAS unsigned*)(kbw + r * 136) = pk2(ka, kb);
            *(LAS unsigned*)(qbw + r * 136) = pk2(qa, qb);
            *(LAS f32x2v*)(rhw + r * 256) = (f32x2v){bi * val[2][r][0], bi * val[2][r][1]};
            *(LAS f32x2v*)(rhw + r * 256 + 128) = (f32x2v){bi * eg * ka, bi * eg * kb};
            *(unsigned*)(gqw + r * 8) = pk2(qa * eg, qb * eg);
            kd0[r] = ka * ed; kd1[r] = kb * ed;
        }
        { v4u o; o.x = pk2(kd0[0], kd0[1]); o.y = pk2(kd0[2], kd0[3]); o.z = pk2(kd0[4], kd0[5]); o.w = pk2(kd0[6], kd0[7]);
          *(v4u*)(GKDT + ch * 8192 + ((((2 * lane) >> 5) * 4 + (wave >> 1)) * 64 + (wave & 1) * 32 + ((2 * lane) & 31)) * 8) = o;
          o.x = pk2(kd1[0], kd1[1]); o.y = pk2(kd1[2], kd1[3]); o.z = pk2(kd1[4], kd1[5]); o.w = pk2(kd1[6], kd1[7]);
          *(v4u*)(GKDT + ch * 8192 + ((((2 * lane + 1) >> 5) * 4 + (wave >> 1)) * 64 + (wave & 1) * 32 + ((2 * lane + 1) & 31)) * 8) = o; }
        LBAR();
        {
            const int which = wave >> 2, mi = (wave >> 1) & 1, ni = wave & 1;
            const LAS bf16* ab = (which ? qb16 : kb16) + (mi * 32 + r32) * 136 + hi * 8; const LAS bf16* bb = kb16 + (ni * 32 + r32) * 136 + hi * 8;
            f32x16v Dv = {};
#pragma unroll
            for (int kk = 0; kk < 8; ++kk) Dv = __builtin_amdgcn_mfma_f32_32x32x16_bf16(*(const LAS s16x8*)(ab + kk * 16), *(const LAS s16x8*)(bb + kk * 16), Dv, 0, 0, 0);
            const int j = ni * 32 + r32; const float gcj = gcl[j];
#pragma unroll
            for (int r = 0; r < 16; ++r) { const int i = mi * 32 + crow16(r, hi); const float dec = __expf(gcl[i] - gcj);
                if (which == 0) Am[i * 68 + j] = (j < i) ? betal[i] * Dv[r] * dec : 0.f;
                else GQKM[ch * 4096 + ((mi * 4 + (j >> 4)) * 64 + ((j >> 3) & 1) * 32 + crow16(r, hi)) * 8 + (j & 7)] = (bf16)f2bf((j <= i) ? Dv[r] * dec : 0.f); }
        }
        LBAR();
        if (tid < 256) {
            const int c = tid; float x[64]; int zv = 0; asm volatile("" : "+v"(zv)); const LAS float* Amv = Am + zv;
            f32x4 A0_0, A0_1, A0_2, A0_3, A0_4, A0_5, A0_6, A0_7, A1_0, A1_1, A1_2, A1_3, A1_4, A1_5, A1_6, A1_7; float r0 = 0.f, r1 = 0.f, c0 = 0.f, c1 = 0.f, c2 = 0.f, c3 = 0.f;
            r0 = RHS[0 + c];
            A1_0 = *(const LAS f32x4*)(Amv + 68); r1 = RHS[256 + c]; __builtin_amdgcn_sched_barrier(0); c0 = r0; c1 = 0.f; c2 = 0.f; c3 = 0.f; x[0] = (c0 + c1) + (c2 + c3); __builtin_amdgcn_sched_barrier(0);
            A0_0 = *(const LAS f32x4*)(Amv + 136); r0 = RHS[512 + c]; __builtin_amdgcn_sched_barrier(0); c0 = r1; c1 = 0.f; c2 = 0.f; c3 = 0.f; c0 -= A1_0[0] * x[0]; x[1] = (c0 + c1) + (c2 + c3); __builtin_amdgcn_sched_barrier(0);
            A1_0 = *(const LAS f32x4*)(Amv + 204); r1 = RHS[768 + c]; __builtin_amdgcn_sched_barrier(0); c0 = r0; c1 = 0.f; c2 = 0.f; c3 = 0.f; c0 -= A0_0[0] * x[0]; c1 -= A0_0[1] * x[1]; x[2] = (c0 + c1) + (c2 + c3); __builtin_amdgcn_sched_barrier(0);
            A0_0 = *(const LAS f32x4*)(Amv + 272); r0 = RHS[1024 + c]; __builtin_amdgcn_sched_barrier(0); c0 = r1; c1 = 0.f; c2 = 0.f; c3 = 0.f; c0 -= A1_0[0] * x[0]; c1 -= A1_0[1] * x[1]; c2 -= A1_0[2] * x[2]; x[3] = (c0 + c1) + (c2 + c3); __builtin_amdgcn_sched_barrier(0);
            A1_0 = *(const LAS f32x4*)(Amv + 340); A1_1 = *(const LAS f32x4*)(Amv + 344); r1 = RHS[1280 + c]; __builtin_amdgcn_sched_barrier(0); c0 = r0; c1 = 0.f; c2 = 0.f; c3 = 0.f; c0 -= A0_0[0] * x[0]; c1 -= A0_0[1] * x[1]; c2 -= A0_0[2] * x[2]; c3 -= A0_0[3] * x[3]; x[4] = (c0 + c1) + (c2 + c3); __builtin_amdgcn_sched_barrier(0);
            A0_0 = *(const LAS f32x4*)(Amv + 408); A0_1 = *(const LAS f32x4*)(Amv + 412); r0 = RHS[1536 + c]; __builtin_amdgcn_sched_barrier(0); c0 = r1; c1 = 0.f; c2 = 0.f; c3 = 0.f; c0 -= A1_0[0] * x[0]; c1 -= A1_0[1] * x[1]; c2 -= A1_0[2] * x[2]; c3 -= A1_0[3] * x[3]; c0 -= A1_1[0] * x[4]; x[5] = (c0 + c1) + (c2 + c3); __builtin_amdgcn_sched_barrier(0);
            A1_0 = *(const LAS f32x4*)(Amv + 476); A1_1 = *(const LAS f32x4*)(Amv + 480); r1 = RHS[1792 + c]; __builtin_amdgcn_sched_barrier(0); c0 = r0; c1 = 0.f; c2 = 0.f; c3 = 0.f; c0 -= A0_0[0] * x[0]; c1 -= A0_0[1] * x[1]; c2 -= A0_0[2] * x[2]; c3 -= A0_0[3] * x[3]; c0 -= A0_1[0] * x[4]; c1 -= A0_1[1] * x[5]; x[6] = (c0 + c1) + (c2 + c3); __builtin_amdgcn_sched_barrier(0);
            A0_0 = *(const LAS f32x4*)(Amv + 544); A0_1 = *(const LAS f32x4*)(Amv + 548); r0 = RHS[2048 + c]; __builtin_amdgcn_sched_barrier(0); c0 = r1; c1 = 0.f; c2 = 0.f; c3 = 0.f; c0 -= A1_0[0] * x[0]; c1 -= A1_0[1] * x[1]; c2 -= A1_0[2] * x[2]; c3 -= A1_0[3] * x[3]; c0 -= A1_1[0] * x[4]; c1 -= A1_1[1] * x[5]; c2 -= A1_1[2] * x[6]; x[7] = (c0 + c1) + (c2 + c3); __builtin_amdgcn_sched_barrier(0);
            A1_0 = *(const LAS f32x4*)(Amv + 612); A1_1 = *(const LAS f32x4*)(Amv + 616); A1_2 = *(const LAS f32x4*)(Amv + 620); r1 = RHS[2304 + c]; __builtin_amdgcn_sched_barrier(0); c0 = r0; c1 = 0.f; c2 = 0.f; c3 = 0.f; c0 -= A0_0[0] * x[0]; c1 -= A0_0[1] * x[1]; c2 -= A0_0[2] * x[2]; c3 -= A0_0[3] * x[3]; c0 -= A0_1[0] * x[4]; c1 -= A0_1[1] * x[5]; c2 -= A0_1[2] * x[6]; c3 -= A0_1[3] * x[7]; x[8] = (c0 + c1) + (c2 + c3); __builtin_amdgcn_sched_barrier(0);
            A0_0 = *(const LAS f32x4*)(Amv + 680); A0_1 = *(const LAS f32x4*)(Amv + 684); A0_2 = *(const LAS f32x4*)(Amv + 688); r0 = RHS[2560 + c]; __builtin_amdgcn_sched_barrier(0); c0 = r1; c1 = 0.f; c2 = 0.f; c3 = 0.f; c0 -= A1_0[0] * x[0]; c1 -= A1_0[1] * x[1]; c2 -= A1_0[2] * x[2]; c3 -= A1_0[3] * x[3]; c0 -= A1_1[0] * x[4]; c1 -= A1_1[1] * x[5]; c2 -= A1_1[2] * x[6]; c3 -= A1_1[3] * x[7]; c0 -= A1_2[0] * x[8]; x[9] = (c0 + c1) + (c2 + c3); __builtin_amdgcn_sched_barrier(0);
            A1_0 = *(const LAS f32x4*)(Amv + 748); A1_1 = *(const LAS f32x4*)(Amv + 752); A1_2 = *(const LAS f32x4*)(Amv + 756); r1 = RHS[2816 + c]; __builtin_amdgcn_sched_barrier(0); c0 = r0; c1 = 0.f; c2 = 0.f; c3 = 0.f; c0 -= A0_0[0] * x[0]; c1 -= A0_0[1] * x[1]; c2 -= A0_0[2] * x[2]; c3 -= A0_0[3] * x[3]; c0 -= A0_1[0] * x[4]; c1 -= A0_1[1] * x[5]; c2 -= A0_1[2] * x[6]; c3 -= A0_1[3] * x[7]; c0 -= A0_2[0] * x[8]; c1 -= A0_2[1] * x[9]; x[10] = (c0 + c1) + (c2 + c3); __builtin_amdgcn_sched_barrier(0);
            A0_0 = *(const LAS f32x4*)(Amv + 816); A0_1 = *(const LAS f32x4*)(Amv + 820); A0_2 = *(const LAS f32x4*)(Amv + 824); r0 = RHS[3072 + c]; __builtin_amdgcn_sched_barrier(0); c0 = r1; c1 = 0.f; c2 = 0.f; c3 = 0.f; c0 -= A1_0[0] * x[0]; c1 -= A1_0[1] * x[1]; c2 -= A1_0[2] * x[2]; c3 -= A1_0[3] * x[3]; c0 -= A1_1[0] * x[4]; c1 -= A1_1[1] * x[5]; c2 -= A1_1[2] * x[6]; c3 -= A1_1[3] * x[7]; c0 -= A1_2[0] * x[8]; c1 -= A1_2[1] * x[9]; c2 -= A1_2[2] * x[10]; x[11] = (c0 + c1) + (c2 + c3); __builtin_amdgcn_sched_barrier(0);
            A1_0 = *(const LAS f32x4*)(Amv + 884); A1_1 = *(const LAS f32x4*)(Amv + 888); A1_2 = *(const LAS f32x4*)(Amv + 892); A1_3 = *(const LAS f32x4*)(Amv + 896); r1 = RHS[3328 + c]; __builtin_amdgcn_sched_barrier(0); c0 = r0; c1 = 0.f; c2 = 0.f; c3 = 0.f; c0 -= A0_0[0] * x[0]; c1 -= A0_0[1] * x[1]; c2 -= A0_0[2] * x[2]; c3 -= A0_0[3] * x[3]; c0 -= A0_1[0] * x[4]; c1 -= A0_1[1] * x[5]; c2 -= A0_1[2] * x[6]; c3 -= A0_1[3] * x[7]; c0 -= A0_2[0] * x[8]; c1 -= A0_2[1] * x[9]; c2 -= A0_2[2] * x[10]; c3 -= A0_2[3] * x[11]; x[12] = (c0 + c1) + (c2 + c3); __builtin_amdgcn_sched_barrier(0);
            A0_0 = *(const LAS f32x4*)(Amv + 952); A0_1 = *(const LAS f32x4*)(Amv + 956); A0_2 = *(const LAS f32x4*)(Amv + 960); A0_3 = *(const LAS f32x4*)(Amv + 964); r0 = RHS[3584 + c]; __builtin_amdgcn_sched_barrier(0); c0 = r1; c1 = 0.f; c2 = 0.f; c3 = 0.f; c0 -= A1_0[0] * x[0]; c1 -= A1_0[1] * x[1]; c2 -= A1_0[2] * x[2]; c3 -= A1_0[3] * x[3]; c0 -= A1_1[0] * x[4]; c1 -= A1_1[1] * x[5]; c2 -= A1_1[2] * x[6]; c3 -= A1_1[3] * x[7]; c0 -= A1_2[0] * x[8]; c1 -= A1_2[1] * x[9]; c2 -= A1_2[2] * x[10]; c3 -= A1_2[3] * x[11]; c0 -= A1_3[0] * x[12]; x[13] = (c0 + c1) + (c2 + c3); __builtin_amdgcn_sched_barrier(0);
            A1_0 = *(const LAS f32x4*)(Amv + 1020); A1_1 = *(const LAS f32x4*)(Amv + 1024); A1_2 = *(const LAS f32x4*)(Amv + 1028); A1_3 = *(const LAS f32x4*)(Amv + 1032); r1 = RHS[3840 + c]; __builtin_amdgcn_sched_barrier(0); c0 = r0; c1 = 0.f; c2 = 0.f; c3 = 0.f; c0 -= A0_0[0] * x[0]; c1 -= A0_0[1] * x[1]; c2 -= A0_0[2] * x[2]; c3 -= A0_0[3] * x[3]; c0 -= A0_1[0] * x[4]; c1 -= A0_1[1] * x[5]; c2 -= A0_1[2] * x[6]; c3 -= A0_1[3] * x[7]; c0 -= A0_2[0] * x[8]; c1 -= A0_2[1] * x[9]; c2 -= A0_2[2] * x[10]; c3 -= A0_2[3] * x[11]; c0 -= A0_3[0] * x[12]; c1 -= A0_3[1] * x[13]; x[14] = (c0 + c1) + (c2 + c3); __builtin_amdgcn_sched_barrier(0);
            A0_0 = *(const LAS f32x4*)(Amv + 1088); A0_1 = *(const LAS f32x4*)(Amv + 1092); A0_2 = *(const LAS f32x4*)(Amv + 1096); A0_3 = *(const LAS f32x4*)(Amv + 1100); r0 = RHS[4096 + c]; __builtin_amdgcn_sched_barrier(0); c0 = r1; c1 = 0.f; c2 = 0.f; c3 = 0.f; c0 -= A1_0[0] * x[0]; c1 -= A1_0[1] * x[1]; c2 -= A1_0[2] * x[2]; c3 -= A1_0[3] * x[3]; c0 -= A1_1[0] * x[4]; c1 -= A1_1[1] * x[5]; c2 -= A1_1[2] * x[6]; c3 -= A1_1[3] * x[7]; c0 -= A1_2[0] * x[8]; c1 -= A1_2[1] * x[9]; c2 -= A1_2[2] * x[10]; c3 -= A1_2[3] * x[11]; c0 -= A1_3[0] * x[12]; c1 -= A1_3[1] * x[13]; c2 -= A1_3[2] * x[14]; x[15] = (c0 + c1) + (c2 + c3); __builtin_amdgcn_sched_barrier(0);
            A1_0 = *(const LAS f32x4*)(Amv + 1156); A1_1 = *(const LAS f32x4*)(Amv + 1160); A1_2 = *(const LAS f32x4*)(Amv + 1164); A1_3 = *(const LAS f32x4*)(Amv + 1168); A1_4 = *(const LAS f32x4*)(Amv + 1172); r1 = RHS[4352 + c]; __builtin_amdgcn_sched_barrier(0); c0 = r0; c1 = 0.f; c2 = 0.f; c3 = 0.f; c0 -= A0_0[0] * x[0]; c1 -= A0_0[1] * x[1]; c2 -= A0_0[2] * x[2]; c3 -= A0_0[3] * x[3]; c0 -= A0_1[0] * x[4]; c1 -= A0_1[1] * x[5]; c2 -= A0_1[2] * x[6]; c3 -= A0_1[3] * x[7]; c0 -= A0_2[0] * x[8]; c1 -= A0_2[1] * x[9]; c2 -= A0_2[2] * x[10]; c3 -= A0_2[3] * x[11]; c0 -= A0_3[0] * x[12]; c1 -= A0_3[1] * x[13]; c2 -= A0_3[2] * x[14]; c3 -= A0_3[3] * x[15]; x[16] = (c0 + c1) + (c2 + c3); __builtin_amdgcn_sched_barrier(0);
            A0_0 = *(const LAS f32x4*)(Amv + 1224); A0_1 = *(const LAS f32x4*)(Amv + 1228); A0_2 = *(const LAS f32x4*)(Amv + 1232); A0_3 = *(const LAS f32x4*)(Amv + 1236); A0_4 = *(const LAS f32x4*)(Amv + 1240); r0 = RHS[4608 + c]; __builtin_amdgcn_sched_barrier(0); c0 = r1; c1 = 0.f; c2 = 0.f; c3 = 0.f; c0 -= A1_0[0] * x[0]; c1 -= A1_0[1] * x[1]; c2 -= A1_0[2] * x[2]; c3 -= A1_0[3] * x[3]; c0 -= A1_1[0] * x[4]; c1 -= A1_1[1] * x[5]; c2 -= A1_1[2] * x[6]; c3 -= A1_1[3] * x[7]; c0 -= A1_2[0] * x[8]; c1 -= A1_2[1] * x[9]; c2 -= A1_2[2] * x[10]; c3 -= A1_2[3] * x[11]; c0 -= A1_3[0] * x[12]; c1 -= A1_3[1] * x[13]; c2 -= A1_3[2] * x[14]; c3 -= A1_3[3] * x[15]; c0 -= A1_4[0] * x[16]; x[17] = (c0 + c1) + (c2 + c3); __builtin_amdgcn_sched_barrier(0);
            A1_0 = *(const LAS f32x4*)(Amv + 1292); A1_1 = *(const LAS f32x4*)(Amv + 1296); A1_2 = *(const LAS f32x4*)(Amv + 1300); A1_3 = *(const LAS f32x4*)(Amv + 1304); A1_4 = *(const LAS f32x4*)(Amv + 1308); r1 = RHS[4864 + c]; __builtin_amdgcn_sched_barrier(0); c0 = r0; c1 = 0.f; c2 = 0.f; c3 = 0.f; c0 -= A0_0[0] * x[0]; c1 -= A0_0[1] * x[1]; c2 -= A0_0[2] * x[2]; c3 -= A0_0[3] * x[3]; c0 -= A0_1[0] * x[4]; c1 -= A0_1[1] * x[5]; c2 -= A0_1[2] * x[6]; c3 -= A0_1[3] * x[7]; c0 -= A0_2[0] * x[8]; c1 -= A0_2[1] * x[9]; c2 -= A0_2[2] * x[10]; c3 -= A0_2[3] * x[11]; c0 -= A0_3[0] * x[12]; c1 -= A0_3[1] * x[13]; c2 -= A0_3[2] * x[14]; c3 -= A0_3[3] * x[15]; c0 -= A0_4[0] * x[16]; c1 -= A0_4[1] * x[17]; x[18] = (c0 + c1) + (c2 + c3); __builtin_amdgcn_sched_barrier(0);
            A0_0 = *(const LAS f32x4*)(Amv + 1360); A0_1 = *(const LAS f32x4*)(Amv + 1364); A0_2 = *(const LAS f32x4*)(Amv + 1368); A0_3 = *(const LAS f32x4*)(Amv + 1372); A0_4 = *(const LAS f32x4*)(Amv + 1376); r0 = RHS[5120 + c]; __builtin_amdgcn_sched_barrier(0); c0 = r1; c1 = 0.f; c2 = 0.f; c3 = 0.f; c0 -= A1_0[0] * x[0]; c1 -= A1_0[1] * x[1]; c2 -= A1_0[2] * x[2]; c3 -= A1_0[3] * x[3]; c0 -= A1_1[0] * x[4]; c1 -= A1_1[1] * x[5]; c2 -= A1_1[2] * x[6]; c3 -= A1_1[3] * x[7]; c0 -= A1_2[0] * x[8]; c1 -= A1_2[1] * x[9]; c2 -= A1_2[2] * x[10]; c3 -= A1_2[3] * x[11]; c0 -= A1_3[0] * x[12]; c1 -= A1_3[1] * x[13]; c2 -= A1_3[2] * x[14]; c3 -= A1_3[3] * x[15]; c0 -= A1_4[0] * x[16]; c1 -= A1_4[1] * x[17]; c2 -= A1_4[2] * x[18]; x[19] = (c0 + c1) + (c2 + c3); __builtin_amdgcn_sched_barrier(0);
            A1_0 = *(const LAS f32x4*)(Amv + 1428); A1_1 = *(const LAS f32x4*)(Amv + 1432); A1_2 = *(const LAS f32x4*)(Amv + 1436); A1_3 = *(const LAS f32x4*)(Amv + 1440); A1_4 = *(const LAS f32x4*)(Amv + 1444); A1_5 = *(const LAS f32x4*)(Amv + 1448); r1 = RHS[5376 + c]; __builtin_amdgcn_sched_barrier(0); c0 = r0; c1 = 0.f; c2 = 0.f; c3 = 0.f; c0 -= A0_0[0] * x[0]; c1 -= A0_0[1] * x[1]; c2 -= A0_0[2] * x[2]; c3 -= A0_0[3] * x[3]; c0 -= A0_1[0] * x[4]; c1 -= A0_1[1] * x[5]; c2 -= A0_1[2] * x[6]; c3 -= A0_1[3] * x[7]; c0 -= A0_2[0] * x[8]; c1 -= A0_2[1] * x[9]; c2 -= A0_2[2] * x[10]; c3 -= A0_2[3] * x[11]; c0 -= A0_3[0] * x[12]; c1 -= A0_3[1] * x[13]; c2 -= A0_3[2] * x[14]; c3 -= A0_3[3] * x[15]; c0 -= A0_4[0] * x[16]; c1 -= A0_4[1] * x[17]; c2 -= A0_4[2] * x[18]; c3 -= A0_4[3] * x[19]; x[20] = (c0 + c1) + (c2 + c3); __builtin_amdgcn_sched_barrier(0);
            A0_0 = *(const LAS f32x4*)(Amv + 1496); A0_1 = *(const LAS f32x4*)(Amv + 1500); A0_2 = *(const LAS f32x4*)(Amv + 1504); A0_3 = *(const LAS f32x4*)(Amv + 1508); A0_4 = *(const LAS f32x4*)(Amv + 1512); A0_5 = *(const LAS f32x4*)(Amv + 1516); r0 = RHS[5632 + c]; __builtin_amdgcn_sched_barrier(0); c0 = r1; c1 = 0.f; c2 = 0.f; c3 = 0.f; c0 -= A1_0[0] * x[0]; c1 -= A1_0[1] * x[1]; c2 -= A1_0[2] * x[2]; c3 -= A1_0[3] * x[3]; c0 -= A1_1[0] * x[4]; c1 -= A1_1[1] * x[5]; c2 -= A1_1[2] * x[6]; c3 -= A1_1[3] * x[7]; c0 -= A1_2[0] * x[8]; c1 -= A1_2[1] * x[9]; c2 -= A1_2[2] * x[10]; c3 -= A1_2[3] * x[11]; c0 -= A1_3[0] * x[12]; c1 -= A1_3[1] * x[13]; c2 -= A1_3[2] * x[14]; c3 -= A1_3[3] * x[15]; c0 -= A1_4[0] * x[16]; c1 -= A1_4[1] * x[17]; c2 -= A1_4[2] * x[18]; c3 -= A1_4[3] * x[19]; c0 -= A1_5[0] * x[20]; x[21] = (c0 + c1) + (c2 + c3); __builtin_amdgcn_sched_barrier(0);
            A1_0 = *(const LAS f32x4*)(Amv + 1564); A1_1 = *(const LAS f32x4*)(Amv + 1568); A1_2 = *(const LAS f32x4*)(Amv + 1572); A1_3 = *(const LAS f32x4*)(Amv + 1576); A1_4 = *(const LAS f32x4*)(Amv + 1580); A1_5 = *(const LAS f32x4*)(Amv + 1584); r1 = RHS[5888 + c]; __builtin_amdgcn_sched_barrier(0); c0 = r0; c1 = 0.f; c2 = 0.f; c3 = 0.f; c0 -= A0_0[0] * x[0]; c1 -= A0_0[1] * x[1]; c2 -= A0_0[2] * x[2]; c3 -= A0_0[3] * x[3]; c0 -= A0_1[0] * x[4]; c1 -= A0_1[1] * x[5]; c2 -= A0_1[2] * x[6]; c3 -= A0_1[3] * x[7]; c0 -= A0_2[0] * x[8]; c1 -= A0_2[1] * x[9]; c2 -= A0_2[2] * x[10]; c3 -= A0_2[3] * x[11]; c0 -= A0_3[0] * x[12]; c1 -= A0_3[1] * x[13]; c2 -= A0_3[2] * x[14]; c3 -= A0_3[3] * x[15]; c0 -= A0_4[0] * x[16]; c1 -= A0_4[1] * x[17]; c2 -= A0_4[2] * x[18]; c3 -= A0_4[3] * x[19]; c0 -= A0_5[0] * x[20]; c1 -= A0_5[1] * x[21]; x[22] = (c0 + c1) + (c2 + c3); __builtin_amdgcn_sched_barrier(0);
            A0_0 = *(const LAS f32x4*)(Amv + 1632); A0_1 = *(const LAS f32x4*)(Amv + 1636); A0_2 = *(const LAS f32x4*)(Amv + 1640); A0_3 = *(const LAS f32x4*)(Amv + 1644); A0_4 = *(const LAS f32x4*)(Amv + 1648); A0_5 = *(const LAS f32x4*)(Amv + 1652); r0 = RHS[6144 + c]; __builtin_amdgcn_sched_barrier(0); c0 = r1; c1 = 0.f; c2 = 0.f; c3 = 0.f; c0 -= A1_0[0] * x[0]; c1 -= A1_0[1] * x[1]; c2 -= A1_0[2] * x[2]; c3 -= A1_0[3] * x[3]; c0 -= A1_1[0] * x[4]; c1 -= A1_1[1] * x[5]; c2 -= A1_1[2] * x[6]; c3 -= A1_1[3] * x[7]; c0 -= A1_2[0] * x[8]; c1 -= A1_2[1] * x[9]; c2 -= A1_2[2] * x[10]; c3 -= A1_2[3] * x[11]; c0 -= A1_3[0] * x[12]; c1 -= A1_3[1] * x[13]; c2 -= A1_3[2] * x[14]; c3 -= A1_3[3] * x[15]; c0 -= A1_4[0] * x[16]; c1 -= A1_4[1] * x[17]; c2 -= A1_4[2] * x[18]; c3 -= A1_4[3] * x[19]; c0 -= A1_5[0] * x[20]; c1 -= A1_5[1] * x[21]; c2 -= A1_5[2] * x[22]; x[23] = (c0 + c1) + (c2 + c3); __builtin_amdgcn_sched_barrier(0);
            A1_0 = *(const LAS f32x4*)(Amv + 1700); A1_1 = *(const LAS f32x4*)(Amv + 1704); A1_2 = *(const LAS f32x4*)(Amv + 1708); A1_3 = *(const LAS f32x4*)(Amv + 1712); A1_4 = *(const LAS f32x4*)(Amv + 1716); A1_5 = *(const LAS f32x4*)(Amv + 1720); A1_6 = *(const LAS f32x4*)(Amv + 1724); r1 = RHS[6400 + c]; __builtin_amdgcn_sched_barrier(0); c0 = r0; c1 = 0.f; c2 = 0.f; c3 = 0.f; c0 -= A0_0[0] * x[0]; c1 -= A0_0[1] * x[1]; c2 -= A0_0[2] * x[2]; c3 -= A0_0[3] * x[3]; c0 -= A0_1[0] * x[4]; c1 -= A0_1[1] * x[5]; c2 -= A0_1[2] * x[6]; c3 -= A0_1[3] * x[7]; c0 -= A0_2[0] * x[8]; c1 -= A0_2[1] * x[9]; c2 -= A0_2[2] * x[10]; c3 -= A0_2[3] * x[11]; c0 -= A0_3[0] * x[12]; c1 -= A0_3[1] * x[13]; c2 -= A0_3[2] * x[14]; c3 -= A0_3[3] * x[15]; c0 -= A0_4[0] * x[16]; c1 -= A0_4[1] * x[17]; c2 -= A0_4[2] * x[18]; c3 -= A0_4[3] * x[19]; c0 -= A0_5[0] * x[20]; c1 -= A0_5[1] * x[21]; c2 -= A0_5[2] * x[22]; c3 -= A0_5[3] * x[23]; x[24] = (c0 + c1) + (c2 + c3); __builtin_amdgcn_sched_barrier(0);
            A0_0 = *(const LAS f32x4*)(Amv + 1768); A0_1 = *(const LAS f32x4*)(Amv + 1772); A0_2 = *(const LAS f32x4*)(Amv + 1776); A0_3 = *(const LAS f32x4*)(Amv + 1780); A0_4 = *(const LAS f32x4*)(Amv + 1784); A0_5 = *(const LAS f32x4*)(Amv + 1788); A0_6 = *(const LAS f32x4*)(Amv + 1792); r0 = RHS[6656 + c]; __builtin_amdgcn_sched_barrier(0); c0 = r1; c1 = 0.f; c2 = 0.f; c3 = 0.f; c0 -= A1_0[0] * x[0]; c1 -= A1_0[1] * x[1]; c2 -= A1_0[2] * x[2]; c3 -= A1_0[3] * x[3]; c0 -= A1_1[0] * x[4]; c1 -= A1_1[1] * x[5]; c2 -= A1_1[2] * x[6]; c3 -= A1_1[3] * x[7]; c0 -= A1_2[0] * x[8]; c1 -= A1_2[1] * x[9]; c2 -= A1_2[2] * x[10]; c3 -= A1_2[3] * x[11]; c0 -= A1_3[0] * x[12]; c1 -= A1_3[1] * x[13]; c2 -= A1_3[2] * x[14]; c3 -= A1_3[3] * x[15]; c0 -= A1_4[0] * x[16]; c1 -= A1_4[1] * x[17]; c2 -= A1_4[2] * x[18]; c3 -= A1_4[3] * x[19]; c0 -= A1_5[0] * x[20]; c1 -= A1_5[1] * x[21]; c2 -= A1_5[2] * x[22]; c3 -= A1_5[3] * x[23]; c0 -= A1_6[0] * x[24]; x[25] = (c0 + c1) + (c2 + c3); __builtin_amdgcn_sched_barrier(0);
            A1_0 = *(const LAS f32x4*)(Amv + 1836); A1_1 = *(const LAS f32x4*)(Amv + 1840); A1_2 = *(const LAS f32x4*)(Amv + 1844); A1_3 = *(const LAS f32x4*)(Amv + 1848); A1_4 = *(const LAS f32x4*)(Amv + 1852); A1_5 = *(const LAS f32x4*)(Amv + 1856); A1_6 = *(const LAS f32x4*)(Amv + 1860); r1 = RHS[6912 + c]; __builtin_amdgcn_sched_barrier(0); c0 = r0; c1 = 0.f; c2 = 0.f; c3 = 0.f; c0 -= A0_0[0] * x[0]; c1 -= A0_0[1] * x[1]; c2 -= A0_0[2] * x[2]; c3 -= A0_0[3] * x[3]; c0 -= A0_1[0] * x[4]; c1 -= A0_1[1] * x[5]; c2 -= A0_1[2] * x[6]; c3 -= A0_1[3] * x[7]; c0 -= A0_2[0] * x[8]; c1 -= A0_2[1] * x[9]; c2 -= A0_2[2] * x[10]; c3 -= A0_2[3] * x[11]; c0 -= A0_3[0] * x[12]; c1 -= A0_3[1] * x[13]; c2 -= A0_3[2] * x[14]; c3 -= A0_3[3] * x[15]; c0 -= A0_4[0] * x[16]; c1 -= A0_4[1] * x[17]; c2 -= A0_4[2] * x[18]; c3 -= A0_4[3] * x[19]; c0 -= A0_5[0] * x[20]; c1 -= A0_5[1] * x[21]; c2 -= A0_5[2] * x[22]; c3 -= A0_5[3] * x[23]; c0 -= A0_6[0] * x[24]; c1 -= A0_6[1] * x[25]; x[26] = (c0 + c1) + (c2 + c3); __builtin_amdgcn_sched_barrier(0);
            A0_0 = *(const LAS f32x4*)(Amv + 1904); A0_1 = *(const LAS f32x4*)(Amv + 1908); A0_2 = *(const LAS f32x4*)(Amv + 1912); A0_3 = *(const LAS f32x4*)(Amv + 1916); A0_4 = *(const LAS f32x4*)(Amv + 1920); A0_5 = *(const LAS f32x4*)(Amv + 1924); A0_6 = *(const LAS f32x4*)(Amv + 1928); r0 = RHS[7168 + c]; __builtin_amdgcn_sched_barrier(0); c0 = r1; c1 = 0.f; c2 = 0.f; c3 = 0.f; c0 -= A1_0[0] * x[0]; c1 -= A1_0[1] * x[1]; c2 -= A1_0[2] * x[2]; c3 -= A1_0[3] * x[3]; c0 -= A1_1[0] * x[4]; c1 -= A1_1[1] * x[5]; c2 -= A1_1[2] * x[6]; c3 -= A1_1[3] * x[7]; c0 -= A1_2[0] * x[8]; c1 -= A1_2[1] * x[9]; c2 -= A1_2[2] * x[10]; c3 -= A1_2[3] * x[11]; c0 -= A1_3[0] * x[12]; c1 -= A1_3[1] * x[13]; c2 -= A1_3[2] * x[14]; c3 -= A1_3[3] * x[15]; c0 -= A1_4[0] * x[16]; c1 -= A1_4[1] * x[17]; c2 -= A1_4[2] * x[18]; c3 -= A1_4[3] * x[19]; c0 -= A1_5[0] * x[20]; c1 -= A1_5[1] * x[21]; c2 -= A1_5[2] * x[22]; c3 -= A1_5[3] * x[23]; c0 -= A1_6[0] * x[24]; c1 -= A1_6[1] * x[25]; c2 -= A1_6[2] * x[26]; x[27] = (c0 + c1) + (c2 + c3); __builtin_amdgcn_sched_barrier(0);
            A1_0 = *(const LAS f32x4*)(Amv + 1972); A1_1 = *(const LAS f32x4*)(Amv + 1976); A1_2 = *(const LAS f32x4*)(Amv + 1980); A1_3 = *(const LAS f32x4*)(Amv + 1984); A1_4 = *(const LAS f32x4*)(Amv + 1988); A1_5 = *(const LAS f32x4*)(Amv + 1992); A1_6 = *(const LAS f32x4*)(Amv + 1996); A1_7 = *(const LAS f32x4*)(Amv + 2000); r1 = RHS[7424 + c]; __builtin_amdgcn_sched_barrier(0); c0 = r0; c1 = 0.f; c2 = 0.f; c3 = 0.f; c0 -= A0_0[0] * x[0]; c1 -= A0_0[1] * x[1]; c2 -= A0_0[2] * x[2]; c3 -= A0_0[3] * x[3]; c0 -= A0_1[0] * x[4]; c1 -= A0_1[1] * x[5]; c2 -= A0_1[2] * x[6]; c3 -= A0_1[3] * x[7]; c0 -= A0_2[0] * x[8]; c1 -= A0_2[1] * x[9]; c2 -= A0_2[2] * x[10]; c3 -= A0_2[3] * x[11]; c0 -= A0_3[0] * x[12]; c1 -= A0_3[1] * x[13]; c2 -= A0_3[2] * x[14]; c3 -= A0_3[3] * x[15]; c0 -= A0_4[0] * x[16]; c1 -= A0_4[1] * x[17]; c2 -= A0_4[2] * x[18]; c3 -= A0_4[3] * x[19]; c0 -= A0_5[0] * x[20]; c1 -= A0_5[1] * x[21]; c2 -= A0_5[2] * x[22]; c3 -= A0_5[3] * x[23]; c0 -= A0_6[0] * x[24]; c1 -= A0_6[1] * x[25]; c2 -= A0_6[2] * x[26]; c3 -= A0_6[3] * x[27]; x[28] = (c0 + c1) + (c2 + c3); __builtin_amdgcn_sched_barrier(0);
            A0_0 = *(const LAS f32x4*)(Amv + 2040); A0_1 = *(const LAS f32x4*)(Amv + 2044); A0_2 = *(const LAS f32x4*)(Amv + 2048); A0_3 = *(const LAS f32x4*)(Amv + 2052); A0_4 = *(const LAS f32x4*)(Amv + 2056); A0_5 = *(const LAS f32x4*)(Amv + 2060); A0_6 = *(const LAS f32x4*)(Amv + 2064); A0_7 = *(const LAS f32x4*)(Amv + 2068); r0 = RHS[7680 + c]; __builtin_amdgcn_sched_barrier(0); c0 = r1; c1 = 0.f; c2 = 0.f; c3 = 0.f; c0 -= A1_0[0] * x[0]; c1 -= A1_0[1] * x[1]; c2 -= A1_0[2] * x[2]; c3 -= A1_0[3] * x[3]; c0 -= A1_1[0] * x[4]; c1 -= A1_1[1] * x[5]; c2 -= A1_1[2] * x[6]; c3 -= A1_1[3] * x[7]; c0 -= A1_2[0] * x[8]; c1 -= A1_2[1] * x[9]; c2 -= A1_2[2] * x[10]; c3 -= A1_2[3] * x[11]; c0 -= A1_3[0] * x[12]; c1 -= A1_3[1] * x[13]; c2 -= A1_3[2] * x[14]; c3 -= A1_3[3] * x[15]; c0 -= A1_4[0] * x[16]; c1 -= A1_4[1] * x[17]; c2 -= A1_4[2] * x[18]; c3 -= A1_4[3] * x[19]; c0 -= A1_5[0] * x[20]; c1 -= A1_5[1] * x[21]; c2 -= A1_5[2] * x[22]; c3 -= A1_5[3] * x[23]; c0 -= A1_6[0] * x[24]; c1 -= A1_6[1] * x[25]; c2 -= A1_6[2] * x[26]; c3 -= A1_6[3] * x[27]; c0 -= A1_7[0] * x[28]; x[29] = (c0 + c1) + (c2 + c3); __builtin_amdgcn_sched_barrier(0);
            A1_0 = *(const LAS f32x4*)(Amv + 2108); A1_1 = *(const LAS f32x4*)(Amv + 2112); A1_2 = *(const LAS f32x4*)(Amv + 2116); A1_3 = *(const LAS f32x4*)(Amv + 2120); A1_4 = *(const LAS f32x4*)(Amv + 2124); A1_5 = *(const LAS f32x4*)(Amv + 2128); A1_6 = *(const LAS f32x4*)(Amv + 2132); A1_7 = *(const LAS f32x4*)(Amv + 2136); r1 = RHS[7936 + c]; __builtin_amdgcn_sched_barrier(0); c0 = r0; c1 = 0.f; c2 = 0.f; c3 = 0.f; c0 -= A0_0[0] * x[0]; c1 -= A0_0[1] * x[1]; c2 -= A0_0[2] * x[2]; c3 -= A0_0[3] * x[3]; c0 -= A0_1[0] * x[4]; c1 -= A0_1[1] * x[5]; c2 -= A0_1[2] * x[6]; c3 -= A0_1[3] * x[7]; c0 -= A0_2[0] * x[8]; c1 -= A0_2[1] * x[9]; c2 -= A0_2[2] * x[10]; c3 -= A0_2[3] * x[11]; c0 -= A0_3[0] * x[12]; c1 -= A0_3[1] * x[13]; c2 -= A0_3[2] * x[14]; c3 -= A0_3[3] * x[15]; c0 -= A0_4[0] * x[16]; c1 -= A0_4[1] * x[17]; c2 -= A0_4[2] * x[18]; c3 -= A0_4[3] * x[19]; c0 -= A0_5[0] * x[20]; c1 -= A0_5[1] * x[21]; c2 -= A0_5[2] * x[22]; c3 -= A0_5[3] * x[23]; c0 -= A0_6[0] * x[24]; c1 -= A0_6[1] * x[25]; c2 -= A0_6[2] * x[26]; c3 -= A0_6[3] * x[27]; c0 -= A0_7[0] * x[28]; c1 -= A0_7[1] * x[29]; x[30] = (c0 + c1) + (c2 + c3); __builtin_amdgcn_sched_barrier(0);
            A0_0 = *(const LAS f32x4*)(Amv + 2176); A0_1 = *(const LAS f32x4*)(Amv + 2180); A0_2 = *(const LAS f32x4*)(Amv + 2184); A0_3 = *(const LAS f32x4*)(Amv + 2188); A0_4 = *(const LAS f32x4*)(Amv + 2192); A0_5 = *(const LAS f32x4*)(Amv + 2196); A0_6 = *(const LAS f32x4*)(Amv + 2200); A0_7 = *(const LAS f32x4*)(Amv + 2204); r0 = RHS[8192 + c]; __builtin_amdgcn_sched_barrier(0); c0 = r1; c1 = 0.f; c2 = 0.f; c3 = 0.f; c0 -= A1_0[0] * x[0]; c1 -= A1_0[1] * x[1]; c2 -= A1_0[2] * x[2]; c3 -= A1_0[3] * x[3]; c0 -= A1_1[0] * x[4]; c1 -= A1_1[1] * x[5]; c2 -= A1_1[2] * x[6]; c3 -= A1_1[3] * x[7]; c0 -= A1_2[0] * x[8]; c1 -= A1_2[1] * x[9]; c2 -= A1_2[2] * x[10]; c3 -= A1_2[3] * x[11]; c0 -= A1_3[0] * x[12]; c1 -= A1_3[1] * x[13]; c2 -= A1_3[2] * x[14]; c3 -= A1_3[3] * x[15]; c0 -= A1_4[0] * x[16]; c1 -= A1_4[1] * x[17]; c2 -= A1_4[2] * x[18]; c3 -= A1_4[3] * x[19]; c0 -= A1_5[0] * x[20]; c1 -= A1_5[1] * x[21]; c2 -= A1_5[2] * x[22]; c3 -= A1_5[3] * x[23]; c0 -= A1_6[0] * x[24]; c1 -= A1_6[1] * x[25]; c2 -= A1_6[2] * x[26]; c3 -= A1_6[3] * x[27]; c0 -= A1_7[0] * x[28]; c1 -= A1_7[1] * x[29]; c2 -= A1_7[2] * x[30]; x[31] = (c0 + c1) + (c2 + c3); __builtin_amdgcn_sched_barrier(0);
            A1_0 = *(const LAS f32x4*)(Amv + 2244); A1_1 = *(const LAS f32x4*)(Amv + 2248); A1_2 = *(const LAS f32x4*)(Amv + 2252); A1_3 = *(const LAS f32x4*)(Amv + 2256); A1_4 = *(const LAS f32x4*)(Amv + 2260); A1_5 = *(const LAS f32x4*)(Amv + 2264); A1_6 = *(const LAS f32x4*)(Amv + 2268); A1_7 = *(const LAS f32x4*)(Amv + 2272); r1 = RHS[8448 + c]; __builtin_amdgcn_sched_barrier(0); c0 = r0; c1 = 0.f; c2 = 0.f; c3 = 0.f; c0 -= A0_0[0] * x[0]; c1 -= A0_0[1] * x[1]; c2 -= A0_0[2] * x[2]; c3 -= A0_0[3] * x[3]; c0 -= A0_1[0] * x[4]; c1 -= A0_1[1] * x[5]; c2 -= A0_1[2] * x[6]; c3 -= A0_1[3] * x[7]; c0 -= A0_2[0] * x[8]; c1 -= A0_2[1] * x[9]; c2 -= A0_2[2] * x[10]; c3 -= A0_2[3] * x[11]; c0 -= A0_3[0] * x[12]; c1 -= A0_3[1] * x[13]; c2 -= A0_3[2] * x[14]; c3 -= A0_3[3] * x[15]; c0 -= A0_4[0] * x[16]; c1 -= A0_4[1] * x[17]; c2 -= A0_4[2] * x[18]; c3 -= A0_4[3] * x[19]; c0 -= A0_5[0] * x[20]; c1 -= A0_5[1] * x[21]; c2 -= A0_5[2] * x[22]; c3 -= A0_5[3] * x[23]; c0 -= A0_6[0] * x[24]; c1 -= A0_6[1] * x[25]; c2 -= A0_6[2] * x[26]; c3 -= A0_6[3] * x[27]; c0 -= A0_7[0] * x[28]; c1 -= A0_7[1] * x[29]; c2 -= A0_7[2] * x[30]; c3 -= A0_7[3] * x[31]; x[32] = (c0 + c1) + (c2 + c3); __builtin_amdgcn_sched_barrier(0);
            A0_0 = *(const LAS f32x4*)(Amv + 2276); __builtin_amdgcn_sched_barrier(0); c0 = r1; c1 = 0.f; c2 = 0.f; c3 = 0.f; c0 -= A1_0[0] * x[0]; c1 -= A1_0[1] * x[1]; c2 -= A1_0[2] * x[2]; c3 -= A1_0[3] * x[3]; c0 -= A1_1[0] * x[4]; c1 -= A1_1[1] * x[5]; c2 -= A1_1[2] * x[6]; c3 -= A1_1[3] * x[7]; c0 -= A1_2[0] * x[8]; c1 -= A1_2[1] * x[9]; c2 -= A1_2[2] * x[10]; c3 -= A1_2[3] * x[11]; c0 -= A1_3[0] * x[12]; c1 -= A1_3[1] * x[13]; c2 -= A1_3[2] * x[14]; c3 -= A1_3[3] * x[15]; c0 -= A1_4[0] * x[16]; c1 -= A1_4[1] * x[17]; c2 -= A1_4[2] * x[18]; c3 -= A1_4[3] * x[19]; c0 -= A1_5[0] * x[20]; c1 -= A1_5[1] * x[21]; c2 -= A1_5[2] * x[22]; c3 -= A1_5[3] * x[23]; c0 -= A1_6[0] * x[24]; c1 -= A1_6[1] * x[25]; c2 -= A1_6[2] * x[26]; c3 -= A1_6[3] * x[27]; c0 -= A1_7[0] * x[28]; c1 -= A1_7[1] * x[29]; c2 -= A1_7[2] * x[30]; c3 -= A1_7[3] * x[31]; __builtin_amdgcn_sched_barrier(0);
            A1_0 = *(const LAS f32x4*)(Amv + 2312); A1_1 = *(const LAS f32x4*)(Amv + 2316); A1_2 = *(const LAS f32x4*)(Amv + 2320); A1_3 = *(const LAS f32x4*)(Amv + 2324); A1_4 = *(const LAS f32x4*)(Amv + 2328); A1_5 = *(const LAS f32x4*)(Amv + 2332); A1_6 = *(const LAS f32x4*)(Amv + 2336); A1_7 = *(const LAS f32x4*)(Amv + 2340); r1 = RHS[8704 + c]; __builtin_amdgcn_sched_barrier(0); c0 -= A0_0[0] * x[32]; x[33] = (c0 + c1) + (c2 + c3); __builtin_amdgcn_sched_barrier(0);
            A0_0 = *(const LAS f32x4*)(Amv + 2344); __builtin_amdgcn_sched_barrier(0); c0 = r1; c1 = 0.f; c2 = 0.f; c3 = 0.f; c0 -= A1_0[0] * x[0]; c1 -= A1_0[1] * x[1]; c2 -= A1_0[2] * x[2]; c3 -= A1_0[3] * x[3]; c0 -= A1_1[0] * x[4]; c1 -= A1_1[1] * x[5]; c2 -= A1_1[2] * x[6]; c3 -= A1_1[3] * x[7]; c0 -= A1_2[0] * x[8]; c1 -= A1_2[1] * x[9]; c2 -= A1_2[2] * x[10]; c3 -= A1_2[3] * x[11]; c0 -= A1_3[0] * x[12]; c1 -= A1_3[1] * x[13]; c2 -= A1_3[2] * x[14]; c3 -= A1_3[3] * x[15]; c0 -= A1_4[0] * x[16]; c1 -= A1_4[1] * x[17]; c2 -= A1_4[2] * x[18]; c3 -= A1_4[3] * x[19]; c0 -= A1_5[0] * x[20]; c1 -= A1_5[1] * x[21]; c2 -= A1_5[2] * x[22]; c3 -= A1_5[3] * x[23]; c0 -= A1_6[0] * x[24]; c1 -= A1_6[1] * x[25]; c2 -= A1_6[2] * x[26]; c3 -= A1_6[3] * x[27]; c0 -= A1_7[0] * x[28]; c1 -= A1_7[1] * x[29]; c2 -= A1_7[2] * x[30]; c3 -= A1_7[3] * x[31]; __builtin_amdgcn_sched_barrier(0);
            A1_0 = *(const LAS f32x4*)(Amv + 2380); A1_1 = *(const LAS f32x4*)(Amv + 2384); A1_2 = *(const LAS f32x4*)(Amv + 2388); A1_3 = *(const LAS f32x4*)(Amv + 2392); A1_4 = *(const LAS f32x4*)(Amv + 2396); A1_5 = *(const LAS f32x4*)(Amv + 2400); A1_6 = *(const LAS f32x4*)(Amv + 2404); A1_7 = *(const LAS f32x4*)(Amv + 2408); r1 = RHS[8960 + c]; __builtin_amdgcn_sched_barrier(0); c0 -= A0_0[0] * x[32]; c1 -= A0_0[1] * x[33]; x[34] = (c0 + c1) + (c2 + c3); __builtin_amdgcn_sched_barrier(0);
            A0_0 = *(const LAS f32x4*)(Amv + 2412); __builtin_amdgcn_sched_barrier(0); c0 = r1; c1 = 0.f; c2 = 0.f; c3 = 0.f; c0 -= A1_0[0] * x[0]; c1 -= A1_0[1] * x[1]; c2 -= A1_0[2] * x[2]; c3 -= A1_0[3] * x[3]; c0 -= A1_1[0] * x[4]; c1 -= A1_1[1] * x[5]; c2 -= A1_1[2] * x[6]; c3 -= A1_1[3] * x[7]; c0 -= A1_2[0] * x[8]; c1 -= A1_2[1] * x[9]; c2 -= A1_2[2] * x[10]; c3 -= A1_2[3] * x[11]; c0 -= A1_3[0] * x[12]; c1 -= A1_3[1] * x[13]; c2 -= A1_3[2] * x[14]; c3 -= A1_3[3] * x[15]; c0 -= A1_4[0] * x[16]; c1 -= A1_4[1] * x[17]; c2 -= A1_4[2] * x[18]; c3 -= A1_4[3] * x[19]; c0 -= A1_5[0] * x[20]; c1 -= A1_5[1] * x[21]; c2 -= A1_5[2] * x[22]; c3 -= A1_5[3] * x[23]; c0 -= A1_6[0] * x[24]; c1 -= A1_6[1] * x[25]; c2 -= A1_6[2] * x[26]; c3 -= A1_6[3] * x[27]; c0 -= A1_7[0] * x[28]; c1 -= A1_7[1] * x[29]; c2 -= A1_7[2] * x[30]; c3 -= A1_7[3] * x[31]; __builtin_amdgcn_sched_barrier(0);
            A1_0 = *(const LAS f32x4*)(Amv + 2448); A1_1 = *(const LAS f32x4*)(Amv + 2452); A1_2 = *(const LAS f32x4*)(Amv + 2456); A1_3 = *(const LAS f32x4*)(Amv + 2460); A1_4 = *(const LAS f32x4*)(Amv + 2464); A1_5 = *(const LAS f32x4*)(Amv + 2468); A1_6 = *(const LAS f32x4*)(Amv + 2472); A1_7 = *(const LAS f32x4*)(Amv + 2476); r1 = RHS[9216 + c]; __builtin_amdgcn_sched_barrier(0); c0 -= A0_0[0] * x[32]; c1 -= A0_0[1] * x[33]; c2 -= A0_0[2] * x[34]; x[35] = (c0 + c1) + (c2 + c3); __builtin_amdgcn_sched_barrier(0);
            A0_0 = *(const LAS f32x4*)(Amv + 2480); __builtin_amdgcn_sched_barrier(0); c0 = r1; c1 = 0.f; c2 = 0.f; c3 = 0.f; c0 -= A1_0[0] * x[0]; c1 -= A1_0[1] * x[1]; c2 -= A1_0[2] * x[2]; c3 -= A1_0[3] * x[3]; c0 -= A1_1[0] * x[4]; c1 -= A1_1[1] * x[5]; c2 -= A1_1[2] * x[6]; c3 -= A1_1[3] * x[7]; c0 -= A1_2[0] * x[8]; c1 -= A1_2[1] * x[9]; c2 -= A1_2[2] * x[10]; c3 -= A1_2[3] * x[11]; c0 -= A1_3[0] * x[12]; c1 -= A1_3[1] * x[13]; c2 -= A1_3[2] * x[14]; c3 -= A1_3[3] * x[15]; c0 -= A1_4[0] * x[16]; c1 -= A1_4[1] * x[17]; c2 -= A1_4[2] * x[18]; c3 -= A1_4[3] * x[19]; c0 -= A1_5[0] * x[20]; c1 -= A1_5[1] * x[21]; c2 -= A1_5[2] * x[22]; c3 -= A1_5[3] * x[23]; c0 -= A1_6[0] * x[24]; c1 -= A1_6[1] * x[25]; c2 -= A1_6[2] * x[26]; c3 -= A1_6[3] * x[27]; c0 -= A1_7[0] * x[28]; c1 -= A1_7[1] * x[29]; c2 -= A1_7[2] * x[30]; c3 -= A1_7[3] * x[31]; __builtin_amdgcn_sched_barrier(0);
            A1_0 = *(const LAS f32x4*)(Amv + 2516); A1_1 = *(const LAS f32x4*)(Amv + 2520); A1_2 = *(const LAS f32x4*)(Amv + 2524); A1_3 = *(const LAS f32x4*)(Amv + 2528); A1_4 = *(const LAS f32x4*)(Amv + 2532); A1_5 = *(const LAS f32x4*)(Amv + 2536); A1_6 = *(const LAS f32x4*)(Amv + 2540); A1_7 = *(const LAS f32x4*)(Amv + 2544); r1 = RHS[9472 + c]; __builtin_amdgcn_sched_barrier(0); c0 -= A0_0[0] * x[32]; c1 -= A0_0[1] * x[33]; c2 -= A0_0[2] * x[34]; c3 -= A0_0[3] * x[35]; x[36] = (c0 + c1) + (c2 + c3); __builtin_amdgcn_sched_barrier(0);
            A0_0 = *(const LAS f32x4*)(Amv + 2548); A0_1 = *(const LAS f32x4*)(Amv + 2552); __builtin_amdgcn_sched_barrier(0); c0 = r1; c1 = 0.f; c2 = 0.f; c3 = 0.f; c0 -= A1_0[0] * x[0]; c1 -= A1_0[1] * x[1]; c2 -= A1_0[2] * x[2]; c3 -= A1_0[3] * x[3]; c0 -= A1_1[0] * x[4]; c1 -= A1_1[1] * x[5]; c2 -= A1_1[2] * x[6]; c3 -= A1_1[3] * x[7]; c0 -= A1_2[0] * x[8]; c1 -= A1_2[1] * x[9]; c2 -= A1_2[2] * x[10]; c3 -= A1_2[3] * x[11]; c0 -= A1_3[0] * x[12]; c1 -= A1_3[1] * x[13]; c2 -= A1_3[2] * x[14]; c3 -= A1_3[3] * x[15]; c0 -= A1_4[0] * x[16]; c1 -= A1_4[1] * x[17]; c2 -= A1_4[2] * x[18]; c3 -= A1_4[3] * x[19]; c0 -= A1_5[0] * x[20]; c1 -= A1_5[1] * x[21]; c2 -= A1_5[2] * x[22]; c3 -= A1_5[3] * x[23]; c0 -= A1_6[0] * x[24]; c1 -= A1_6[1] * x[25]; c2 -= A1_6[2] * x[26]; c3 -= A1_6[3] * x[27]; c0 -= A1_7[0] * x[28]; c1 -= A1_7[1] * x[29]; c2 -= A1_7[2] * x[30]; c3 -= A1_7[3] * x[31]; __builtin_amdgcn_sched_barrier(0);
            A1_0 = *(const LAS f32x4*)(Amv + 2584); A1_1 = *(const LAS f32x4*)(Amv + 2588); A1_2 = *(const LAS f32x4*)(Amv + 2592); A1_3 = *(const LAS f32x4*)(Amv + 2596); A1_4 = *(const LAS f32x4*)(Amv + 2600); A1_5 = *(const LAS f32x4*)(Amv + 2604); A1_6 = *(const LAS f32x4*)(Amv + 2608); A1_7 = *(const LAS f32x4*)(Amv + 2612); r1 = RHS[9728 + c]; __builtin_amdgcn_sched_barrier(0); c0 -= A0_0[0] * x[32]; c1 -= A0_0[1] * x[33]; c2 -= A0_0[2] * x[34]; c3 -= A0_0[3] * x[35]; c0 -= A0_1[0] * x[36]; x[37] = (c0 + c1) + (c2 + c3); __builtin_amdgcn_sched_barrier(0);
            A0_0 = *(const LAS f32x4*)(Amv + 2616); A0_1 = *(const LAS f32x4*)(Amv + 2620); __builtin_amdgcn_sched_barrier(0); c0 = r1; c1 = 0.f; c2 = 0.f; c3 = 0.f; c0 -= A1_0[0] * x[0]; c1 -= A1_0[1] * x[1]; c2 -= A1_0[2] * x[2]; c3 -= A1_0[3] * x[3]; c0 -= A1_1[0] * x[4]; c1 -= A1_1[1] * x[5]; c2 -= A1_1[2] * x[6]; c3 -= A1_1[3] * x[7]; c0 -= A1_2[0] * x[8]; c1 -= A1_2[1] * x[9]; c2 -= A1_2[2] * x[10]; c3 -= A1_2[3] * x[11]; c0 -= A1_3[0] * x[12]; c1 -= A1_3[1] * x[13]; c2 -= A1_3[2] * x[14]; c3 -= A1_3[3] * x[15]; c0 -= A1_4[0] * x[16]; c1 -= A1_4[1] * x[17]; c2 -= A1_4[2] * x[18]; c3 -= A1_4[3] * x[19]; c0 -= A1_5[0] * x[20]; c1 -= A1_5[1] * x[21]; c2 -= A1_5[2] * x[22]; c3 -= A1_5[3] * x[23]; c0 -= A1_6[0] * x[24]; c1 -= A1_6[1] * x[25]; c2 -= A1_6[2] * x[26]; c3 -= A1_6[3] * x[27]; c0 -= A1_7[0] * x[28]; c1 -= A1_7[1] * x[29]; c2 -= A1_7[2] * x[30]; c3 -= A1_7[3] * x[31]; __builtin_amdgcn_sched_barrier(0);
            A1_0 = *(const LAS f32x4*)(Amv + 2652); A1_1 = *(const LAS f32x4*)(Amv + 2656); A1_2 = *(const LAS f32x4*)(Amv + 2660); A1_3 = *(const LAS f32x4*)(Amv + 2664); A1_4 = *(const LAS f32x4*)(Amv + 2668); A1_5 = *(const LAS f32x4*)(Amv + 2672); A1_6 = *(const LAS f32x4*)(Amv + 2676); A1_7 = *(const LAS f32x4*)(Amv + 2680); r1 = RHS[9984 + c]; __builtin_amdgcn_sched_barrier(0); c0 -= A0_0[0] * x[32]; c1 -= A0_0[1] * x[33]; c2 -= A0_0[2] * x[34]; c3 -= A0_0[3] * x[35]; c0 -= A0_1[0] * x[36]; c1 -= A0_1[1] * x[37]; x[38] = (c0 + c1) + (c2 + c3); __builtin_amdgcn_sched_barrier(0);
            A0_0 = *(const LAS f32x4*)(Amv + 2684); A0_1 = *(const LAS f32x4*)(Amv + 2688); __builtin_amdgcn_sched_barrier(0); c0 = r1; c1 = 0.f; c2 = 0.f; c3 = 0.f; c0 -= A1_0[0] * x[0]; c1 -= A1_0[1] * x[1]; c2 -= A1_0[2] * x[2]; c3 -= A1_0[3] * x[3]; c0 -= A1_1[0] * x[4]; c1 -= A1_1[1] * x[5]; c2 -= A1_1[2] * x[6]; c3 -= A1_1[3] * x[7]; c0 -= A1_2[0] * x[8]; c1 -= A1_2[1] * x[9]; c2 -= A1_2[2] * x[10]; c3 -= A1_2[3] * x[11]; c0 -= A1_3[0] * x[12]; c1 -= A1_3[1] * x[13]; c2 -= A1_3[2] * x[14]; c3 -= A1_3[3] * x[15]; c0 -= A1_4[0] * x[16]; c1 -= A1_4[1] * x[17]; c2 -= A1_4[2] * x[18]; c3 -= A1_4[3] * x[19]; c0 -= A1_5[0] * x[20]; c1 -= A1_5[1] * x[21]; c2 -= A1_5[2] * x[22]; c3 -= A1_5[3] * x[23]; c0 -= A1_6[0] * x[24]; c1 -= A1_6[1] * x[25]; c2 -= A1_6[2] * x[26]; c3 -= A1_6[3] * x[27]; c0 -= A1_7[0] * x[28]; c1 -= A1_7[1] * x[29]; c2 -= A1_7[2] * x[30]; c3 -= A1_7[3] * x[31]; __builtin_amdgcn_sched_barrier(0);
            A1_0 = *(const LAS f32x4*)(Amv + 2720); A1_1 = *(const LAS f32x4*)(Amv + 2724); A1_2 = *(const LAS f32x4*)(Amv + 2728); A1_3 = *(const LAS f32x4*)(Amv + 2732); A1_4 = *(const LAS f32x4*)(Amv + 2736); A1_5 = *(const LAS f32x4*)(Amv + 2740); A1_6 = *(const LAS f32x4*)(Amv + 2744); A1_7 = *(const LAS f32x4*)(Amv + 2748); r1 = RHS[10240 + c]; __builtin_amdgcn_sched_barrier(0); c0 -= A0_0[0] * x[32]; c1 -= A0_0[1] * x[33]; c2 -= A0_0[2] * x[34]; c3 -= A0_0[3] * x[35]; c0 -= A0_1[0] * x[36]; c1 -= A0_1[1] * x[37]; c2 -= A0_1[2] * x[38]; x[39] = (c0 + c1) + (c2 + c3); __builtin_amdgcn_sched_barrier(0);
            A0_0 = *(const LAS f32x4*)(Amv + 2752); A0_1 = *(const LAS f32x4*)(Amv + 2756); __builtin_amdgcn_sched_barrier(0); c0 = r1; c1 = 0.f; c2 = 0.f; c3 = 0.f; c0 -= A1_0[0] * x[0]; c1 -= A1_0[1] * x[1]; c2 -= A1_0[2] * x[2]; c3 -= A1_0[3] * x[3]; c0 -= A1_1[0] * x[4]; c1 -= A1_1[1] * x[5]; c2 -= A1_1[2] * x[6]; c3 -= A1_1[3] * x[7]; c0 -= A1_2[0] * x[8]; c1 -= A1_2[1] * x[9]; c2 -= A1_2[2] * x[10]; c3 -= A1_2[3] * x[11]; c0 -= A1_3[0] * x[12]; c1 -= A1_3[1] * x[13]; c2 -= A1_3[2] * x[14]; c3 -= A1_3[3] * x[15]; c0 -= A1_4[0] * x[16]; c1 -= A1_4[1] * x[17]; c2 -= A1_4[2] * x[18]; c3 -= A1_4[3] * x[19]; c0 -= A1_5[0] * x[20]; c1 -= A1_5[1] * x[21]; c2 -= A1_5[2] * x[22]; c3 -= A1_5[3] * x[23]; c0 -= A1_6[0] * x[24]; c1 -= A1_6[1] * x[25]; c2 -= A1_6[2] * x[26]; c3 -= A1_6[3] * x[27]; c0 -= A1_7[0] * x[28]; c1 -= A1_7[1] * x[29]; c2 -= A1_7[2] * x[30]; c3 -= A1_7[3] * x[31]; __builtin_amdgcn_sched_barrier(0);
            A1_0 = *(const LAS f32x4*)(Amv + 2788); A1_1 = *(const LAS f32x4*)(Amv + 2792); A1_2 = *(const LAS f32x4*)(Amv + 2796); A1_3 = *(const LAS f32x4*)(Amv + 2800); A1_4 = *(const LAS f32x4*)(Amv + 2804); A1_5 = *(const LAS f32x4*)(Amv + 2808); A1_6 = *(const LAS f32x4*)(Amv + 2812); A1_7 = *(const LAS f32x4*)(Amv + 2816); r1 = RHS[10496 + c]; __builtin_amdgcn_sched_barrier(0); c0 -= A0_0[0] * x[32]; c1 -= A0_0[1] * x[33]; c2 -= A0_0[2] * x[34]; c3 -= A0_0[3] * x[35]; c0 -= A0_1[0] * x[36]; c1 -= A0_1[1] * x[37]; c2 -= A0_1[2] * x[38]; c3 -= A0_1[3] * x[39]; x[40] = (c0 + c1) + (c2 + c3); __builtin_amdgcn_sched_barrier(0);
            A0_0 = *(const LAS f32x4*)(Amv + 2820); A0_1 = *(const LAS f32x4*)(Amv + 2824); A0_2 = *(const LAS f32x4*)(Amv + 2828); __builtin_amdgcn_sched_barrier(0); c0 = r1; c1 = 0.f; c2 = 0.f; c3 = 0.f; c0 -= A1_0[0] * x[0]; c1 -= A1_0[1] * x[1]; c2 -= A1_0[2] * x[2]; c3 -= A1_0[3] * x[3]; c0 -= A1_1[0] * x[4]; c1 -= A1_1[1] * x[5]; c2 -= A1_1[2] * x[6]; c3 -= A1_1[3] * x[7]; c0 -= A1_2[0] * x[8]; c1 -= A1_2[1] * x[9]; c2 -= A1_2[2] * x[10]; c3 -= A1_2[3] * x[11]; c0 -= A1_3[0] * x[12]; c1 -= A1_3[1] * x[13]; c2 -= A1_3[2] * x[14]; c3 -= A1_3[3] * x[15]; c0 -= A1_4[0] * x[16]; c1 -= A1_4[1] * x[17]; c2 -= A1_4[2] * x[18]; c3 -= A1_4[3] * x[19]; c0 -= A1_5[0] * x[20]; c1 -= A1_5[1] * x[21]; c2 -= A1_5[2] * x[22]; c3 -= A1_5[3] * x[23]; c0 -= A1_6[0] * x[24]; c1 -= A1_6[1] * x[25]; c2 -= A1_6[2] * x[26]; c3 -= A1_6[3] * x[27]; c0 -= A1_7[0] * x[28]; c1 -= A1_7[1] * x[29]; c2 -= A1_7[2] * x[30]; c3 -= A1_7[3] * x[31]; __builtin_amdgcn_sched_barrier(0);
            A1_0 = *(const LAS f32x4*)(Amv + 2856); A1_1 = *(const LAS f32x4*)(Amv + 2860); A1_2 = *(const LAS f32x4*)(Amv + 2864); A1_3 = *(const LAS f32x4*)(Amv + 2868); A1_4 = *(const LAS f32x4*)(Amv + 2872); A1_5 = *(const LAS f32x4*)(Amv + 2876); A1_6 = *(const LAS f32x4*)(Amv + 2880); A1_7 = *(const LAS f32x4*)(Amv + 2884); r1 = RHS[10752 + c]; __builtin_amdgcn_sched_barrier(0); c0 -= A0_0[0] * x[32]; c1 -= A0_0[1] * x[33]; c2 -= A0_0[2] * x[34]; c3 -= A0_0[3] * x[35]; c0 -= A0_1[0] * x[36]; c1 -= A0_1[1] * x[37]; c2 -= A0_1[2] * x[38]; c3 -= A0_1[3] * x[39]; c0 -= A0_2[0] * x[40]; x[41] = (c0 + c1) + (c2 + c3); __builtin_amdgcn_sched_barrier(0);
            A0_0 = *(const LAS f32x4*)(Amv + 2888); A0_1 = *(const LAS f32x4*)(Amv + 2892); A0_2 = *(const LAS f32x4*)(Amv + 2896); __builtin_amdgcn_sched_barrier(0); c0 = r1; c1 = 0.f; c2 = 0.f; c3 = 0.f; c0 -= A1_0[0] * x[0]; c1 -= A1_0[1] * x[1]; c2 -= A1_0[2] * x[2]; c3 -= A1_0[3] * x[3]; c0 -= A1_1[0] * x[4]; c1 -= A1_1[1] * x[5]; c2 -= A1_1[2] * x[6]; c3 -= A1_1[3] * x[7]; c0 -= A1_2[0] * x[8]; c1 -= A1_2[1] * x[9]; c2 -= A1_2[2] * x[10]; c3 -= A1_2[3] * x[11]; c0 -= A1_3[0] * x[12]; c1 -= A1_3[1] * x[13]; c2 -= A1_3[2] * x[14]; c3 -= A1_3[3] * x[15]; c0 -= A1_4[0] * x[16]; c1 -= A1_4[1] * x[17]; c2 -= A1_4[2] * x[18]; c3 -= A1_4[3] * x[19]; c0 -= A1_5[0] * x[20]; c1 -= A1_5[1] * x[21]; c2 -= A1_5[2] * x[22]; c3 -= A1_5[3] * x[23]; c0 -= A1_6[0] * x[24]; c1 -= A1_6[1] * x[25]; c2 -= A1_6[2] * x[26]; c3 -= A1_6[3] * x[27]; c0 -= A1_7[0] * x[28]; c1 -= A1_7[1] * x[29]; c2 -= A1_7[2] * x[30]; c3 -= A1_7[3] * x[31]; __builtin_amdgcn_sched_barrier(0);
            A1_0 = *(const LAS f32x4*)(Amv + 2924); A1_1 = *(const LAS f32x4*)(Amv + 2928); A1_2 = *(const LAS f32x4*)(Amv + 2932); A1_3 = *(const LAS f32x4*)(Amv + 2936); A1_4 = *(const LAS f32x4*)(Amv + 2940); A1_5 = *(const LAS f32x4*)(Amv + 2944); A1_6 = *(const LAS f32x4*)(Amv + 2948); A1_7 = *(const LAS f32x4*)(Amv + 2952); r1 = RHS[11008 + c]; __builtin_amdgcn_sched_barrier(0); c0 -= A0_0[0] * x[32]; c1 -= A0_0[1] * x[33]; c2 -= A0_0[2] * x[34]; c3 -= A0_0[3] * x[35]; c0 -= A0_1[0] * x[36]; c1 -= A0_1[1] * x[37]; c2 -= A0_1[2] * x[38]; c3 -= A0_1[3] * x[39]; c0 -= A0_2[0] * x[40]; c1 -= A0_2[1] * x[41]; x[42] = (c0 + c1) + (c2 + c3); __builtin_amdgcn_sched_barrier(0);
            A0_0 = *(const LAS f32x4*)(Amv + 2956); A0_1 = *(const LAS f32x4*)(Amv + 2960); A0_2 = *(const LAS f32x4*)(Amv + 2964); __builtin_amdgcn_sched_barrier(0); c0 = r1; c1 = 0.f; c2 = 0.f; c3 = 0.f; c0 -= A1_0[0] * x[0]; c1 -= A1_0[1] * x[1]; c2 -= A1_0[2] * x[2]; c3 -= A1_0[3] * x[3]; c0 -= A1_1[0] * x[4]; c1 -= A1_1[1] * x[5]; c2 -= A1_1[2] * x[6]; c3 -= A1_1[3] * x[7]; c0 -= A1_2[0] * x[8]; c1 -= A1_2[1] * x[9]; c2 -= A1_2[2] * x[10]; c3 -= A1_2[3] * x[11]; c0 -= A1_3[0] * x[12]; c1 -= A1_3[1] * x[13]; c2 -= A1_3[2] * x[14]; c3 -= A1_3[3] * x[15]; c0 -= A1_4[0] * x[16]; c1 -= A1_4[1] * x[17]; c2 -= A1_4[2] * x[18]; c3 -= A1_4[3] * x[19]; c0 -= A1_5[0] * x[20]; c1 -= A1_5[1] * x[21]; c2 -= A1_5[2] * x[22]; c3 -= A1_5[3] * x[23]; c0 -= A1_6[0] * x[24]; c1 -= A1_6[1] * x[25]; c2 -= A1_6[2] * x[26]; c3 -= A1_6[3] * x[27]; c0 -= A1_7[0] * x[28]; c1 -= A1_7[1] * x[29]; c2 -= A1_7[2] * x[30]; c3 -= A1_7[3] * x[31]; __builtin_amdgcn_sched_barrier(0);
            A1_0 = *(const LAS f32x4*)(Amv + 2992); A1_1 = *(const LAS f32x4*)(Amv + 2996); A1_2 = *(const LAS f32x4*)(Amv + 3000); A1_3 = *(const LAS f32x4*)(Amv + 3004); A1_4 = *(const LAS f32x4*)(Amv + 3008); A1_5 = *(const LAS f32x4*)(Amv + 3012); A1_6 = *(const LAS f32x4*)(Amv + 3016); A1_7 = *(const LAS f32x4*)(Amv + 3020); r1 = RHS[11264 + c]; __builtin_amdgcn_sched_barrier(0); c0 -= A0_0[0] * x[32]; c1 -= A0_0[1] * x[33]; c2 -= A0_0[2] * x[34]; c3 -= A0_0[3] * x[35]; c0 -= A0_1[0] * x[36]; c1 -= A0_1[1] * x[37]; c2 -= A0_1[2] * x[38]; c3 -= A0_1[3] * x[39]; c0 -= A0_2[0] * x[40]; c1 -= A0_2[1] * x[41]; c2 -= A0_2[2] * x[42]; x[43] = (c0 + c1) + (c2 + c3); __builtin_amdgcn_sched_barrier(0);
            A0_0 = *(const LAS f32x4*)(Amv + 3024); A0_1 = *(const LAS f32x4*)(Amv + 3028); A0_2 = *(const LAS f32x4*)(Amv + 3032); __builtin_amdgcn_sched_barrier(0); c0 = r1; c1 = 0.f; c2 = 0.f; c3 = 0.f; c0 -= A1_0[0] * x[0]; c1 -= A1_0[1] * x[1]; c2 -= A1_0[2] * x[2]; c3 -= A1_0[3] * x[3]; c0 -= A1_1[0] * x[4]; c1 -= A1_1[1] * x[5]; c2 -= A1_1[2] * x[6]; c3 -= A1_1[3] * x[7]; c0 -= A1_2[0] * x[8]; c1 -= A1_2[1] * x[9]; c2 -= A1_2[2] * x[10]; c3 -= A1_2[3] * x[11]; c0 -= A1_3[0] * x[12]; c1 -= A1_3[1] * x[13]; c2 -= A1_3[2] * x[14]; c3 -= A1_3[3] * x[15]; c0 -= A1_4[0] * x[16]; c1 -= A1_4[1] * x[17]; c2 -= A1_4[2] * x[18]; c3 -= A1_4[3] * x[19]; c0 -= A1_5[0] * x[20]; c1 -= A1_5[1] * x[21]; c2 -= A1_5[2] * x[22]; c3 -= A1_5[3] * x[23]; c0 -= A1_6[0] * x[24]; c1 -= A1_6[1] * x[25]; c2 -= A1_6[2] * x[26]; c3 -= A1_6[3] * x[27]; c0 -= A1_7[0] * x[28]; c1 -= A1_7[1] * x[29]; c2 -= A1_7[2] * x[30]; c3 -= A1_7[3] * x[31]; __builtin_amdgcn_sched_barrier(0);
            A1_0 = *(const LAS f32x4*)(Amv + 3060); A1_1 = *(const LAS f32x4*)(Amv + 3064); A1_2 = *(const LAS f32x4*)(Amv + 3068); A1_3 = *(const LAS f32x4*)(Amv + 3072); A1_4 = *(const LAS f32x4*)(Amv + 3076); A1_5 = *(const LAS f32x4*)(Amv + 3080); A1_6 = *(const LAS f32x4*)(Amv + 3084); A1_7 = *(const LAS f32x4*)(Amv + 3088); r1 = RHS[11520 + c]; __builtin_amdgcn_sched_barrier(0); c0 -= A0_0[0] * x[32]; c1 -= A0_0[1] * x[33]; c2 -= A0_0[2] * x[34]; c3 -= A0_0[3] * x[35]; c0 -= A0_1[0] * x[36]; c1 -= A0_1[1] * x[37]; c2 -= A0_1[2] * x[38]; c3 -= A0_1[3] * x[39]; c0 -= A0_2[0] * x[40]; c1 -= A0_2[1] * x[41]; c2 -= A0_2[2] * x[42]; c3 -= A0_2[3] * x[43]; x[44] = (c0 + c1) + (c2 + c3); __builtin_amdgcn_sched_barrier(0);
            A0_0 = *(const LAS f32x4*)(Amv + 3092); A0_1 = *(const LAS f32x4*)(Amv + 3096); A0_2 = *(const LAS f32x4*)(Amv + 3100); A0_3 = *(const LAS f32x4*)(Amv + 3104); __builtin_amdgcn_sched_barrier(0); c0 = r1; c1 = 0.f; c2 = 0.f; c3 = 0.f; c0 -= A1_0[0] * x[0]; c1 -= A1_0[1] * x[1]; c2 -= A1_0[2] * x[2]; c3 -= A1_0[3] * x[3]; c0 -= A1_1[0] * x[4]; c1 -= A1_1[1] * x[5]; c2 -= A1_1[2] * x[6]; c3 -= A1_1[3] * x[7]; c0 -= A1_2[0] * x[8]; c1 -= A1_2[1] * x[9]; c2 -= A1_2[2] * x[10]; c3 -= A1_2[3] * x[11]; c0 -= A1_3[0] * x[12]; c1 -= A1_3[1] * x[13]; c2 -= A1_3[2] * x[14]; c3 -= A1_3[3] * x[15]; c0 -= A1_4[0] * x[16]; c1 -= A1_4[1] * x[17]; c2 -= A1_4[2] * x[18]; c3 -= A1_4[3] * x[19]; c0 -= A1_5[0] * x[20]; c1 -= A1_5[1] * x[21]; c2 -= A1_5[2] * x[22]; c3 -= A1_5[3] * x[23]; c0 -= A1_6[0] * x[24]; c1 -= A1_6[1] * x[25]; c2 -= A1_6[2] * x[26]; c3 -= A1_6[3] * x[27]; c0 -= A1_7[0] * x[28]; c1 -= A1_7[1] * x[29]; c2 -= A1_7[2] * x[30]; c3 -= A1_7[3] * x[31]; __builtin_amdgcn_sched_barrier(0);
            A1_0 = *(const LAS f32x4*)(Amv + 3128); A1_1 = *(const LAS f32x4*)(Amv + 3132); A1_2 = *(const LAS f32x4*)(Amv + 3136); A1_3 = *(const LAS f32x4*)(Amv + 3140); A1_4 = *(const LAS f32x4*)(Amv + 3144); A1_5 = *(const LAS f32x4*)(Amv + 3148); A1_6 = *(const LAS f32x4*)(Amv + 3152); A1_7 = *(const LAS f32x4*)(Amv + 3156); r1 = RHS[11776 + c]; __builtin_amdgcn_sched_barrier(0); c0 -= A0_0[0] * x[32]; c1 -= A0_0[1] * x[33]; c2 -= A0_0[2] * x[34]; c3 -= A0_0[3] * x[35]; c0 -= A0_1[0] * x[36]; c1 -= A0_1[1] * x[37]; c2 -= A0_1[2] * x[38]; c3 -= A0_1[3] * x[39]; c0 -= A0_2[0] * x[40]; c1 -= A0_2[1] * x[41]; c2 -= A0_2[2] * x[42]; c3 -= A0_2[3] * x[43]; c0 -= A0_3[0] * x[44]; x[45] = (c0 + c1) + (c2 + c3); __builtin_amdgcn_sched_barrier(0);
            A0_0 = *(const LAS f32x4*)(Amv + 3160); A0_1 = *(const LAS f32x4*)(Amv + 3164); A0_2 = *(const LAS f32x4*)(Amv + 3168); A0_3 = *(const LAS f32x4*)(Amv + 3172); __builtin_amdgcn_sched_barrier(0); c0 = r1; c1 = 0.f; c2 = 0.f; c3 = 0.f; c0 -= A1_0[0] * x[0]; c1 -= A1_0[1] * x[1]; c2 -= A1_0[2] * x[2]; c3 -= A1_0[3] * x[3]; c0 -= A1_1[0] * x[4]; c1 -= A1_1[1] * x[5]; c2 -= A1_1[2] * x[6]; c3 -= A1_1[3] * x[7]; c0 -= A1_2[0] * x[8]; c1 -= A1_2[1] * x[9]; c2 -= A1_2[2] * x[10]; c3 -= A1_2[3] * x[11]; c0 -= A1_3[0] * x[12]; c1 -= A1_3[1] * x[13]; c2 -= A1_3[2] * x[14]; c3 -= A1_3[3] * x[15]; c0 -= A1_4[0] * x[16]; c1 -= A1_4[1] * x[17]; c2 -= A1_4[2] * x[18]; c3 -= A1_4[3] * x[19]; c0 -= A1_5[0] * x[20]; c1 -= A1_5[1] * x[21]; c2 -= A1_5[2] * x[22]; c3 -= A1_5[3] * x[23]; c0 -= A1_6[0] * x[24]; c1 -= A1_6[1] * x[25]; c2 -= A1_6[2] * x[26]; c3 -= A1_6[3] * x[27]; c0 -= A1_7[0] * x[28]; c1 -= A1_7[1] * x[29]; c2 -= A1_7[2] * x[30]; c3 -= A1_7[3] * x[31]; __builtin_amdgcn_sched_barrier(0);
            A1_0 = *(const LAS f32x4*)(Amv + 3196); A1_1 = *(const LAS f32x4*)(Amv + 3200); A1_2 = *(const LAS f32x4*)(Amv + 3204); A1_3 = *(const LAS f32x4*)(Amv + 3208); A1_4 = *(const LAS f32x4*)(Amv + 3212); A1_5 = *(const LAS f32x4*)(Amv + 3216); A1_6 = *(const LAS f32x4*)(Amv + 3220); A1_7 = *(const LAS f32x4*)(Amv + 3224); r1 = RHS[12032 + c]; __builtin_amdgcn_sched_barrier(0); c0 -= A0_0[0] * x[32]; c1 -= A0_0[1] * x[33]; c2 -= A0_0[2] * x[34]; c3 -= A0_0[3] * x[35]; c0 -= A0_1[0] * x[36]; c1 -= A0_1[1] * x[37]; c2 -= A0_1[2] * x[38]; c3 -= A0_1[3] * x[39]; c0 -= A0_2[0] * x[40]; c1 -= A0_2[1] * x[41]; c2 -= A0_2[2] * x[42]; c3 -= A0_2[3] * x[43]; c0 -= A0_3[0] * x[44]; c1 -= A0_3[1] * x[45]; x[46] = (c0 + c1) + (c2 + c3); __builtin_amdgcn_sched_barrier(0);
            A0_0 = *(const LAS f32x4*)(Amv + 3228); A0_1 = *(const LAS f32x4*)(Amv + 3232); A0_2 = *(const LAS f32x4*)(Amv + 3236); A0_3 = *(const LAS f32x4*)(Amv + 3240); __builtin_amdgcn_sched_barrier(0); c0 = r1; c1 = 0.f; c2 = 0.f; c3 = 0.f; c0 -= A1_0[0] * x[0]; c1 -= A1_0[1] * x[1]; c2 -= A1_0[2] * x[2]; c3 -= A1_0[3] * x[3]; c0 -= A1_1[0] * x[4]; c1 -= A1_1[1] * x[5]; c2 -= A1_1[2] * x[6]; c3 -= A1_1[3] * x[7]; c0 -= A1_2[0] * x[8]; c1 -= A1_2[1] * x[9]; c2 -= A1_2[2] * x[10]; c3 -= A1_2[3] * x[11]; c0 -= A1_3[0] * x[12]; c1 -= A1_3[1] * x[13]; c2 -= A1_3[2] * x[14]; c3 -= A1_3[3] * x[15]; c0 -= A1_4[0] * x[16]; c1 -= A1_4[1] * x[17]; c2 -= A1_4[2] * x[18]; c3 -= A1_4[3] * x[19]; c0 -= A1_5[0] * x[20]; c1 -= A1_5[1] * x[21]; c2 -= A1_5[2] * x[22]; c3 -= A1_5[3] * x[23]; c0 -= A1_6[0] * x[24]; c1 -= A1_6[1] * x[25]; c2 -= A1_6[2] * x[26]; c3 -= A1_6[3] * x[27]; c0 -= A1_7[0] * x[28]; c1 -= A1_7[1] * x[29]; c2 -= A1_7[2] * x[30]; c3 -= A1_7[3] * x[31]; __builtin_amdgcn_sched_barrier(0);
            A1_0 = *(const LAS f32x4*)(Amv + 3264); A1_1 = *(const LAS f32x4*)(Amv + 3268); A1_2 = *(const LAS f32x4*)(Amv + 3272); A1_3 = *(const LAS f32x4*)(Amv + 3276); A1_4 = *(const LAS f32x4*)(Amv + 3280); A1_5 = *(const LAS f32x4*)(Amv + 3284); A1_6 = *(const LAS f32x4*)(Amv + 3288); A1_7 = *(const LAS f32x4*)(Amv + 3292); r1 = RHS[12288 + c]; __builtin_amdgcn_sched_barrier(0); c0 -= A0_0[0] * x[32]; c1 -= A0_0[1] * x[33]; c2 -= A0_0[2] * x[34]; c3 -= A0_0[3] * x[35]; c0 -= A0_1[0] * x[36]; c1 -= A0_1[1] * x[37]; c2 -= A0_1[2] * x[38]; c3 -= A0_1[3] * x[39]; c0 -= A0_2[0] * x[40]; c1 -= A0_2[1] * x[41]; c2 -= A0_2[2] * x[42]; c3 -= A0_2[3] * x[43]; c0 -= A0_3[0] * x[44]; c1 -= A0_3[1] * x[45]; c2 -= A0_3[2] * x[46]; x[47] = (c0 + c1) + (c2 + c3); __builtin_amdgcn_sched_barrier(0);
            A0_0 = *(const LAS f32x4*)(Amv + 3296); A0_1 = *(const LAS f32x4*)(Amv + 3300); A0_2 = *(const LAS f32x4*)(Amv + 3304); A0_3 = *(const LAS f32x4*)(Amv + 3308); __builtin_amdgcn_sched_barrier(0); c0 = r1; c1 = 0.f; c2 = 0.f; c3 = 0.f; c0 -= A1_0[0] * x[0]; c1 -= A1_0[1] * x[1]; c2 -= A1_0[2] * x[2]; c3 -= A1_0[3] * x[3]; c0 -= A1_1[0] * x[4]; c1 -= A1_1[1] * x[5]; c2 -= A1_1[2] * x[6]; c3 -= A1_1[3] * x[7]; c0 -= A1_2[0] * x[8]; c1 -= A1_2[1] * x[9]; c2 -= A1_2[2] * x[10]; c3 -= A1_2[3] * x[11]; c0 -= A1_3[0] * x[12]; c1 -= A1_3[1] * x[13]; c2 -= A1_3[2] * x[14]; c3 -= A1_3[3] * x[15]; c0 -= A1_4[0] * x[16]; c1 -= A1_4[1] * x[17]; c2 -= A1_4[2] * x[18]; c3 -= A1_4[3] * x[19]; c0 -= A1_5[0] * x[20]; c1 -= A1_5[1] * x[21]; c2 -= A1_5[2] * x[22]; c3 -= A1_5[3] * x[23]; c0 -= A1_6[0] * x[24]; c1 -= A1_6[1] * x[25]; c2 -= A1_6[2] * x[26]; c3 -= A1_6[3] * x[27]; c0 -= A1_7[0] * x[28]; c1 -= A1_7[1] * x[29]; c2 -= A1_7[2] * x[30]; c3 -= A1_7[3] * x[31]; __builtin_amdgcn_sched_barrier(0);
            A1_0 = *(const LAS f32x4*)(Amv + 3332); A1_1 = *(const LAS f32x4*)(Amv + 3336); A1_2 = *(const LAS f32x4*)(Amv + 3340); A1_3 = *(const LAS f32x4*)(Amv + 3344); A1_4 = *(const LAS f32x4*)(Amv + 3348); A1_5 = *(const LAS f32x4*)(Amv + 3352); A1_6 = *(const LAS f32x4*)(Amv + 3356); A1_7 = *(const LAS f32x4*)(Amv + 3360); r1 = RHS[12544 + c]; __builtin_amdgcn_sched_barrier(0); c0 -= A0_0[0] * x[32]; c1 -= A0_0[1] * x[33]; c2 -= A0_0[2] * x[34]; c3 -= A0_0[3] * x[35]; c0 -= A0_1[0] * x[36]; c1 -= A0_1[1] * x[37]; c2 -= A0_1[2] * x[38]; c3 -= A0_1[3] * x[39]; c0 -= A0_2[0] * x[40]; c1 -= A0_2[1] * x[41]; c2 -= A0_2[2] * x[42]; c3 -= A0_2[3] * x[43]; c0 -= A0_3[0] * x[44]; c1 -= A0_3[1] * x[45]; c2 -= A0_3[2] * x[46]; c3 -= A0_3[3] * x[47]; x[48] = (c0 + c1) + (c2 + c3); __builtin_amdgcn_sched_barrier(0);
            A0_0 = *(const LAS f32x4*)(Amv + 3364); A0_1 = *(const LAS f32x4*)(Amv + 3368); A0_2 = *(const LAS f32x4*)(Amv + 3372); A0_3 = *(const LAS f32x4*)(Amv + 3376); A0_4 = *(const LAS f32x4*)(Amv + 3380); __builtin_amdgcn_sched_barrier(0); c0 = r1; c1 = 0.f; c2 = 0.f; c3 = 0.f; c0 -= A1_0[0] * x[0]; c1 -= A1_0[1] * x[1]; c2 -= A1_0[2] * x[2]; c3 -= A1_0[3] * x[3]; c0 -= A1_1[0] * x[4]; c1 -= A1_1[1] * x[5]; c2 -= A1_1[2] * x[6]; c3 -= A1_1[3] * x[7]; c0 -= A1_2[0] * x[8]; c1 -= A1_2[1] * x[9]; c2 -= A1_2[2] * x[10]; c3 -= A1_2[3] * x[11]; c0 -= A1_3[0] * x[12]; c1 -= A1_3[1] * x[13]; c2 -= A1_3[2] * x[14]; c3 -= A1_3[3] * x[15]; c0 -= A1_4[0] * x[16]; c1 -= A1_4[1] * x[17]; c2 -= A1_4[2] * x[18]; c3 -= A1_4[3] * x[19]; c0 -= A1_5[0] * x[20]; c1 -= A1_5[1] * x[21]; c2 -= A1_5[2] * x[22]; c3 -= A1_5[3] * x[23]; c0 -= A1_6[0] * x[24]; c1 -= A1_6[1] * x[25]; c2 -= A1_6[2] * x[26]; c3 -= A1_6[3] * x[27]; c0 -= A1_7[0] * x[28]; c1 -= A1_7[1] * x[29]; c2 -= A1_7[2] * x[30]; c3 -= A1_7[3] * x[31]; __builtin_amdgcn_sched_barrier(0);
            A1_0 = *(const LAS f32x4*)(Amv + 3400); A1_1 = *(const LAS f32x4*)(Amv + 3404); A1_2 = *(const LAS f32x4*)(Amv + 3408); A1_3 = *(const LAS f32x4*)(Amv + 3412); A1_4 = *(const LAS f32x4*)(Amv + 3416); A1_5 = *(const LAS f32x4*)(Amv + 3420); A1_6 = *(const LAS f32x4*)(Amv + 3424); A1_7 = *(const LAS f32x4*)(Amv + 3428); r1 = RHS[12800 + c]; __builtin_amdgcn_sched_barrier(0); c0 -= A0_0[0] * x[32]; c1 -= A0_0[1] * x[33]; c2 -= A0_0[2] * x[34]; c3 -= A0_0[3] * x[35]; c0 -= A0_1[0] * x[36]; c1 -= A0_1[1] * x[37]; c2 -= A0_1[2] * x[38]; c3 -= A0_1[3] * x[39]; c0 -= A0_2[0] * x[40]; c1 -= A0_2[1] * x[41]; c2 -= A0_2[2] * x[42]; c3 -= A0_2[3] * x[43]; c0 -= A0_3[0] * x[44]; c1 -= A0_3[1] * x[45]; c2 -= A0_3[2] * x[46]; c3 -= A0_3[3] * x[47]; c0 -= A0_4[0] * x[48]; x[49] = (c0 + c1) + (c2 + c3); __builtin_amdgcn_sched_barrier(0);
            A0_0 = *(const LAS f32x4*)(Amv + 3432); A0_1 = *(const LAS f32x4*)(Amv + 3436); A0_2 = *(const LAS f32x4*)(Amv + 3440); A0_3 = *(const LAS f32x4*)(Amv + 3444); A0_4 = *(const LAS f32x4*)(Amv + 3448); __builtin_amdgcn_sched_barrier(0); c0 = r1; c1 = 0.f; c2 = 0.f; c3 = 0.f; c0 -= A1_0[0] * x[0]; c1 -= A1_0[1] * x[1]; c2 -= A1_0[2] * x[2]; c3 -= A1_0[3] * x[3]; c0 -= A1_1[0] * x[4]; c1 -= A1_1[1] * x[5]; c2 -= A1_1[2] * x[6]; c3 -= A1_1[3] * x[7]; c0 -= A1_2[0] * x[8]; c1 -= A1_2[1] * x[9]; c2 -= A1_2[2] * x[10]; c3 -= A1_2[3] * x[11]; c0 -= A1_3[0] * x[12]; c1 -= A1_3[1] * x[13]; c2 -= A1_3[2] * x[14]; c3 -= A1_3[3] * x[15]; c0 -= A1_4[0] * x[16]; c1 -= A1_4[1] * x[17]; c2 -= A1_4[2] * x[18]; c3 -= A1_4[3] * x[19]; c0 -= A1_5[0] * x[20]; c1 -= A1_5[1] * x[21]; c2 -= A1_5[2] * x[22]; c3 -= A1_5[3] * x[23]; c0 -= A1_6[0] * x[24]; c1 -= A1_6[1] * x[25]; c2 -= A1_6[2] * x[26]; c3 -= A1_6[3] * x[27]; c0 -= A1_7[0] * x[28]; c1 -= A1_7[1] * x[29]; c2 -= A1_7[2] * x[30]; c3 -= A1_7[3] * x[31]; __builtin_amdgcn_sched_barrier(0);
            A1_0 = *(const LAS f32x4*)(Amv + 3468); A1_1 = *(const LAS f32x4*)(Amv + 3472); A1_2 = *(const LAS f32x4*)(Amv + 3476); A1_3 = *(const LAS f32x4*)(Amv + 3480); A1_4 = *(const LAS f32x4*)(Amv + 3484); A1_5 = *(const LAS f32x4*)(Amv + 3488); A1_6 = *(const LAS f32x4*)(Amv + 3492); A1_7 = *(const LAS f32x4*)(Amv + 3496); r1 = RHS[13056 + c]; __builtin_amdgcn_sched_barrier(0); c0 -= A0_0[0] * x[32]; c1 -= A0_0[1] * x[33]; c2 -= A0_0[2] * x[34]; c3 -= A0_0[3] * x[35]; c0 -= A0_1[0] * x[36]; c1 -= A0_1[1] * x[37]; c2 -= A0_1[2] * x[38]; c3 -= A0_1[3] * x[39]; c0 -= A0_2[0] * x[40]; c1 -= A0_2[1] * x[41]; c2 -= A0_2[2] * x[42]; c3 -= A0_2[3] * x[43]; c0 -= A0_3[0] * x[44]; c1 -= A0_3[1] * x[45]; c2 -= A0_3[2] * x[46]; c3 -= A0_3[3] * x[47]; c0 -= A0_4[0] * x[48]; c1 -= A0_4[1] * x[49]; x[50] = (c0 + c1) + (c2 + c3); __builtin_amdgcn_sched_barrier(0);
            A0_0 = *(const LAS f32x4*)(Amv + 3500); A0_1 = *(const LAS f32x4*)(Amv + 3504); A0_2 = *(const LAS f32x4*)(Amv + 3508); A0_3 = *(const LAS f32x4*)(Amv + 3512); A0_4 = *(const LAS f32x4*)(Amv + 3516); __builtin_amdgcn_sched_barrier(0); c0 = r1; c1 = 0.f; c2 = 0.f; c3 = 0.f; c0 -= A1_0[0] * x[0]; c1 -= A1_0[1] * x[1]; c2 -= A1_0[2] * x[2]; c3 -= A1_0[3] * x[3]; c0 -= A1_1[0] * x[4]; c1 -= A1_1[1] * x[5]; c2 -= A1_1[2] * x[6]; c3 -= A1_1[3] * x[7]; c0 -= A1_2[0] * x[8]; c1 -= A1_2[1] * x[9]; c2 -= A1_2[2] * x[10]; c3 -= A1_2[3] * x[11]; c0 -= A1_3[0] * x[12]; c1 -= A1_3[1] * x[13]; c2 -= A1_3[2] * x[14]; c3 -= A1_3[3] * x[15]; c0 -= A1_4[0] * x[16]; c1 -= A1_4[1] * x[17]; c2 -= A1_4[2] * x[18]; c3 -= A1_4[3] * x[19]; c0 -= A1_5[0] * x[20]; c1 -= A1_5[1] * x[21]; c2 -= A1_5[2] * x[22]; c3 -= A1_5[3] * x[23]; c0 -= A1_6[0] * x[24]; c1 -= A1_6[1] * x[25]; c2 -= A1_6[2] * x[26]; c3 -= A1_6[3] * x[27]; c0 -= A1_7[0] * x[28]; c1 -= A1_7[1] * x[29]; c2 -= A1_7[2] * x[30]; c3 -= A1_7[3] * x[31]; __builtin_amdgcn_sched_barrier(0);
            A1_0 = *(const LAS f32x4*)(Amv + 3536); A1_1 = *(const LAS f32x4*)(Amv + 3540); A1_2 = *(const LAS f32x4*)(Amv + 3544); A1_3 = *(const LAS f32x4*)(Amv + 3548); A1_4 = *(const LAS f32x4*)(Amv + 3552); A1_5 = *(const LAS f32x4*)(Amv + 3556); A1_6 = *(const LAS f32x4*)(Amv + 3560); A1_7 = *(const LAS f32x4*)(Amv + 3564); r1 = RHS[13312 + c]; __builtin_amdgcn_sched_barrier(0); c0 -= A0_0[0] * x[32]; c1 -= A0_0[1] * x[33]; c2 -= A0_0[2] * x[34]; c3 -= A0_0[3] * x[35]; c0 -= A0_1[0] * x[36]; c1 -= A0_1[1] * x[37]; c2 -= A0_1[2] * x[38]; c3 -= A0_1[3] * x[39]; c0 -= A0_2[0] * x[40]; c1 -= A0_2[1] * x[41]; c2 -= A0_2[2] * x[42]; c3 -= A0_2[3] * x[43]; c0 -= A0_3[0] * x[44]; c1 -= A0_3[1] * x[45]; c2 -= A0_3[2] * x[46]; c3 -= A0_3[3] * x[47]; c0 -= A0_4[0] * x[48]; c1 -= A0_4[1] * x[49]; c2 -= A0_4[2] * x[50]; x[51] = (c0 + c1) + (c2 + c3); __builtin_amdgcn_sched_barrier(0);
            A0_0 = *(const LAS f32x4*)(Amv + 3568); A0_1 = *(const LAS f32x4*)(Amv + 3572); A0_2 = *(const LAS f32x4*)(Amv + 3576); A0_3 = *(const LAS f32x4*)(Amv + 3580); A0_4 = *(const LAS f32x4*)(Amv + 3584); __builtin_amdgcn_sched_barrier(0); c0 = r1; c1 = 0.f; c2 = 0.f; c3 = 0.f; c0 -= A1_0[0] * x[0]; c1 -= A1_0[1] * x[1]; c2 -= A1_0[2] * x[2]; c3 -= A1_0[3] * x[3]; c0 -= A1_1[0] * x[4]; c1 -= A1_1[1] * x[5]; c2 -= A1_1[2] * x[6]; c3 -= A1_1[3] * x[7]; c0 -= A1_2[0] * x[8]; c1 -= A1_2[1] * x[9]; c2 -= A1_2[2] * x[10]; c3 -= A1_2[3] * x[11]; c0 -= A1_3[0] * x[12]; c1 -= A1_3[1] * x[13]; c2 -= A1_3[2] * x[14]; c3 -= A1_3[3] * x[15]; c0 -= A1_4[0] * x[16]; c1 -= A1_4[1] * x[17]; c2 -= A1_4[2] * x[18]; c3 -= A1_4[3] * x[19]; c0 -= A1_5[0] * x[20]; c1 -= A1_5[1] * x[21]; c2 -= A1_5[2] * x[22]; c3 -= A1_5[3] * x[23]; c0 -= A1_6[0] * x[24]; c1 -= A1_6[1] * x[25]; c2 -= A1_6[2] * x[26]; c3 -= A1_6[3] * x[27]; c0 -= A1_7[0] * x[28]; c1 -= A1_7[1] * x[29]; c2 -= A1_7[2] * x[30]; c3 -= A1_7[3] * x[31]; __builtin_amdgcn_sched_barrier(0);
            A1_0 = *(const LAS f32x4*)(Amv + 3604); A1_1 = *(const LAS f32x4*)(Amv + 3608); A1_2 = *(const LAS f32x4*)(Amv + 3612); A1_3 = *(const LAS f32x4*)(Amv + 3616); A1_4 = *(const LAS f32x4*)(Amv + 3620); A1_5 = *(const LAS f32x4*)(Amv + 3624); A1_6 = *(const LAS f32x4*)(Amv + 3628); A1_7 = *(const LAS f32x4*)(Amv + 3632); r1 = RHS[13568 + c]; __builtin_amdgcn_sched_barrier(0); c0 -= A0_0[0] * x[32]; c1 -= A0_0[1] * x[33]; c2 -= A0_0[2] * x[34]; c3 -= A0_0[3] * x[35]; c0 -= A0_1[0] * x[36]; c1 -= A0_1[1] * x[37]; c2 -= A0_1[2] * x[38]; c3 -= A0_1[3] * x[39]; c0 -= A0_2[0] * x[40]; c1 -= A0_2[1] * x[41]; c2 -= A0_2[2] * x[42]; c3 -= A0_2[3] * x[43]; c0 -= A0_3[0] * x[44]; c1 -= A0_3[1] * x[45]; c2 -= A0_3[2] * x[46]; c3 -= A0_3[3] * x[47]; c0 -= A0_4[0] * x[48]; c1 -= A0_4[1] * x[49]; c2 -= A0_4[2] * x[50]; c3 -= A0_4[3] * x[51]; x[52] = (c0 + c1) + (c2 + c3); __builtin_amdgcn_sched_barrier(0);
            A0_0 = *(const LAS f32x4*)(Amv + 3636); A0_1 = *(const LAS f32x4*)(Amv + 3640); A0_2 = *(const LAS f32x4*)(Amv + 3644); A0_3 = *(const LAS f32x4*)(Amv + 3648); A0_4 = *(const LAS f32x4*)(Amv + 3652); A0_5 = *(const LAS f32x4*)(Amv + 3656); __builtin_amdgcn_sched_barrier(0); c0 = r1; c1 = 0.f; c2 = 0.f; c3 = 0.f; c0 -= A1_0[0] * x[0]; c1 -= A1_0[1] * x[1]; c2 -= A1_0[2] * x[2]; c3 -= A1_0[3] * x[3]; c0 -= A1_1[0] * x[4]; c1 -= A1_1[1] * x[5]; c2 -= A1_1[2] * x[6]; c3 -= A1_1[3] * x[7]; c0 -= A1_2[0] * x[8]; c1 -= A1_2[1] * x[9]; c2 -= A1_2[2] * x[10]; c3 -= A1_2[3] * x[11]; c0 -= A1_3[0] * x[12]; c1 -= A1_3[1] * x[13]; c2 -= A1_3[2] * x[14]; c3 -= A1_3[3] * x[15]; c0 -= A1_4[0] * x[16]; c1 -= A1_4[1] * x[17]; c2 -= A1_4[2] * x[18]; c3 -= A1_4[3] * x[19]; c0 -= A1_5[0] * x[20]; c1 -= A1_5[1] * x[21]; c2 -= A1_5[2] * x[22]; c3 -= A1_5[3] * x[23]; c0 -= A1_6[0] * x[24]; c1 -= A1_6[1] * x[25]; c2 -= A1_6[2] * x[26]; c3 -= A1_6[3] * x[27]; c0 -= A1_7[0] * x[28]; c1 -= A1_7[1] * x[29]; c2 -= A1_7[2] * x[30]; c3 -= A1_7[3] * x[31]; __builtin_amdgcn_sched_barrier(0);
            A1_0 = *(const LAS f32x4*)(Amv + 3672); A1_1 = *(const LAS f32x4*)(Amv + 3676); A1_2 = *(const LAS f32x4*)(Amv + 3680); A1_3 = *(const LAS f32x4*)(Amv + 3684); A1_4 = *(const LAS f32x4*)(Amv + 3688); A1_5 = *(const LAS f32x4*)(Amv + 3692); A1_6 = *(const LAS f32x4*)(Amv + 3696); A1_7 = *(const LAS f32x4*)(Amv + 3700); r1 = RHS[13824 + c]; __builtin_amdgcn_sched_barrier(0); c0 -= A0_0[0] * x[32]; c1 -= A0_0[1] * x[33]; c2 -= A0_0[2] * x[34]; c3 -= A0_0[3] * x[35]; c0 -= A0_1[0] * x[36]; c1 -= A0_1[1] * x[37]; c2 -= A0_1[2] * x[38]; c3 -= A0_1[3] * x[39]; c0 -= A0_2[0] * x[40]; c1 -= A0_2[1] * x[41]; c2 -= A0_2[2] * x[42]; c3 -= A0_2[3] * x[43]; c0 -= A0_3[0] * x[44]; c1 -= A0_3[1] * x[45]; c2 -= A0_3[2] * x[46]; c3 -= A0_3[3] * x[47]; c0 -= A0_4[0] * x[48]; c1 -= A0_4[1] * x[49]; c2 -= A0_4[2] * x[50]; c3 -= A0_4[3] * x[51]; c0 -= A0_5[0] * x[52]; x[53] = (c0 + c1) + (c2 + c3); __builtin_amdgcn_sched_barrier(0);
            A0_0 = *(const LAS f32x4*)(Amv + 3704); A0_1 = *(const LAS f32x4*)(Amv + 3708); A0_2 = *(const LAS f32x4*)(Amv + 3712); A0_3 = *(const LAS f32x4*)(Amv + 3716); A0_4 = *(const LAS f32x4*)(Amv + 3720); A0_5 = *(const LAS f32x4*)(Amv + 3724); __builtin_amdgcn_sched_barrier(0); c0 = r1; c1 = 0.f; c2 = 0.f; c3 = 0.f; c0 -= A1_0[0] * x[0]; c1 -= A1_0[1] * x[1]; c2 -= A1_0[2] * x[2]; c3 -= A1_0[3] * x[3]; c0 -= A1_1[0] * x[4]; c1 -= A1_1[1] * x[5]; c2 -= A1_1[2] * x[6]; c3 -= A1_1[3] * x[7]; c0 -= A1_2[0] * x[8]; c1 -= A1_2[1] * x[9]; c2 -= A1_2[2] * x[10]; c3 -= A1_2[3] * x[11]; c0 -= A1_3[0] * x[12]; c1 -= A1_3[1] * x[13]; c2 -= A1_3[2] * x[14]; c3 -= A1_3[3] * x[15]; c0 -= A1_4[0] * x[16]; c1 -= A1_4[1] * x[17]; c2 -= A1_4[2] * x[18]; c3 -= A1_4[3] * x[19]; c0 -= A1_5[0] * x[20]; c1 -= A1_5[1] * x[21]; c2 -= A1_5[2] * x[22]; c3 -= A1_5[3] * x[23]; c0 -= A1_6[0] * x[24]; c1 -= A1_6[1] * x[25]; c2 -= A1_6[2] * x[26]; c3 -= A1_6[3] * x[27]; c0 -= A1_7[0] * x[28]; c1 -= A1_7[1] * x[29]; c2 -= A1_7[2] * x[30]; c3 -= A1_7[3] * x[31]; __builtin_amdgcn_sched_barrier(0);
            A1_0 = *(const LAS f32x4*)(Amv + 3740); A1_1 = *(const LAS f32x4*)(Amv + 3744); A1_2 = *(const LAS f32x4*)(Amv + 3748); A1_3 = *(const LAS f32x4*)(Amv + 3752); A1_4 = *(const LAS f32x4*)(Amv + 3756); A1_5 = *(const LAS f32x4*)(Amv + 3760); A1_6 = *(const LAS f32x4*)(Amv + 3764); A1_7 = *(const LAS f32x4*)(Amv + 3768); r1 = RHS[14080 + c]; __builtin_amdgcn_sched_barrier(0); c0 -= A0_0[0] * x[32]; c1 -= A0_0[1] * x[33]; c2 -= A0_0[2] * x[34]; c3 -= A0_0[3] * x[35]; c0 -= A0_1[0] * x[36]; c1 -= A0_1[1] * x[37]; c2 -= A0_1[2] * x[38]; c3 -= A0_1[3] * x[39]; c0 -= A0_2[0] * x[40]; c1 -= A0_2[1] * x[41]; c2 -= A0_2[2] * x[42]; c3 -= A0_2[3] * x[43]; c0 -= A0_3[0] * x[44]; c1 -= A0_3[1] * x[45]; c2 -= A0_3[2] * x[46]; c3 -= A0_3[3] * x[47]; c0 -= A0_4[0] * x[48]; c1 -= A0_4[1] * x[49]; c2 -= A0_4[2] * x[50]; c3 -= A0_4[3] * x[51]; c0 -= A0_5[0] * x[52]; c1 -= A0_5[1] * x[53]; x[54] = (c0 + c1) + (c2 + c3); __builtin_amdgcn_sched_barrier(0);
            A0_0 = *(const LAS f32x4*)(Amv + 3772); A0_1 = *(const LAS f32x4*)(Amv + 3776); A0_2 = *(const LAS f32x4*)(Amv + 3780); A0_3 = *(const LAS f32x4*)(Amv + 3784); A0_4 = *(const LAS f32x4*)(Amv + 3788); A0_5 = *(const LAS f32x4*)(Amv + 3792); __builtin_amdgcn_sched_barrier(0); c0 = r1; c1 = 0.f; c2 = 0.f; c3 = 0.f; c0 -= A1_0[0] * x[0]; c1 -= A1_0[1] * x[1]; c2 -= A1_0[2] * x[2]; c3 -= A1_0[3] * x[3]; c0 -= A1_1[0] * x[4]; c1 -= A1_1[1] * x[5]; c2 -= A1_1[2] * x[6]; c3 -= A1_1[3] * x[7]; c0 -= A1_2[0] * x[8]; c1 -= A1_2[1] * x[9]; c2 -= A1_2[2] * x[10]; c3 -= A1_2[3] * x[11]; c0 -= A1_3[0] * x[12]; c1 -= A1_3[1] * x[13]; c2 -= A1_3[2] * x[14]; c3 -= A1_3[3] * x[15]; c0 -= A1_4[0] * x[16]; c1 -= A1_4[1] * x[17]; c2 -= A1_4[2] * x[18]; c3 -= A1_4[3] * x[19]; c0 -= A1_5[0] * x[20]; c1 -= A1_5[1] * x[21]; c2 -= A1_5[2] * x[22]; c3 -= A1_5[3] * x[23]; c0 -= A1_6[0] * x[24]; c1 -= A1_6[1] * x[25]; c2 -= A1_6[2] * x[26]; c3 -= A1_6[3] * x[27]; c0 -= A1_7[0] * x[28]; c1 -= A1_7[1] * x[29]; c2 -= A1_7[2] * x[30]; c3 -= A1_7[3] * x[31]; __builtin_amdgcn_sched_barrier(0);
            A1_0 = *(const LAS f32x4*)(Amv + 3808); A1_1 = *(const LAS f32x4*)(Amv + 3812); A1_2 = *(const LAS f32x4*)(Amv + 3816); A1_3 = *(const LAS f32x4*)(Amv + 3820); A1_4 = *(const LAS f32x4*)(Amv + 3824); A1_5 = *(const LAS f32x4*)(Amv + 3828); A1_6 = *(const LAS f32x4*)(Amv + 3832); A1_7 = *(const LAS f32x4*)(Amv + 3836); r1 = RHS[14336 + c]; __builtin_amdgcn_sched_barrier(0); c0 -= A0_0[0] * x[32]; c1 -= A0_0[1] * x[33]; c2 -= A0_0[2] * x[34]; c3 -= A0_0[3] * x[35]; c0 -= A0_1[0] * x[36]; c1 -= A0_1[1] * x[37]; c2 -= A0_1[2] * x[38]; c3 -= A0_1[3] * x[39]; c0 -= A0_2[0] * x[40]; c1 -= A0_2[1] * x[41]; c2 -= A0_2[2] * x[42]; c3 -= A0_2[3] * x[43]; c0 -= A0_3[0] * x[44]; c1 -= A0_3[1] * x[45]; c2 -= A0_3[2] * x[46]; c3 -= A0_3[3] * x[47]; c0 -= A0_4[0] * x[48]; c1 -= A0_4[1] * x[49]; c2 -= A0_4[2] * x[50]; c3 -= A0_4[3] * x[51]; c0 -= A0_5[0] * x[52]; c1 -= A0_5[1] * x[53]; c2 -= A0_5[2] * x[54]; x[55] = (c0 + c1) + (c2 + c3); __builtin_amdgcn_sched_barrier(0);
            A0_0 = *(const LAS f32x4*)(Amv + 3840); A0_1 = *(const LAS f32x4*)(Amv + 3844); A0_2 = *(const LAS f32x4*)(Amv + 3848); A0_3 = *(const LAS f32x4*)(Amv + 3852); A0_4 = *(const LAS f32x4*)(Amv + 3856); A0_5 = *(const LAS f32x4*)(Amv + 3860); __builtin_amdgcn_sched_barrier(0); c0 = r1; c1 = 0.f; c2 = 0.f; c3 = 0.f; c0 -= A1_0[0] * x[0]; c1 -= A1_0[1] * x[1]; c2 -= A1_0[2] * x[2]; c3 -= A1_0[3] * x[3]; c0 -= A1_1[0] * x[4]; c1 -= A1_1[1] * x[5]; c2 -= A1_1[2] * x[6]; c3 -= A1_1[3] * x[7]; c0 -= A1_2[0] * x[8]; c1 -= A1_2[1] * x[9]; c2 -= A1_2[2] * x[10]; c3 -= A1_2[3] * x[11]; c0 -= A1_3[0] * x[12]; c1 -= A1_3[1] * x[13]; c2 -= A1_3[2] * x[14]; c3 -= A1_3[3] * x[15]; c0 -= A1_4[0] * x[16]; c1 -= A1_4[1] * x[17]; c2 -= A1_4[2] * x[18]; c3 -= A1_4[3] * x[19]; c0 -= A1_5[0] * x[20]; c1 -= A1_5[1] * x[21]; c2 -= A1_5[2] * x[22]; c3 -= A1_5[3] * x[23]; c0 -= A1_6[0] * x[24]; c1 -= A1_6[1] * x[25]; c2 -= A1_6[2] * x[26]; c3 -= A1_6[3] * x[27]; c0 -= A1_7[0] * x[28]; c1 -= A1_7[1] * x[29]; c2 -= A1_7[2] * x[30]; c3 -= A1_7[3] * x[31]; __builtin_amdgcn_sched_barrier(0);
            A1_0 = *(const LAS f32x4*)(Amv + 3876); A1_1 = *(const LAS f32x4*)(Amv + 3880); A1_2 = *(const LAS f32x4*)(Amv + 3884); A1_3 = *(const LAS f32x4*)(Amv + 3888); A1_4 = *(const LAS f32x4*)(Amv + 3892); A1_5 = *(const LAS f32x4*)(Amv + 3896); A1_6 = *(const LAS f32x4*)(Amv + 3900); A1_7 = *(const LAS f32x4*)(Amv + 3904); r1 = RHS[14592 + c]; __builtin_amdgcn_sched_barrier(0); c0 -= A0_0[0] * x[32]; c1 -= A0_0[1] * x[33]; c2 -= A0_0[2] * x[34]; c3 -= A0_0[3] * x[35]; c0 -= A0_1[0] * x[36]; c1 -= A0_1[1] * x[37]; c2 -= A0_1[2] * x[38]; c3 -= A0_1[3] * x[39]; c0 -= A0_2[0] * x[40]; c1 -= A0_2[1] * x[41]; c2 -= A0_2[2] * x[42]; c3 -= A0_2[3] * x[43]; c0 -= A0_3[0] * x[44]; c1 -= A0_3[1] * x[45]; c2 -= A0_3[2] * x[46]; c3 -= A0_3[3] * x[47]; c0 -= A0_4[0] * x[48]; c1 -= A0_4[1] * x[49]; c2 -= A0_4[2] * x[50]; c3 -= A0_4[3] * x[51]; c0 -= A0_5[0] * x[52]; c1 -= A0_5[1] * x[53]; c2 -= A0_5[2] * x[54]; c3 -= A0_5[3] * x[55]; x[56] = (c0 + c1) + (c2 + c3); __builtin_amdgcn_sched_barrier(0);
            A0_0 = *(const LAS f32x4*)(Amv + 3908); A0_1 = *(const LAS f32x4*)(Amv + 3912); A0_2 = *(const LAS f32x4*)(Amv + 3916); A0_3 = *(const LAS f32x4*)(Amv + 3920); A0_4 = *(const LAS f32x4*)(Amv + 3924); A0_5 = *(const LAS f32x4*)(Amv + 3928); A0_6 = *(const LAS f32x4*)(Amv + 3932); __builtin_amdgcn_sched_barrier(0); c0 = r1; c1 = 0.f; c2 = 0.f; c3 = 0.f; c0 -= A1_0[0] * x[0]; c1 -= A1_0[1] * x[1]; c2 -= A1_0[2] * x[2]; c3 -= A1_0[3] * x[3]; c0 -= A1_1[0] * x[4]; c1 -= A1_1[1] * x[5]; c2 -= A1_1[2] * x[6]; c3 -= A1_1[3] * x[7]; c0 -= A1_2[0] * x[8]; c1 -= A1_2[1] * x[9]; c2 -= A1_2[2] * x[10]; c3 -= A1_2[3] * x[11]; c0 -= A1_3[0] * x[12]; c1 -= A1_3[1] * x[13]; c2 -= A1_3[2] * x[14]; c3 -= A1_3[3] * x[15]; c0 -= A1_4[0] * x[16]; c1 -= A1_4[1] * x[17]; c2 -= A1_4[2] * x[18]; c3 -= A1_4[3] * x[19]; c0 -= A1_5[0] * x[20]; c1 -= A1_5[1] * x[21]; c2 -= A1_5[2] * x[22]; c3 -= A1_5[3] * x[23]; c0 -= A1_6[0] * x[24]; c1 -= A1_6[1] * x[25]; c2 -= A1_6[2] * x[26]; c3 -= A1_6[3] * x[27]; c0 -= A1_7[0] * x[28]; c1 -= A1_7[1] * x[29]; c2 -= A1_7[2] * x[30]; c3 -= A1_7[3] * x[31]; __builtin_amdgcn_sched_barrier(0);
            A1_0 = *(const LAS f32x4*)(Amv + 3944); A1_1 = *(const LAS f32x4*)(Amv + 3948); A1_2 = *(const LAS f32x4*)(Amv + 3952); A1_3 = *(const LAS f32x4*)(Amv + 3956); A1_4 = *(const LAS f32x4*)(Amv + 3960); A1_5 = *(const LAS f32x4*)(Amv + 3964); A1_6 = *(const LAS f32x4*)(Amv + 3968); A1_7 = *(const LAS f32x4*)(Amv + 3972); r1 = RHS[14848 + c]; __builtin_amdgcn_sched_barrier(0); c0 -= A0_0[0] * x[32]; c1 -= A0_0[1] * x[33]; c2 -= A0_0[2] * x[34]; c3 -= A0_0[3] * x[35]; c0 -= A0_1[0] * x[36]; c1 -= A0_1[1] * x[37]; c2 -= A0_1[2] * x[38]; c3 -= A0_1[3] * x[39]; c0 -= A0_2[0] * x[40]; c1 -= A0_2[1] * x[41]; c2 -= A0_2[2] * x[42]; c3 -= A0_2[3] * x[43]; c0 -= A0_3[0] * x[44]; c1 -= A0_3[1] * x[45]; c2 -= A0_3[2] * x[46]; c3 -= A0_3[3] * x[47]; c0 -= A0_4[0] * x[48]; c1 -= A0_4[1] * x[49]; c2 -= A0_4[2] * x[50]; c3 -= A0_4[3] * x[51]; c0 -= A0_5[0] * x[52]; c1 -= A0_5[1] * x[53]; c2 -= A0_5[2] * x[54]; c3 -= A0_5[3] * x[55]; c0 -= A0_6[0] * x[56]; x[57] = (c0 + c1) + (c2 + c3); __builtin_amdgcn_sched_barrier(0);
            A0_0 = *(const LAS f32x4*)(Amv + 3976); A0_1 = *(const LAS f32x4*)(Amv + 3980); A0_2 = *(const LAS f32x4*)(Amv + 3984); A0_3 = *(const LAS f32x4*)(Amv + 3988); A0_4 = *(const LAS f32x4*)(Amv + 3992); A0_5 = *(const LAS f32x4*)(Amv + 3996); A0_6 = *(const LAS f32x4*)(Amv + 4000); __builtin_amdgcn_sched_barrier(0); c0 = r1; c1 = 0.f; c2 = 0.f; c3 = 0.f; c0 -= A1_0[0] * x[0]; c1 -= A1_0[1] * x[1]; c2 -= A1_0[2] * x[2]; c3 -= A1_0[3] * x[3]; c0 -= A1_1[0] * x[4]; c1 -= A1_1[1] * x[5]; c2 -= A1_1[2] * x[6]; c3 -= A1_1[3] * x[7]; c0 -= A1_2[0] * x[8]; c1 -= A1_2[1] * x[9]; c2 -= A1_2[2] * x[10]; c3 -= A1_2[3] * x[11]; c0 -= A1_3[0] * x[12]; c1 -= A1_3[1] * x[13]; c2 -= A1_3[2] * x[14]; c3 -= A1_3[3] * x[15]; c0 -= A1_4[0] * x[16]; c1 -= A1_4[1] * x[17]; c2 -= A1_4[2] * x[18]; c3 -= A1_4[3] * x[19]; c0 -= A1_5[0] * x[20]; c1 -= A1_5[1] * x[21]; c2 -= A1_5[2] * x[22]; c3 -= A1_5[3] * x[23]; c0 -= A1_6[0] * x[24]; c1 -= A1_6[1] * x[25]; c2 -= A1_6[2] * x[26]; c3 -= A1_6[3] * x[27]; c0 -= A1_7[0] * x[28]; c1 -= A1_7[1] * x[29]; c2 -= A1_7[2] * x[30]; c3 -= A1_7[3] * x[31]; __builtin_amdgcn_sched_barrier(0);
            A1_0 = *(const LAS f32x4*)(Amv + 4012); A1_1 = *(const LAS f32x4*)(Amv + 4016); A1_2 = *(const LAS f32x4*)(Amv + 4020); A1_3 = *(const LAS f32x4*)(Amv + 4024); A1_4 = *(const LAS f32x4*)(Amv + 4028); A1_5 = *(const LAS f32x4*)(Amv + 4032); A1_6 = *(const LAS f32x4*)(Amv + 4036); A1_7 = *(const LAS f32x4*)(Amv + 4040); r1 = RHS[15104 + c]; __builtin_amdgcn_sched_barrier(0); c0 -= A0_0[0] * x[32]; c1 -= A0_0[1] * x[33]; c2 -= A0_0[2] * x[34]; c3 -= A0_0[3] * x[35]; c0 -= A0_1[0] * x[36]; c1 -= A0_1[1] * x[37]; c2 -= A0_1[2] * x[38]; c3 -= A0_1[3] * x[39]; c0 -= A0_2[0] * x[40]; c1 -= A0_2[1] * x[41]; c2 -= A0_2[2] * x[42]; c3 -= A0_2[3] * x[43]; c0 -= A0_3[0] * x[44]; c1 -= A0_3[1] * x[45]; c2 -= A0_3[2] * x[46]; c3 -= A0_3[3] * x[47]; c0 -= A0_4[0] * x[48]; c1 -= A0_4[1] * x[49]; c2 -= A0_4[2] * x[50]; c3 -= A0_4[3] * x[51]; c0 -= A0_5[0] * x[52]; c1 -= A0_5[1] * x[53]; c2 -= A0_5[2] * x[54]; c3 -= A0_5[3] * x[55]; c0 -= A0_6[0] * x[56]; c1 -= A0_6[1] * x[57]; x[58] = (c0 + c1) + (c2 + c3); __builtin_amdgcn_sched_barrier(0);
            A0_0 = *(const LAS f32x4*)(Amv + 4044); A0_1 = *(const LAS f32x4*)(Amv + 4048); A0_2 = *(const LAS f32x4*)(Amv + 4052); A0_3 = *(const LAS f32x4*)(Amv + 4056); A0_4 = *(const LAS f32x4*)(Amv + 4060); A0_5 = *(const LAS f32x4*)(Amv + 4064); A0_6 = *(const LAS f32x4*)(Amv + 4068); __builtin_amdgcn_sched_barrier(0); c0 = r1; c1 = 0.f; c2 = 0.f; c3 = 0.f; c0 -= A1_0[0] * x[0]; c1 -= A1_0[1] * x[1]; c2 -= A1_0[2] * x[2]; c3 -= A1_0[3] * x[3]; c0 -= A1_1[0] * x[4]; c1 -= A1_1[1] * x[5]; c2 -= A1_1[2] * x[6]; c3 -= A1_1[3] * x[7]; c0 -= A1_2[0] * x[8]; c1 -= A1_2[1] * x[9]; c2 -= A1_2[2] * x[10]; c3 -= A1_2[3] * x[11]; c0 -= A1_3[0] * x[12]; c1 -= A1_3[1] * x[13]; c2 -= A1_3[2] * x[14]; c3 -= A1_3[3] * x[15]; c0 -= A1_4[0] * x[16]; c1 -= A1_4[1] * x[17]; c2 -= A1_4[2] * x[18]; c3 -= A1_4[3] * x[19]; c0 -= A1_5[0] * x[20]; c1 -= A1_5[1] * x[21]; c2 -= A1_5[2] * x[22]; c3 -= A1_5[3] * x[23]; c0 -= A1_6[0] * x[24]; c1 -= A1_6[1] * x[25]; c2 -= A1_6[2] * x[26]; c3 -= A1_6[3] * x[27]; c0 -= A1_7[0] * x[28]; c1 -= A1_7[1] * x[29]; c2 -= A1_7[2] * x[30]; c3 -= A1_7[3] * x[31]; __builtin_amdgcn_sched_barrier(0);
            A1_0 = *(const LAS f32x4*)(Amv + 4080); A1_1 = *(const LAS f32x4*)(Amv + 4084); A1_2 = *(const LAS f32x4*)(Amv + 4088); A1_3 = *(const LAS f32x4*)(Amv + 4092); A1_4 = *(const LAS f32x4*)(Amv + 4096); A1_5 = *(const LAS f32x4*)(Amv + 4100); A1_6 = *(const LAS f32x4*)(Amv + 4104); A1_7 = *(const LAS f32x4*)(Amv + 4108); r1 = RHS[15360 + c]; __builtin_amdgcn_sched_barrier(0); c0 -= A0_0[0] * x[32]; c1 -= A0_0[1] * x[33]; c2 -= A0_0[2] * x[34]; c3 -= A0_0[3] * x[35]; c0 -= A0_1[0] * x[36]; c1 -= A0_1[1] * x[37]; c2 -= A0_1[2] * x[38]; c3 -= A0_1[3] * x[39]; c0 -= A0_2[0] * x[40]; c1 -= A0_2[1] * x[41]; c2 -= A0_2[2] * x[42]; c3 -= A0_2[3] * x[43]; c0 -= A0_3[0] * x[44]; c1 -= A0_3[1] * x[45]; c2 -= A0_3[2] * x[46]; c3 -= A0_3[3] * x[47]; c0 -= A0_4[0] * x[48]; c1 -= A0_4[1] * x[49]; c2 -= A0_4[2] * x[50]; c3 -= A0_4[3] * x[51]; c0 -= A0_5[0] * x[52]; c1 -= A0_5[1] * x[53]; c2 -= A0_5[2] * x[54]; c3 -= A0_5[3] * x[55]; c0 -= A0_6[0] * x[56]; c1 -= A0_6[1] * x[57]; c2 -= A0_6[2] * x[58]; x[59] = (c0 + c1) + (c2 + c3); __builtin_amdgcn_sched_barrier(0);
            A0_0 = *(const LAS f32x4*)(Amv + 4112); A0_1 = *(const LAS f32x4*)(Amv + 4116); A0_2 = *(const LAS f32x4*)(Amv + 4120); A0_3 = *(const LAS f32x4*)(Amv + 4124); A0_4 = *(const LAS f32x4*)(Amv + 4128); A0_5 = *(const LAS f32x4*)(Amv + 4132); A0_6 = *(const LAS f32x4*)(Amv + 4136); __builtin_amdgcn_sched_barrier(0); c0 = r1; c1 = 0.f; c2 = 0.f; c3 = 0.f; c0 -= A1_0[0] * x[0]; c1 -= A1_0[1] * x[1]; c2 -= A1_0[2] * x[2]; c3 -= A1_0[3] * x[3]; c0 -= A1_1[0] * x[4]; c1 -= A1_1[1] * x[5]; c2 -= A1_1[2] * x[6]; c3 -= A1_1[3] * x[7]; c0 -= A1_2[0] * x[8]; c1 -= A1_2[1] * x[9]; c2 -= A1_2[2] * x[10]; c3 -= A1_2[3] * x[11]; c0 -= A1_3[0] * x[12]; c1 -= A1_3[1] * x[13]; c2 -= A1_3[2] * x[14]; c3 -= A1_3[3] * x[15]; c0 -= A1_4[0] * x[16]; c1 -= A1_4[1] * x[17]; c2 -= A1_4[2] * x[18]; c3 -= A1_4[3] * x[19]; c0 -= A1_5[0] * x[20]; c1 -= A1_5[1] * x[21]; c2 -= A1_5[2] * x[22]; c3 -= A1_5[3] * x[23]; c0 -= A1_6[0] * x[24]; c1 -= A1_6[1] * x[25]; c2 -= A1_6[2] * x[26]; c3 -= A1_6[3] * x[27]; c0 -= A1_7[0] * x[28]; c1 -= A1_7[1] * x[29]; c2 -= A1_7[2] * x[30]; c3 -= A1_7[3] * x[31]; __builtin_amdgcn_sched_barrier(0);
            A1_0 = *(const LAS f32x4*)(Amv + 4148); A1_1 = *(const LAS f32x4*)(Amv + 4152); A1_2 = *(const LAS f32x4*)(Amv + 4156); A1_3 = *(const LAS f32x4*)(Amv + 4160); A1_4 = *(const LAS f32x4*)(Amv + 4164); A1_5 = *(const LAS f32x4*)(Amv + 4168); A1_6 = *(const LAS f32x4*)(Amv + 4172); A1_7 = *(const LAS f32x4*)(Amv + 4176); r1 = RHS[15616 + c]; __builtin_amdgcn_sched_barrier(0); c0 -= A0_0[0] * x[32]; c1 -= A0_0[1] * x[33]; c2 -= A0_0[2] * x[34]; c3 -= A0_0[3] * x[35]; c0 -= A0_1[0] * x[36]; c1 -= A0_1[1] * x[37]; c2 -= A0_1[2] * x[38]; c3 -= A0_1[3] * x[39]; c0 -= A0_2[0] * x[40]; c1 -= A0_2[1] * x[41]; c2 -= A0_2[2] * x[42]; c3 -= A0_2[3] * x[43]; c0 -= A0_3[0] * x[44]; c1 -= A0_3[1] * x[45]; c2 -= A0_3[2] * x[46]; c3 -= A0_3[3] * x[47]; c0 -= A0_4[0] * x[48]; c1 -= A0_4[1] * x[49]; c2 -= A0_4[2] * x[50]; c3 -= A0_4[3] * x[51]; c0 -= A0_5[0] * x[52]; c1 -= A0_5[1] * x[53]; c2 -= A0_5[2] * x[54]; c3 -= A0_5[3] * x[55]; c0 -= A0_6[0] * x[56]; c1 -= A0_6[1] * x[57]; c2 -= A0_6[2] * x[58]; c3 -= A0_6[3] * x[59]; x[60] = (c0 + c1) + (c2 + c3); __builtin_amdgcn_sched_barrier(0);
            A0_0 = *(const LAS f32x4*)(Amv + 4180); A0_1 = *(const LAS f32x4*)(Amv + 4184); A0_2 = *(const LAS f32x4*)(Amv + 4188); A0_3 = *(const LAS f32x4*)(Amv + 4192); A0_4 = *(const LAS f32x4*)(Amv + 4196); A0_5 = *(const LAS f32x4*)(Amv + 4200); A0_6 = *(const LAS f32x4*)(Amv + 4204); A0_7 = *(const LAS f32x4*)(Amv + 4208); __builtin_amdgcn_sched_barrier(0); c0 = r1; c1 = 0.f; c2 = 0.f; c3 = 0.f; c0 -= A1_0[0] * x[0]; c1 -= A1_0[1] * x[1]; c2 -= A1_0[2] * x[2]; c3 -= A1_0[3] * x[3]; c0 -= A1_1[0] * x[4]; c1 -= A1_1[1] * x[5]; c2 -= A1_1[2] * x[6]; c3 -= A1_1[3] * x[7]; c0 -= A1_2[0] * x[8]; c1 -= A1_2[1] * x[9]; c2 -= A1_2[2] * x[10]; c3 -= A1_2[3] * x[11]; c0 -= A1_3[0] * x[12]; c1 -= A1_3[1] * x[13]; c2 -= A1_3[2] * x[14]; c3 -= A1_3[3] * x[15]; c0 -= A1_4[0] * x[16]; c1 -= A1_4[1] * x[17]; c2 -= A1_4[2] * x[18]; c3 -= A1_4[3] * x[19]; c0 -= A1_5[0] * x[20]; c1 -= A1_5[1] * x[21]; c2 -= A1_5[2] * x[22]; c3 -= A1_5[3] * x[23]; c0 -= A1_6[0] * x[24]; c1 -= A1_6[1] * x[25]; c2 -= A1_6[2] * x[26]; c3 -= A1_6[3] * x[27]; c0 -= A1_7[0] * x[28]; c1 -= A1_7[1] * x[29]; c2 -= A1_7[2] * x[30]; c3 -= A1_7[3] * x[31]; __builtin_amdgcn_sched_barrier(0);
            A1_0 = *(const LAS f32x4*)(Amv + 4216); A1_1 = *(const LAS f32x4*)(Amv + 4220); A1_2 = *(const LAS f32x4*)(Amv + 4224); A1_3 = *(const LAS f32x4*)(Amv + 4228); A1_4 = *(const LAS f32x4*)(Amv + 4232); A1_5 = *(const LAS f32x4*)(Amv + 4236); A1_6 = *(const LAS f32x4*)(Amv + 4240); A1_7 = *(const LAS f32x4*)(Amv + 4244); r1 = RHS[15872 + c]; __builtin_amdgcn_sched_barrier(0); c0 -= A0_0[0] * x[32]; c1 -= A0_0[1] * x[33]; c2 -= A0_0[2] * x[34]; c3 -= A0_0[3] * x[35]; c0 -= A0_1[0] * x[36]; c1 -= A0_1[1] * x[37]; c2 -= A0_1[2] * x[38]; c3 -= A0_1[3] * x[39]; c0 -= A0_2[0] * x[40]; c1 -= A0_2[1] * x[41]; c2 -= A0_2[2] * x[42]; c3 -= A0_2[3] * x[43]; c0 -= A0_3[0] * x[44]; c1 -= A0_3[1] * x[45]; c2 -= A0_3[2] * x[46]; c3 -= A0_3[3] * x[47]; c0 -= A0_4[0] * x[48]; c1 -= A0_4[1] * x[49]; c2 -= A0_4[2] * x[50]; c3 -= A0_4[3] * x[51]; c0 -= A0_5[0] * x[52]; c1 -= A0_5[1] * x[53]; c2 -= A0_5[2] * x[54]; c3 -= A0_5[3] * x[55]; c0 -= A0_6[0] * x[56]; c1 -= A0_6[1] * x[57]; c2 -= A0_6[2] * x[58]; c3 -= A0_6[3] * x[59]; c0 -= A0_7[0] * x[60]; x[61] = (c0 + c1) + (c2 + c3); __builtin_amdgcn_sched_barrier(0);
            A0_0 = *(const LAS f32x4*)(Amv + 4248); A0_1 = *(const LAS f32x4*)(Amv + 4252); A0_2 = *(const LAS f32x4*)(Amv + 4256); A0_3 = *(const LAS f32x4*)(Amv + 4260); A0_4 = *(const LAS f32x4*)(Amv + 4264); A0_5 = *(const LAS f32x4*)(Amv + 4268); A0_6 = *(const LAS f32x4*)(Amv + 4272); A0_7 = *(const LAS f32x4*)(Amv + 4276); __builtin_amdgcn_sched_barrier(0); c0 = r1; c1 = 0.f; c2 = 0.f; c3 = 0.f; c0 -= A1_0[0] * x[0]; c1 -= A1_0[1] * x[1]; c2 -= A1_0[2] * x[2]; c3 -= A1_0[3] * x[3]; c0 -= A1_1[0] * x[4]; c1 -= A1_1[1] * x[5]; c2 -= A1_1[2] * x[6]; c3 -= A1_1[3] * x[7]; c0 -= A1_2[0] * x[8]; c1 -= A1_2[1] * x[9]; c2 -= A1_2[2] * x[10]; c3 -= A1_2[3] * x[11]; c0 -= A1_3[0] * x[12]; c1 -= A1_3[1] * x[13]; c2 -= A1_3[2] * x[14]; c3 -= A1_3[3] * x[15]; c0 -= A1_4[0] * x[16]; c1 -= A1_4[1] * x[17]; c2 -= A1_4[2] * x[18]; c3 -= A1_4[3] * x[19]; c0 -= A1_5[0] * x[20]; c1 -= A1_5[1] * x[21]; c2 -= A1_5[2] * x[22]; c3 -= A1_5[3] * x[23]; c0 -= A1_6[0] * x[24]; c1 -= A1_6[1] * x[25]; c2 -= A1_6[2] * x[26]; c3 -= A1_6[3] * x[27]; c0 -= A1_7[0] * x[28]; c1 -= A1_7[1] * x[29]; c2 -= A1_7[2] * x[30]; c3 -= A1_7[3] * x[31]; __builtin_amdgcn_sched_barrier(0);
            A1_0 = *(const LAS f32x4*)(Amv + 4284); A1_1 = *(const LAS f32x4*)(Amv + 4288); A1_2 = *(const LAS f32x4*)(Amv + 4292); A1_3 = *(const LAS f32x4*)(Amv + 4296); A1_4 = *(const LAS f32x4*)(Amv + 4300); A1_5 = *(const LAS f32x4*)(Amv + 4304); A1_6 = *(const LAS f32x4*)(Amv + 4308); A1_7 = *(const LAS f32x4*)(Amv + 4312); r1 = RHS[16128 + c]; __builtin_amdgcn_sched_barrier(0); c0 -= A0_0[0] * x[32]; c1 -= A0_0[1] * x[33]; c2 -= A0_0[2] * x[34]; c3 -= A0_0[3] * x[35]; c0 -= A0_1[0] * x[36]; c1 -= A0_1[1] * x[37]; c2 -= A0_1[2] * x[38]; c3 -= A0_1[3] * x[39]; c0 -= A0_2[0] * x[40]; c1 -= A0_2[1] * x[41]; c2 -= A0_2[2] * x[42]; c3 -= A0_2[3] * x[43]; c0 -= A0_3[0] * x[44]; c1 -= A0_3[1] * x[45]; c2 -= A0_3[2] * x[46]; c3 -= A0_3[3] * x[47]; c0 -= A0_4[0] * x[48]; c1 -= A0_4[1] * x[49]; c2 -= A0_4[2] * x[50]; c3 -= A0_4[3] * x[51]; c0 -= A0_5[0] * x[52]; c1 -= A0_5[1] * x[53]; c2 -= A0_5[2] * x[54]; c3 -= A0_5[3] * x[55]; c0 -= A0_6[0] * x[56]; c1 -= A0_6[1] * x[57]; c2 -= A0_6[2] * x[58]; c3 -= A0_6[3] * x[59]; c0 -= A0_7[0] * x[60]; c1 -= A0_7[1] * x[61]; x[62] = (c0 + c1) + (c2 + c3); __builtin_amdgcn_sched_barrier(0);
            A0_0 = *(const LAS f32x4*)(Amv + 4316); A0_1 = *(const LAS f32x4*)(Amv + 4320); A0_2 = *(const LAS f32x4*)(Amv + 4324); A0_3 = *(const LAS f32x4*)(Amv + 4328); A0_4 = *(const LAS f32x4*)(Amv + 4332); A0_5 = *(const LAS f32x4*)(Amv + 4336); A0_6 = *(const LAS f32x4*)(Amv + 4340); A0_7 = *(const LAS f32x4*)(Amv + 4344); __builtin_amdgcn_sched_barrier(0); c0 = r1; c1 = 0.f; c2 = 0.f; c3 = 0.f; c0 -= A1_0[0] * x[0]; c1 -= A1_0[1] * x[1]; c2 -= A1_0[2] * x[2]; c3 -= A1_0[3] * x[3]; c0 -= A1_1[0] * x[4]; c1 -= A1_1[1] * x[5]; c2 -= A1_1[2] * x[6]; c3 -= A1_1[3] * x[7]; c0 -= A1_2[0] * x[8]; c1 -= A1_2[1] * x[9]; c2 -= A1_2[2] * x[10]; c3 -= A1_2[3] * x[11]; c0 -= A1_3[0] * x[12]; c1 -= A1_3[1] * x[13]; c2 -= A1_3[2] * x[14]; c3 -= A1_3[3] * x[15]; c0 -= A1_4[0] * x[16]; c1 -= A1_4[1] * x[17]; c2 -= A1_4[2] * x[18]; c3 -= A1_4[3] * x[19]; c0 -= A1_5[0] * x[20]; c1 -= A1_5[1] * x[21]; c2 -= A1_5[2] * x[22]; c3 -= A1_5[3] * x[23]; c0 -= A1_6[0] * x[24]; c1 -= A1_6[1] * x[25]; c2 -= A1_6[2] * x[26]; c3 -= A1_6[3] * x[27]; c0 -= A1_7[0] * x[28]; c1 -= A1_7[1] * x[29]; c2 -= A1_7[2] * x[30]; c3 -= A1_7[3] * x[31]; __builtin_amdgcn_sched_barrier(0);
            __builtin_amdgcn_sched_barrier(0); c0 -= A0_0[0] * x[32]; c1 -= A0_0[1] * x[33]; c2 -= A0_0[2] * x[34]; c3 -= A0_0[3] * x[35]; c0 -= A0_1[0] * x[36]; c1 -= A0_1[1] * x[37]; c2 -= A0_1[2] * x[38]; c3 -= A0_1[3] * x[39]; c0 -= A0_2[0] * x[40]; c1 -= A0_2[1] * x[41]; c2 -= A0_2[2] * x[42]; c3 -= A0_2[3] * x[43]; c0 -= A0_3[0] * x[44]; c1 -= A0_3[1] * x[45]; c2 -= A0_3[2] * x[46]; c3 -= A0_3[3] * x[47]; c0 -= A0_4[0] * x[48]; c1 -= A0_4[1] * x[49]; c2 -= A0_4[2] * x[50]; c3 -= A0_4[3] * x[51]; c0 -= A0_5[0] * x[52]; c1 -= A0_5[1] * x[53]; c2 -= A0_5[2] * x[54]; c3 -= A0_5[3] * x[55]; c0 -= A0_6[0] * x[56]; c1 -= A0_6[1] * x[57]; c2 -= A0_6[2] * x[58]; c3 -= A0_6[3] * x[59]; c0 -= A0_7[0] * x[60]; c1 -= A0_7[1] * x[61]; c2 -= A0_7[2] * x[62]; x[63] = (c0 + c1) + (c2 + c3); __builtin_amdgcn_sched_barrier(0);
            if (c < 128) {
                bf16* ub = GUT + ch * 8192 + (size_t)((c >> 5) * 8) * 256 + (c & 31) * 4;
#pragma unroll
                for (int mi = 0; mi < 2; ++mi)
#pragma unroll
                    for (int g = 0; g < 4; ++g)
#pragma unroll
                        for (int hh = 0; hh < 2; ++hh) { const int i0 = mi * 32 + 8 * g + 4 * hh; v2u o; o.x = pk2(x[i0], x[i0 + 1]); o.y = pk2(x[i0 + 2], x[i0 + 3]);
                            *(v2u*)(ub + (mi * 4 + g) * 256 + hh * 128) = o; }
            } else {
                const int k = c - 128; bf16* wb = GW + ch * 8192 + ((k >> 4) * 64 + ((k >> 3) & 1) * 32) * 8 + (k & 7);
#pragma unroll
                for (int i = 0; i < 64; ++i) wb[((i >> 5) * 8 * 64 + (i & 31)) * 8] = (bf16)f2bf(x[i]);
            }
        }
        LBAR();
    }
}

struct GdnFr { s16x8 a[8]; s16x8 c[4]; s16x8 d[4]; v2u u[4]; float egl; };
__device__ __forceinline__ void phase_gdn_scan(const Args& A, LAS unsigned char* lds, int vcu, int G, int tid, int lane, int wave) {
    unsigned char* ws = A.ws;
    const bf16* GW = (const bf16*)(ws + WS_GW); const bf16* GQG = (const bf16*)(ws + WS_GQG); const bf16* GKDT = (const bf16*)(ws + WS_GKDT); const bf16* GUT = (const bf16*)(ws + WS_GUT); const bf16* GQKM = (const bf16*)(ws + WS_GQKM);
    const float* EGL = (const float*)(ws + WS_EGL); bf16* OB = (bf16*)(ws + WS_OB);
    LAS bf16* ST = (LAS bf16*)lds; LAS bf16* VT = (LAS bf16*)(lds + 17408);
    const int r32 = lane & 31, hi = lane >> 5;
    const int grp = wave >> 2, mi = (wave >> 1) & 1, ni = wave & 1, di = wave >> 1, nd = wave & 1;
    for (int chain = vcu; chain < 256; chain += G) {
        const int b = chain >> 3, h = (chain >> 1) & 3, half = chain & 1;
        for (int e = tid; e < 17408 / 4; e += NTHR) ((LAS unsigned*)lds)[e] = 0u;
        __syncthreads();
        f32x16v Sacc = {};
#define GDN_LOAD(f, nn) do { const size_t ch_ = ((size_t)b * 32 + (nn)) * 4 + h; \
            const bf16* ab_ = (grp == 0 ? GW : GQG) + ch_ * 8192 + (mi * 8 * 64 + lane) * 8; \
            _Pragma("unroll") for (int kk = 0; kk < 8; ++kk) f.a[kk] = *(const s16x8*)(ab_ + kk * 512); \
            { const bf16* cb_ = GQKM + ch_ * 4096 + (mi * 4 * 64 + lane) * 8; _Pragma("unroll") for (int kk = 0; kk < 4; ++kk) f.c[kk] = *(const s16x8*)(cb_ + kk * 512); } \
            { const bf16* ub_ = GUT + ch_ * 8192 + (size_t)(((half * 2 + ni) * 2 + mi) * 4) * 256 + lane * 4; _Pragma("unroll") for (int g = 0; g < 4; ++g) f.u[g] = *(const v2u*)(ub_ + g * 256); } \
            const bf16* db_ = GKDT + ch_ * 8192 + (di * 4 * 64 + lane) * 8; _Pragma("unroll") for (int kk = 0; kk < 4; ++kk) f.d[kk] = *(const s16x8*)(db_ + kk * 512); \
            f.egl = EGL[ch_]; } while (0)
#define GDN_COMPUTE(f, nn) do { f32x16v Dv = {}; const LAS bf16* sb_ = ST + (ni * 32 + r32) * 136 + hi * 8; \
            _Pragma("unroll") for (int kk = 0; kk < 8; ++kk) Dv = __builtin_amdgcn_mfma_f32_32x32x16_bf16(f.a[kk], *(const LAS s16x8*)(sb_ + kk * 16), Dv, 0, 0, 0); \
            if (grp == 0) { _Pragma("unroll") for (int g = 0; g < 4; ++g) { const v2u uu = f.u[g]; \
                const float v0 = __uint_as_float(uu.x << 16) - Dv[4 * g], v1 = __uint_as_float(uu.x & 0xffff0000u) - Dv[4 * g + 1], v2 = __uint_as_float(uu.y << 16) - Dv[4 * g + 2], v3 = __uint_as_float(uu.y & 0xffff0000u) - Dv[4 * g + 3]; \
                v2u pk_; pk_.x = pk2(v0, v1); pk_.y = pk2(v2, v3); *(LAS v2u*)(VT + (ni * 32 + r32) * 72 + mi * 32 + 8 * g + 4 * hi) = pk_; } } \
            LBAR(); \
            if (grp == 1) { const LAS bf16* vb_ = VT + (ni * 32 + r32) * 72 + hi * 8; \
                _Pragma("unroll") for (int kk = 0; kk < 4; ++kk) Dv = __builtin_amdgcn_mfma_f32_32x32x16_bf16(f.c[kk], *(const LAS s16x8*)(vb_ + kk * 16), Dv, 0, 0, 0); \
                bf16* ob_ = OB + ((size_t)b * SEQ + (nn) * 64 + mi * 32) * 512 + h * 128 + half * 64 + ni * 32 + r32; \
                _Pragma("unroll") for (int r = 0; r < 16; ++r) ob_[(size_t)crow16(r, hi) * 512] = (bf16)f2bf(Dv[r]); } \
            { const LAS bf16* vb2_ = VT + (nd * 32 + r32) * 72 + hi * 8; Sacc = Sacc * f.egl; \
              _Pragma("unroll") for (int kk = 0; kk < 4; ++kk) Sacc = __builtin_amdgcn_mfma_f32_32x32x16_bf16(f.d[kk], *(const LAS s16x8*)(vb2_ + kk * 16), Sacc, 0, 0, 0); \
              _Pragma("unroll") for (int g = 0; g < 4; ++g) { v2u pk_; pk_.x = pk2(Sacc[4 * g], Sacc[4 * g + 1]); pk_.y = pk2(Sacc[4 * g + 2], Sacc[4 * g + 3]); *(LAS v2u*)(ST + (nd * 32 + r32) * 136 + di * 32 + 8 * g + 4 * hi) = pk_; } } \
            LBAR(); } while (0)
        GdnFr fa, fb;
        GDN_LOAD(fa, 0);
        for (int n = 0; n < 32; n += 2) {
            GDN_LOAD(fb, n + 1);
            GDN_COMPUTE(fa, n);
            if (n + 2 < 32) GDN_LOAD(fa, n + 2);
            GDN_COMPUTE(fb, n + 1);
        }
#undef GDN_LOAD
#undef GDN_COMPUTE
        __syncthreads();
    }
}

struct GdnFr2 { s16x8 a[8]; v2u x[8]; float egl; };
__device__ __forceinline__ void phase_gdn_scan2(const Args& A, LAS unsigned char* lds, int vcu, int G, int tid, int lane, int wave) {
    unsigned char* ws = A.ws;
    const bf16* GW = (const bf16*)(ws + WS_GW); const bf16* GQG = (const bf16*)(ws + WS_GQG); const bf16* GKDT = (const bf16*)(ws + WS_GKDT); const bf16* GUT = (const bf16*)(ws + WS_GUT); const bf16* GQKM = (const bf16*)(ws + WS_GQKM);
    const float* EGL = (const float*)(ws + WS_EGL); bf16* OB = (bf16*)(ws + WS_OB);
    LAS bf16* ST = (LAS bf16*)lds; LAS bf16* VT = (LAS bf16*)(lds + 17408);
    const int r32 = lane & 31, hi = lane >> 5;
    const bool roleV = wave < 2, roleO = (wave >> 1) == 1, roleS = wave >= 4;
    const int mi = wave & 1, di = wave & 3;
    for (int chain = vcu; chain < 256; chain += G) {
        const int b = chain >> 3, h = (chain >> 1) & 3, half = chain & 1;
        for (int e = tid; e < 17408 / 4; e += NTHR) ((LAS unsigned*)lds)[e] = 0u;
        __syncthreads();
        f32x16v acc0 = {}, acc1 = {};
#define G2_LOAD(f, nn) do { const int n_ = (nn) < 32 ? (nn) : 31; const size_t ch_ = ((size_t)b * 32 + n_) * 4 + h; \
            const bf16* pa_ = roleV ? GW + ch_ * 8192 + (mi * 8 * 64 + lane) * 8 : roleO ? GQG + ch_ * 8192 + (mi * 8 * 64 + lane) * 8 : GKDT + ch_ * 8192 + (di * 4 * 64 + lane) * 8; \
            _Pragma("unroll") for (int kk = 0; kk < 8; ++kk) { const int kq_ = roleS ? (kk & 3) : kk; f.a[kk] = *(const s16x8*)(pa_ + kq_ * 512); } \
            const bf16* px_ = roleV ? GUT + ch_ * 8192 + (size_t)((half * 2) * 2 + mi) * 1024 + lane * 4 : GQKM + ch_ * 4096 + (mi * 4 * 64) * 8 + lane * 8; \
            _Pragma("unroll") for (int j = 0; j < 8; ++j) { const int ox_ = roleV ? (j >> 2) * 2048 + (j & 3) * 256 : (j >> 1) * 512 + (j & 1) * 4; f.x[j] = *(const v2u*)(px_ + ox_); } \
            f.egl = EGL[ch_]; } while (0)
#define G2_COMPUTE(f, nn) do { if ((nn) < 32) { \
            if (!roleS) { acc0 = f32x16v{}; acc1 = f32x16v{}; const LAS bf16* sb0_ = ST + r32 * 136 + hi * 8; const LAS bf16* sb1_ = ST + (32 + r32) * 136 + hi * 8; \
                _Pragma("unroll") for (int kk = 0; kk < 8; ++kk) { acc0 = __builtin_amdgcn_mfma_f32_32x32x16_bf16(f.a[kk], *(const LAS s16x8*)(sb0_ + kk * 16), acc0, 0, 0, 0); \
                                                                 acc1 = __builtin_amdgcn_mfma_f32_32x32x16_bf16(f.a[kk], *(const LAS s16x8*)(sb1_ + kk * 16), acc1, 0, 0, 0); } \
                if (roleV) { _Pragma("unroll") for (int g = 0; g < 4; ++g) { \
                    { const v2u uu = f.x[g]; v2u pk_; pk_.x = pk2(__uint_as_float(uu.x << 16) - acc0[4 * g], __uint_as_float(uu.x & 0xffff0000u) - acc0[4 * g + 1]); pk_.y = pk2(__uint_as_float(uu.y << 16) - acc0[4 * g + 2], __uint_as_float(uu.y & 0xffff0000u) - acc0[4 * g + 3]); \
                      *(LAS v2u*)(VT + r32 * 72 + mi * 32 + 8 * g + 4 * hi) = pk_; } \
                    { const v2u uu = f.x[4 + g]; v2u pk_; pk_.x = pk2(__uint_as_float(uu.x << 16) - acc1[4 * g], __uint_as_float(uu.x & 0xffff0000u) - acc1[4 * g + 1]); pk_.y = pk2(__uint_as_float(uu.y << 16) - acc1[4 * g + 2], __uint_as_float(uu.y & 0xffff0000u) - acc1[4 * g + 3]); \
                      *(LAS v2u*)(VT + (32 + r32) * 72 + mi * 32 + 8 * g + 4 * hi) = pk_; } } } } \
            LBAR(); \
            { const LAS bf16* vb0_ = VT + r32 * 72 + hi * 8; const LAS bf16* vb1_ = VT + (32 + r32) * 72 + hi * 8; \
              if (roleO) { \
                _Pragma("unroll") for (int kk = 0; kk < 4; ++kk) { v4u q_; q_.x = f.x[2 * kk].x; q_.y = f.x[2 * kk].y; q_.z = f.x[2 * kk + 1].x; q_.w = f.x[2 * kk + 1].y; const s16x8 fr_ = __builtin_bit_cast(s16x8, q_); \
                    acc0 = __builtin_amdgcn_mfma_f32_32x32x16_bf16(fr_, *(const LAS s16x8*)(vb0_ + kk * 16), acc0, 0, 0, 0); acc1 = __builtin_amdgcn_mfma_f32_32x32x16_bf16(fr_, *(const LAS s16x8*)(vb1_ + kk * 16), acc1, 0, 0, 0); } \
                bf16* ob_ = OB + ((size_t)b * SEQ + (nn) * 64 + mi * 32) * 512 + h * 128 + half * 64 + r32; \
                _Pragma("unroll") for (int r = 0; r < 16; ++r) { ob_[(size_t)crow16(r, hi) * 512] = (bf16)f2bf(acc0[r]); ob_[(size_t)crow16(r, hi) * 512 + 32] = (bf16)f2bf(acc1[r]); } } \
              if (roleS) { acc0 = acc0 * f.egl; acc1 = acc1 * f.egl; \
                _Pragma("unroll") for (int kk = 0; kk < 4; ++kk) { acc0 = __builtin_amdgcn_mfma_f32_32x32x16_bf16(f.a[kk], *(const LAS s16x8*)(vb0_ + kk * 16), acc0, 0, 0, 0); acc1 = __builtin_amdgcn_mfma_f32_32x32x16_bf16(f.a[kk], *(const LAS s16x8*)(vb1_ + kk * 16), acc1, 0, 0, 0); } \
                _Pragma("unroll") for (int g = 0; g < 4; ++g) { v2u pk_; pk_.x = pk2(acc0[4 * g], acc0[4 * g + 1]); pk_.y = pk2(acc0[4 * g + 2], acc0[4 * g + 3]); *(LAS v2u*)(ST + r32 * 136 + di * 32 + 8 * g + 4 * hi) = pk_; \
                                                                   pk_.x = pk2(acc1[4 * g], acc1[4 * g + 1]); pk_.y = pk2(acc1[4 * g + 2], acc1[4 * g + 3]); *(LAS v2u*)(ST + (32 + r32) * 136 + di * 32 + 8 * g + 4 * hi) = pk_; } } } \
            LBAR(); } } while (0)
        GdnFr2 f0, f1, f2;
        G2_LOAD(f0, 0); G2_LOAD(f1, 1);
        for (int n = 0; n < 33; n += 3) {
            G2_LOAD(f2, n + 2); G2_COMPUTE(f0, n);
            G2_LOAD(f0, n + 3); G2_COMPUTE(f1, n + 1);
            G2_LOAD(f1, n + 4); G2_COMPUTE(f2, n + 2);
        }
#undef G2_LOAD
#undef G2_COMPUTE
        __syncthreads();
    }
}

__device__ __forceinline__ void phase_gate0(const Args& A, int vcu, int G, int lane, int wave) {
    unsigned char* ws = A.ws;
    const bf16* OA = (const bf16*)(ws + WS_OA); const bf16* OBp = (const bf16*)(ws + WS_OB);
    const bf16* PAZ = (const bf16*)(ws + WS_P) + 1 * PSTRIDE + 512;
    const bf16* PBZ = (const bf16*)(ws + WS_P) + 3 * PSTRIDE + 512;
    bf16* MIX = (bf16*)(ws + WS_XB);
    const float l1 = wave_sum(A.lq1[lane] * A.lk1[lane]), l2 = wave_sum(A.lq2[lane] * A.lk2[lane]);
    const float lam = expf(l1) - expf(l2) + 0.2f;
    const int e0 = (8 * lane) & 127; float sub[8], hn[8];
#pragma unroll
    for (int i = 0; i < 8; ++i) { sub[i] = A.subln[e0 + i] * 0.8f; hn[i] = A.head_norm[e0 + i]; }
    const int gw = vcu * NWAVES + wave, NGW = G * NWAVES;
    for (int m = gw; m < M; m += NGW) {
        const v4u o0 = *(const v4u*)(OA + (size_t)m * 1024 + 8 * lane), o1 = *(const v4u*)(OA + (size_t)m * 1024 + 512 + 8 * lane);
        const v4u az = *(const v4u*)(PAZ + (size_t)m * 1024 + 8 * lane), bz = *(const v4u*)(PBZ + (size_t)m * 1024 + 8 * lane);
        const v4u ob = *(const v4u*)(OBp + (size_t)m * 512 + 8 * lane);
        float f0[8], f1[8], fz[8], d[8], r[8];
        unpack8(o0, f0); unpack8(o1, f1); unpack8(az, fz);
        float ss = 0.f;
#pragma unroll
        for (int i = 0; i < 8; ++i) { d[i] = f0[i] - lam * f1[i]; ss += d[i] * d[i]; }
        ss = row16_sum(ss);
        float rs = __builtin_amdgcn_rsqf(ss * (1.f / 128.f) + EPS);
#pragma unroll
        for (int i = 0; i < 8; ++i) r[i] = d[i] * rs * sub[i] * silu_f(fz[i]);
        v4u w; w.x = pk2(r[0], r[1]); w.y = pk2(r[2], r[3]); w.z = pk2(r[4], r[5]); w.w = pk2(r[6], r[7]);
        *(v4u*)(MIX + (size_t)m * 1024 + 8 * lane) = w;
        unpack8(ob, f0); unpack8(bz, fz);
        ss = 0.f;
#pragma unroll
        for (int i = 0; i < 8; ++i) ss += f0[i] * f0[i];
        ss = row16_sum(ss);
        rs = __builtin_amdgcn_rsqf(ss * (1.f / 128.f) + EPS);
#pragma unroll
        for (int i = 0; i < 8; ++i) r[i] = f0[i] * rs * hn[i] * silu_f(fz[i]);
        w.x = pk2(r[0], r[1]); w.y = pk2(r[2], r[3]); w.z = pk2(r[4], r[5]); w.w = pk2(r[6], r[7]);
        *(v4u*)(MIX + (size_t)m * 1024 + 512 + 8 * lane) = w;
    }
}

template <bool NEXT> __device__ __forceinline__ void phase_residual(const Args& A, LAS unsigned char* lds, const float* xin, const float* postw, int vcu, int G, int tid, int lane, int wave) {
    unsigned char* ws = A.ws;
    const bf16* Y = (const bf16*)(ws + WS_OA); bf16* XB = (bf16*)(ws + WS_XB); float* LOGF = (float*)(ws + WS_CUM);
    LAS float* wl = (LAS float*)lds;
    if (NEXT) { stage_small_w<16>(wl, A.w_in_c, IN_C, A.pre + D, tid); __syncthreads(); }
    f32x4 pw[4];
#pragma unroll
    for (int j = 0; j < 4; ++j) pw[j] = ((const f32x4*)postw)[64 * j + lane];
    const float fb = NEXT ? A.fbias[lane & 15] : 0.f;
    const int gw = vcu * NWAVES + wave, NGW = G * NWAVES;
    for (int m = gw; m < M; m += NGW) {
        const f32x4* xr = (const f32x4*)(xin + (size_t)m * D) + lane; const v2u* yr = (const v2u*)(Y + (size_t)m * D) + lane;
        f32x4 v[4], y[4];
#pragma unroll
        for (int j = 0; j < 4; ++j) { v[j] = xr[64 * j]; const v2u yy = yr[64 * j]; y[j].x = __uint_as_float(yy.x << 16); y[j].y = __uint_as_float(yy.x & 0xffff0000u); y[j].z = __uint_as_float(yy.y << 16); y[j].w = __uint_as_float(yy.y & 0xffff0000u); }
        const float ry = __builtin_amdgcn_rsqf(wave_sum(sumsq4(y)) * (1.f / D) + EPS);
#pragma unroll
        for (int j = 0; j < 4; ++j) v[j] = v[j] + y[j] * ry * pw[j];
        f32x4* orow = (f32x4*)(A.out + (size_t)m * D) + lane;
#pragma unroll
        for (int j = 0; j < 4; ++j) orow[64 * j] = v[j];
        if (NEXT) {
            const float rstd = __builtin_amdgcn_rsqf(wave_sum(sumsq4(v)) * (1.f / D) + EPS);
            store_row_bf16(XB + (size_t)m * D, v, rstd, lane);
            const float mine = small_dots<16>(wl, v, lane);
            if (lane < 16) { const float z = mine * rstd + fb; const float lf = fminf(z, 0.f) - log1pf(expf(-fabsf(z))); const int b = m / SEQ, sidx = m % SEQ; LOGF[((size_t)b * 16 + lane) * SEQ + sidx] = lf; }
        }
    }
}

__device__ __forceinline__ void phase_cumsum(const Args& A, int vcu, int G, int lane, int wave) {
    float* C = (float*)(A.ws + WS_CUM);
    const int gw = vcu * NWAVES + wave, NGW = G * NWAVES;
    for (int sq = gw; sq < BATCH * 16; sq += NGW) {
        f32x4* p = (f32x4*)(C + (size_t)sq * SEQ + 32 * lane); f32x4 v[8]; float run = 0.f;
#pragma unroll
        for (int j = 0; j < 8; ++j) { v[j] = p[j]; v[j].x += run; v[j].y += v[j].x; v[j].z += v[j].y; v[j].w += v[j].z; run = v[j].w; }
        float inc = run;
#pragma unroll
        for (int o = 1; o < 64; o <<= 1) { const float t = __shfl_up(inc, o); if (lane >= o) inc += t; }
        const float excl = inc - run;
#pragma unroll
        for (int j = 0; j < 8; ++j) { v[j] = v[j] + excl; p[j] = v[j]; }
    }
}

__device__ __forceinline__ void phase_gate1(const Args& A, int vcu, int G, int tid) {
    unsigned char* ws = A.ws;
    const v4u* O = (const v4u*)(ws + WS_OA); const v4u* Z = (const v4u*)((const bf16*)(ws + WS_P) + 3 * PSTRIDE); v4u* MIX = (v4u*)(ws + WS_XB);
    const size_t n = (size_t)M * 1024 / 8;
    for (size_t i = (size_t)vcu * NTHR + tid; i < n; i += (size_t)G * NTHR) {
        const v4u o = O[i], z = Z[i]; float fo[8], fz[8]; unpack8(o, fo); unpack8(z, fz);
#pragma unroll
        for (int k = 0; k < 8; ++k) fo[k] *= silu_f(fz[k]);
        v4u w; w.x = pk2(fo[0], fo[1]); w.y = pk2(fo[2], fo[3]); w.z = pk2(fo[4], fo[5]); w.w = pk2(fo[6], fo[7]);
        MIX[i] = w;
    }
}

__global__ void __launch_bounds__(NTHR, 2) trunk_fwd(Args A) {
    extern __shared__ __attribute__((aligned(16))) unsigned char lds_raw[];
    cg::grid_group grid = cg::this_grid();
    LAS unsigned char* lds = (LAS unsigned char*)lds_raw;
    const int tid = threadIdx.x, lane = tid & 63, wave = __builtin_amdgcn_readfirstlane(tid >> 6);
    const int G = gridDim.x, bx = blockIdx.x; const int vcu = (G % 8 == 0) ? (bx % 8) * (G / 8) + bx / 8 : bx;
    unsigned char* ws = A.ws;
    bf16* XB = (bf16*)(ws + WS_XB); bf16* P = (bf16*)(ws + WS_P); bf16* OA = (bf16*)(ws + WS_OA);
    volatile LAS unsigned* bst = (volatile LAS unsigned*)(lds + 147456 - 16);
    if (tid < 4) ((LAS unsigned*)(lds + 147456 - 16))[tid] = 0u;
    __syncthreads();
    const XcdBarrier xbar = xcd_barrier_post((unsigned*)(ws + WS_BAR), bst);
#define GSYNC() xcd_barrier(xbar)

    phase_prologue(A, lds, vcu, G, tid, lane, wave);
    grid.sync();
    {   pg8::Gemm g{XB, (const bf16*)(ws + WS_W1T), M, NP, D}; pg8::StaticOrder S; S.init(M, NP, G, bx);
        EpiRope E{P, (const float*)(ws + WS_CS)};
        pg8::gemm_phase<EpiRope, pg8::StaticOrder, PG8_ALIGN, PG8_SP2>(lds, g, S, E); }
    GSYNC();
    phase_gdn_prep(A, lds, vcu, G, tid, lane, wave);
    GSYNC();
    phase_gdn_scan2(A, lds, vcu, G, tid, lane, wave);
    {   const attn_body::AttnTensors AT{(const attn_body::bf16*)P, (const attn_body::bf16*)(P + 512), (const attn_body::bf16*)(P + PSTRIDE), (attn_body::bf16*)OA, nullptr, nullptr};
        const attn_body::StaticOrder S(vcu, G, 1024);
        attn_body::attn_phase<false>((char*)lds_raw, AT, S); }
    GSYNC();
    phase_gate0(A, vcu, G, lane, wave);
    GSYNC();
    {   pg8::Gemm g{XB, (const bf16*)(ws + WS_WO1T), M, D, D}; pg8::StaticOrder S; S.init(M, D, G, bx);
        pg8::EpiBf16<0> E{OA, D, nullptr, 0, 0, 1.f};
        pg8::gemm_phase<pg8::EpiBf16<0>, pg8::StaticOrder, PG8_ALIGN, PG8_SP2>(lds, g, S, E); }
    GSYNC();
    phase_residual<true>(A, lds, A.x, A.post, vcu, G, tid, lane, wave);
    GSYNC();
    phase_cumsum(A, vcu, G, lane, wave);
    {   pg8::Gemm g{XB, (const bf16*)(ws + WS_W2T), M, NP, D}; pg8::StaticOrder S; S.init(M, NP, G, bx);
        pg8::EpiBf16<0> E{P, D, nullptr, 1024, PSTRIDE, 1.f};
        pg8::gemm_phase<pg8::EpiBf16<0>, pg8::StaticOrder, PG8_ALIGN, PG8_SP2>(lds, g, S, E); }
    GSYNC();
    {   const attn_body::AttnTensors AT{(const attn_body::bf16*)P, (const attn_body::bf16*)(P + PSTRIDE), (const attn_body::bf16*)(P + 2 * PSTRIDE), (attn_body::bf16*)XB, (const float*)(ws + WS_CUM), (const attn_body::bf16*)(P + 3 * PSTRIDE)};
        const attn_body::StaticOrder S(vcu, G, 2048);
        attn_body::attn_phase<true>((char*)lds_raw, AT, S); }
    GSYNC();
    {   pg8::Gemm g{XB, (const bf16*)(ws + WS_WO2T), M, D, D}; pg8::StaticOrder S; S.init(M, D, G, bx);
        pg8::EpiBf16<0> E{OA, D, nullptr, 0, 0, 1.f};
        pg8::gemm_phase<pg8::EpiBf16<0>, pg8::StaticOrder, PG8_ALIGN, PG8_SP2>(lds, g, S, E); }
    GSYNC();
    phase_residual<false>(A, lds, A.out, A.post + D, vcu, G, tid, lane, wave);
}

extern "C" void kernel_launch(void* const* d_in, const int* in_sizes, int n_in, void* d_out, int out_size, void* d_ws, size_t ws_size, hipStream_t stream) {
    static int grid = 0;
    if (grid == 0) {
        if (n_in != 18 || out_size != M * D || ws_size < WS_END) { fprintf(stderr, "kernel_launch: unexpected shapes (n_in %d out %d ws %zu)\n", n_in, out_size, ws_size); grid = -1; return; }
        int dev = 0, cus = 0, per_cu = 0;
        hipGetDevice(&dev); hipDeviceGetAttribute(&cus, hipDeviceAttributeMultiprocessorCount, dev);
        if (hipFuncSetAttribute((const void*)trunk_fwd, hipFuncAttributeMaxDynamicSharedMemorySize, LDS_BYTES) != hipSuccess) { fprintf(stderr, "kernel_launch: hipFuncSetAttribute failed\n"); grid = -1; return; }
        if (hipOccupancyMaxActiveBlocksPerMultiprocessor(&per_cu, (const void*)trunk_fwd, NTHR, LDS_BYTES) != hipSuccess || per_cu < 1) { fprintf(stderr, "kernel_launch: occupancy query gives %d\n", per_cu); per_cu = 1; }
        (void)hipGetLastError();
        grid = cus * 1;
    }
    if (grid < 0) return;
    Args a{};
    a.x = (const float*)d_in[0]; a.pos = (const int*)d_in[1]; a.pre = (const float*)d_in[2]; a.post = (const float*)d_in[3]; a.w_in_ab = (const float*)d_in[4];
    a.lq1 = (const float*)d_in[5]; a.lk1 = (const float*)d_in[6]; a.lq2 = (const float*)d_in[7]; a.lk2 = (const float*)d_in[8]; a.subln = (const float*)d_in[9];
    a.convw = (const float*)d_in[10]; a.a_log = (const float*)d_in[11]; a.dt_bias = (const float*)d_in[12]; a.head_norm = (const float*)d_in[13]; a.w_out_ab = (const float*)d_in[14];
    a.w_in_c = (const float*)d_in[15]; a.fbias = (const float*)d_in[16]; a.w_out_c = (const float*)d_in[17];
    a.out = (float*)d_out; a.ws = (unsigned char*)d_ws;
    if (hipMemsetAsync((char*)d_ws + WS_BAR, 0, XCD_BAR_WORDS * 4, stream) != hipSuccess) { fprintf(stderr, "kernel_launch: memset failed\n"); return; }
    void* args[] = {&a};
    hipError_t e = hipLaunchCooperativeKernel((const void*)trunk_fwd, dim3(grid), dim3(NTHR), args, LDS_BYTES, stream);
    if (e != hipSuccess) fprintf(stderr, "kernel_launch: cooperative launch failed: %s (grid %d)\n", hipGetErrorString(e), grid);
}
```
